# Optimizing an MI355X kernel written in HIP

```python
import math
import jax, jax.numpy as jnp
from jax import lax
import numpy as np

D_MODEL = 1024
BATCH = 8
SEQ = 4096
DEPTH = 1

N_HEADS = 8
HEAD_DIM = D_MODEL // (2 * N_HEADS)
V_DIM = 2 * HEAD_DIM
ATTN_WIDTH = N_HEADS * V_DIM
QK_WIDTH = N_HEADS * 2 * HEAD_DIM
Q_BLOCK = 128
CONV_WIDTH = D_MODEL
CONV_K = 31
N_EXPERTS = 256
TOP_K = 8
N_GROUPS = 8
TOPK_GROUPS = 4
D_EXPERT = 256
D_SHARED = 256
ROUTED_SCALE = 2.5
MOE_BLOCK = 128
LN_EPS = 1e-5
RMS_EPS = 1e-5
DN_ALPHA = (2.0 * DEPTH) ** 0.25
DN_BETA = (8.0 * DEPTH) ** -0.25

IN_SIZES = [QK_WIDTH, QK_WIDTH, ATTN_WIDTH, CONV_WIDTH, CONV_WIDTH, D_MODEL, D_MODEL]
IN_COLS = sum(IN_SIZES)
IN_SPLITS = [sum(IN_SIZES[:i + 1]) for i in range(len(IN_SIZES) - 1)]
V_COL_START = 2 * QK_WIDTH
V_COL_END = 2 * QK_WIDTH + ATTN_WIDTH

kernel_name = "hybrid_diffattn_conformer_moe_block"


def lambda_init_for(layer_idx_1based):
    return 0.8 - 0.6 * math.exp(-0.3 * (layer_idx_1based - 1))


def layer_norm(x, g, b):
    xf = x.astype(jnp.float32)
    mu = xf.mean(-1, keepdims=True)
    var = jnp.square(xf - mu).mean(-1, keepdims=True)
    y = (xf - mu) * lax.rsqrt(var + LN_EPS) * g.astype(jnp.float32) + b.astype(jnp.float32)
    return y.astype(x.dtype)


def rms_norm(x, g):
    xf = x.astype(jnp.float32)
    y = xf * lax.rsqrt(jnp.square(xf).mean(-1, keepdims=True) + RMS_EPS) * g.astype(jnp.float32)
    return y


def ada_modulation(c, w_ada, b_ada):
    mod = jax.nn.silu(c) @ w_ada + b_ada
    return jnp.split(mod[:, None, :], 6, axis=-1)


def diff_attention(q, k, v, lam):
    S = q.shape[1]
    qf = q.astype(jnp.float32) * (HEAD_DIM ** -0.5)
    kf = k.astype(jnp.float32)
    vf = v.astype(jnp.float32)
    outs = []
    for i in range(S // Q_BLOCK):
        kv_len = (i + 1) * Q_BLOCK
        q_blk = qf[:, i * Q_BLOCK:kv_len]
        k_blk = kf[:, :kv_len]
        v_blk = vf[:, :kv_len]
        s = jnp.einsum('bqhmd,bkhmd->bhmqk', q_blk, k_blk)
        qpos = i * Q_BLOCK + jnp.arange(Q_BLOCK)
        kpos = jnp.arange(kv_len)
        causal = kpos[None, :] <= qpos[:, None]
        s = jnp.where(causal, s, -jnp.inf)
        p = jax.nn.softmax(s, axis=-1)
        a = p[:, :, 0] - lam * p[:, :, 1]
        outs.append(jnp.einsum('bhqk,bkhv->bqhv', a, v_blk))
    return jnp.concatenate(outs, axis=1)


def conformer_conv(u_a, u_b, w_dw, b_dw, ln_g, ln_b, w_pw, b_pw):
    u = u_a * jax.nn.sigmoid(u_b)
    y = lax.conv_general_dilated(
        u, w_dw[:, None, :].astype(u.dtype), window_strides=(1,),
        padding=[(CONV_K - 1, 0)], dimension_numbers=('NWC', 'WIO', 'NWC'),
        feature_group_count=CONV_WIDTH) + b_dw
    y = jax.nn.silu(layer_norm(y, ln_g, ln_b))
    return y @ w_pw + b_pw


def moe_ffn(h, w_router, router_bias, w1, w3, w2, ws1, ws3, ws2):
    B, S, D = h.shape
    T = B * S
    xf = h.reshape(T, D)
    scores = jax.nn.sigmoid(xf.astype(jnp.float32) @ w_router.astype(jnp.float32))
    choice = scores + router_bias.astype(jnp.float32)
    grp_score = lax.top_k(choice.reshape(T, N_GROUPS, N_EXPERTS // N_GROUPS), 2)[0].sum(-1)
    _, top_grp = lax.top_k(grp_score, TOPK_GROUPS)
    grp_mask = jnp.any(top_grp[..., None] == jnp.arange(N_GROUPS)[None, None, :], axis=1)
    exp_mask = jnp.repeat(grp_mask, N_EXPERTS // N_GROUPS, axis=-1)
    _, idx = lax.top_k(jnp.where(exp_mask, choice, -jnp.inf), TOP_K)
    gate = jnp.take_along_axis(scores, idx, axis=-1)
    gate = gate / gate.sum(-1, keepdims=True) * ROUTED_SCALE

    A = T * TOP_K
    e_flat = idx.reshape(A).astype(jnp.int32)
    tok_flat = jnp.arange(A, dtype=jnp.int32) // TOP_K
    g_flat = gate.reshape(A)
    order = jnp.argsort(e_flat)
    e_sorted = e_flat[order]
    tok_sorted = tok_flat[order]
    g_sorted = g_flat[order]
    counts = jnp.bincount(e_flat, length=N_EXPERTS).astype(jnp.int32)
    starts = jnp.cumsum(counts) - counts
    padded = (counts + MOE_BLOCK - 1) // MOE_BLOCK * MOE_BLOCK
    pad_ends = jnp.cumsum(padded)
    pad_starts = pad_ends - padded
    dest = pad_starts[e_sorted] + (jnp.arange(A, dtype=jnp.int32) - starts[e_sorted])
    P = A + N_EXPERTS * MOE_BLOCK
    n_blocks = P // MOE_BLOCK
    buf_tok = jnp.zeros((P,), jnp.int32).at[dest].set(tok_sorted).reshape(n_blocks, MOE_BLOCK)
    buf_gate = jnp.zeros((P,), jnp.float32).at[dest].set(g_sorted).reshape(n_blocks, MOE_BLOCK)
    blk_expert = jnp.minimum(
        jnp.searchsorted(pad_ends, jnp.arange(n_blocks, dtype=jnp.int32) * MOE_BLOCK, side='right'),
        N_EXPERTS - 1).astype(jnp.int32)

    def step(acc, inp):
        e, toks, g = inp
        xb = xf[toks]
        hb = jax.nn.silu(xb @ w1[e]) * (xb @ w3[e])
        yb = (hb @ w2[e]).astype(jnp.float32) * g[:, None]
        return acc.at[toks].add(yb), None

    routed, _ = lax.scan(step, jnp.zeros((T, D), jnp.float32), (blk_expert, buf_tok, buf_gate))
    shared = (jax.nn.silu(xf @ ws1) * (xf @ ws3)) @ ws2
    return (routed.astype(h.dtype) + shared).reshape(B, S, D)


def setup_inputs(seed: int = 0) -> dict:
    key = jax.random.key(seed)
    ks = jax.random.split(key, 32)
    L, D = DEPTH, D_MODEL
    f32 = jnp.float32
    nrm = lambda k, shape, s: jax.random.normal(k, shape, f32) * s
    col_scale = jnp.ones((IN_COLS,), f32).at[V_COL_START:V_COL_END].set(DN_BETA)
    return {
        "x": nrm(ks[0], (BATCH, SEQ, D), 1.0),
        "c": nrm(ks[1], (BATCH, D), 1.0),
        "ada_w": nrm(ks[2], (L, D, 6 * D), D ** -0.5),
        "ada_b": nrm(ks[3], (L, 6 * D), 0.02),
        "w_in": nrm(ks[4], (L, D, IN_COLS), D ** -0.5) * col_scale,
        "b_in": nrm(ks[5], (L, IN_COLS), 0.02),
        "lambda_q1": nrm(ks[6], (L, HEAD_DIM), 0.1),
        "lambda_k1": nrm(ks[7], (L, HEAD_DIM), 0.1),
        "lambda_q2": nrm(ks[8], (L, HEAD_DIM), 0.1),
        "lambda_k2": nrm(ks[9], (L, HEAD_DIM), 0.1),
        "subln_g": 1.0 + nrm(ks[10], (L, V_DIM), 0.02),
        "w_attn_o": nrm(ks[11], (L, ATTN_WIDTH, D), ATTN_WIDTH ** -0.5),
        "conv_w": nrm(ks[12], (L, CONV_K, CONV_WIDTH), CONV_K ** -0.5),
        "conv_b": nrm(ks[13], (L, CONV_WIDTH), 0.02),
        "conv_ln_g": 1.0 + nrm(ks[14], (L, CONV_WIDTH), 0.02),
        "conv_ln_b": nrm(ks[15], (L, CONV_WIDTH), 0.02),
        "conv_pw_w": nrm(ks[16], (L, CONV_WIDTH, D), CONV_WIDTH ** -0.5),
        "conv_pw_b": nrm(ks[17], (L, D), 0.02),
        "w_out": nrm(ks[18], (L, D, D), D ** -0.5) * DN_BETA,
        "ln1_g": 1.0 + nrm(ks[19], (L, D), 0.02),
        "ln1_b": nrm(ks[20], (L, D), 0.02),
        "router_w": nrm(ks[21], (L, D, N_EXPERTS), D ** -0.5),
        "router_bias": nrm(ks[22], (L, N_EXPERTS), 0.01),
        "w1": nrm(ks[23], (L, N_EXPERTS, D, D_EXPERT), D ** -0.5),
        "w3": nrm(ks[24], (L, N_EXPERTS, D, D_EXPERT), D ** -0.5),
        "w2": nrm(ks[25], (L, N_EXPERTS, D_EXPERT, D), D_EXPERT ** -0.5) * DN_BETA,
        "ws1": nrm(ks[26], (L, D, D_SHARED), D ** -0.5),
        "ws3": nrm(ks[27], (L, D, D_SHARED), D ** -0.5),
        "ws2": nrm(ks[28], (L, D_SHARED, D), D_SHARED ** -0.5) * DN_BETA,
        "ln2_g": 1.0 + nrm(ks[29], (L, D), 0.02),
        "ln2_b": nrm(ks[30], (L, D), 0.02),
    }


def reference(x, c, ada_w, ada_b, w_in, b_in, lambda_q1, lambda_k1, lambda_q2, lambda_k2,
              subln_g, w_attn_o, conv_w, conv_b, conv_ln_g, conv_ln_b, conv_pw_w, conv_pw_b,
              w_out, ln1_g, ln1_b, router_w, router_bias, w1, w3, w2, ws1, ws3, ws2, ln2_g, ln2_b):
    B, S, _ = x.shape
    for l in range(DEPTH):
        sh1, sc1, g1, sh2, sc2, g2 = ada_modulation(c, ada_w[l], ada_b[l])
        h = x * (1.0 + sc1) + sh1
        proj = h @ w_in[l] + b_in[l]
        q, k, v, glu_a, glu_b, gate_a, gate_b = jnp.split(proj, IN_SPLITS, axis=-1)
        q = q.reshape(B, S, N_HEADS, 2, HEAD_DIM)
        k = k.reshape(B, S, N_HEADS, 2, HEAD_DIM)
        v = v.reshape(B, S, N_HEADS, V_DIM)
        lam_init = lambda_init_for(l + 1)
        lam = (jnp.exp(jnp.sum(lambda_q1[l].astype(jnp.float32) * lambda_k1[l].astype(jnp.float32)))
               - jnp.exp(jnp.sum(lambda_q2[l].astype(jnp.float32) * lambda_k2[l].astype(jnp.float32)))
               + lam_init)
        o = diff_attention(q, k, v, lam)
        o = rms_norm(o, subln_g[l]) * (1.0 - lam_init)
        y_attn = o.reshape(B, S, ATTN_WIDTH).astype(x.dtype) @ w_attn_o[l]
        y_conv = conformer_conv(glu_a, glu_b, conv_w[l], conv_b[l], conv_ln_g[l], conv_ln_b[l],
                                conv_pw_w[l], conv_pw_b[l])
        m = jax.nn.sigmoid(gate_a) * y_attn + jax.nn.sigmoid(gate_b) * y_conv
        y = m @ w_out[l]
        x = layer_norm(DN_ALPHA * x + g1 * y, ln1_g[l], ln1_b[l])
        h2 = x * (1.0 + sc2) + sh2
        y2 = moe_ffn(h2, router_w[l], router_bias[l], w1[l], w3[l], w2[l], ws1[l], ws3[l], ws2[l])
        x = layer_norm(DN_ALPHA * x + g2 * y2, ln2_g[l], ln2_b[l])
    return x
```

```cpp
#include <hip/hip_runtime.h>
#include <hip/hip_bf16.h>
#include <cstdio>
#include <cstdint>
#include <cmath>

#ifndef MK_SPLIT
#define MK_SPLIT 0
#endif
#ifndef DBG_CHECK
#define DBG_CHECK 0
#endif

constexpr int T_ = 32768, D_ = 1024, NB_ = 8, SEQ_ = 4096;
constexpr int NIN_ = 7168;
constexpr int NE_ = 256, NEX_ = 257, TOPK_ = 8;
constexpr int FE_ = 256;
constexpr float LN_EPS_ = 1e-5f, RMS_EPS_ = 1e-5f;
constexpr float DN_ALPHA_ = 1.189207115002721f;
constexpr float LAM_INIT_ = 0.2f;
constexpr float ROUTED_SCALE_ = 2.5f;
constexpr float LOG2E_ = 1.4426950408889634f;

__device__ __forceinline__ int mk_lane_now() { int l; asm volatile("v_mbcnt_lo_u32_b32 %0, -1, 0\n\tv_mbcnt_hi_u32_b32 %0, -1, %0" : "=v"(l)); return l; }
namespace pg8 {
#define PG8_LAS __attribute__((address_space(3)))
typedef unsigned short bf16_t;
typedef short bf16x8 __attribute__((ext_vector_type(8)));
typedef float f32x4 __attribute__((ext_vector_type(4)));
typedef unsigned u32x4 __attribute__((ext_vector_type(4)));
constexpr int BM = 256, BK = 64, HALF = 128, HTB = HALF * BK * 2  , STAGE_BYTES = 8 * HTB, NXCD = 8, WGM = 8;

__host__ __device__ __forceinline__ int lds_byte(int r, int c) { const int st = (r >> 4) * 2 + (c >> 5), rr = r & 15, cc = c & 31, ob = rr * 64 + cc * 2; return st * 1024 + (ob ^ (((ob >> 9) & 1) << 5)); }
__host__ __device__ __forceinline__ void stage_rc(int b, int& R, int& C) { const int st = b / 1024, sb = b % 1024, swz = sb ^ (((sb >> 9) & 1) << 5); R = (st >> 1) * 16 + swz / 64; C = (st & 1) * 32 + (swz % 64) / 2; }
__host__ __device__ __forceinline__ int perm32(int rho) { const int n = rho >> 4, i = rho & 15; return 8 * (i >> 2) + 4 * n + (i & 3); }

struct UnitS { int pm, pn; };
struct UnitM { int pm, pn, e, rt, nrows, slot; };
struct Gemm { const bf16_t* A; const bf16_t* Bt; };

struct StaticOrder {
    typedef UnitS Unit;
    int nM, nN, nwg, G, c;
    __host__ __device__ void init(int M, int N, int G_, int c_) { nM = M / BM; nN = N / BM; nwg = nM * nN; G = G_; c = c_; }
    __host__ __device__ bool next(int i, Unit& u) const {
        const long L = (long)i * G + c; if (L >= nwg) return false;
        int wgid = (int)L; { const int q = nwg / NXCD, r = nwg % NXCD, xcd = wgid % NXCD, off = wgid / NXCD; wgid = (xcd < r ? xcd * (q + 1) : r * (q + 1) + (xcd - r) * q) + off; }
        const int nig = WGM * nN, gid = wgid / nig, fm = gid * WGM, gsz = (nM - fm) < WGM ? (nM - fm) : WGM;
        u.pm = fm + ((wgid % nig) % gsz); u.pn = (wgid % nig) / gsz; return true;
    }
    __device__ __forceinline__ size_t a_off(const Unit& u, size_t tstep) const { return (size_t)u.pm * tstep; }
    __device__ __forceinline__ size_t b_off(const Unit& u, size_t tstep) const { return (size_t)u.pn * tstep; }
    __device__ __forceinline__ unsigned row_off(const Unit&, int, int) const { return 0u; }
    __device__ __forceinline__ void a_ready(const Unit&) const {}
    __device__ __forceinline__ void done(const Unit&) const {}
};
template <int BTILES, bool A_DENSE, unsigned ROWBYTES>
struct MoeOrder {
    typedef UnitM Unit;
    const PG8_LAS int* UT; const PG8_LAS int* TOK; int nunits;
    __device__ __forceinline__ bool next(int i, Unit& u) const {
        if (i >= nunits) return false;
        u.e = __builtin_amdgcn_readfirstlane(UT[i * 8 + 0]); u.rt = __builtin_amdgcn_readfirstlane(UT[i * 8 + 1]); u.pn = __builtin_amdgcn_readfirstlane(UT[i * 8 + 2]);
        u.nrows = __builtin_amdgcn_readfirstlane(UT[i * 8 + 3]); u.pm = __builtin_amdgcn_readfirstlane(UT[i * 8 + 4]); u.slot = i; return true;
    }
    __device__ __forceinline__ size_t a_off(const Unit& u, size_t tstep) const { return A_DENSE ? (size_t)u.pm * tstep : (size_t)0; }
    __device__ __forceinline__ size_t b_off(const Unit& u, size_t tstep) const { return (size_t)(u.e * BTILES + u.pn) * tstep; }
    __device__ __forceinline__ unsigned row_off(const Unit& u, int row, int C) const { return (unsigned)TOK[u.slot * 256 + row] * ROWBYTES + (unsigned)C * 2u; }
    __device__ __forceinline__ void a_ready(const Unit&) const {}
    __device__ __forceinline__ void done(const Unit&) const {}
};

typedef float f32x2_t_ __attribute__((ext_vector_type(2))); typedef __bf16 bf16x2_t_ __attribute__((ext_vector_type(2)));
__device__ __forceinline__ unsigned cvt_pk_bf16(float lo, float hi) { const f32x2_t_ v = {lo, hi}; const bf16x2_t_ b = __builtin_convertvector(v, bf16x2_t_); return __builtin_bit_cast(unsigned, b); }
__device__ __forceinline__ float bf_lo(unsigned w) { return __uint_as_float(w << 16); }
__device__ __forceinline__ float bf_hi(unsigned w) { return __uint_as_float(w & 0xffff0000u); }
__device__ __forceinline__ float sigm(float x) { return __builtin_amdgcn_rcpf(1.0f + __builtin_amdgcn_exp2f(-x * LOG2E_)); }
__device__ __forceinline__ u32x4 pack8(const f32x4& a, const f32x4& b) { u32x4 w; w.x = cvt_pk_bf16(a[0], a[1]); w.y = cvt_pk_bf16(a[2], a[3]); w.z = cvt_pk_bf16(b[0], b[1]); w.w = cvt_pk_bf16(b[2], b[3]); return w; }
__device__ __forceinline__ void unpack8(const u32x4& w, f32x4& a, f32x4& b) { a = (f32x4){bf_lo(w.x), bf_hi(w.x), bf_lo(w.y), bf_hi(w.y)}; b = (f32x4){bf_lo(w.z), bf_hi(w.z), bf_lo(w.w), bf_hi(w.w)}; }
__device__ __forceinline__ f32x4 sigm4(const f32x4& v) { return (f32x4){sigm(v[0]), sigm(v[1]), sigm(v[2]), sigm(v[3])}; }

#define PG8_EPI_ARGS const f32x4 (&acc)[2][2][4][2], const U& u, int wr, int wc, int fr, int fq
struct EpiInproj {
    static constexpr bool PERM = true, AFTER_DRAIN = false;
    bf16_t *q; size_t slot; bf16_t *ug, *sga, *sgb; const float* biasP; float qscale;
    template <class U> __device__ __forceinline__ void operator()(PG8_EPI_ARGS) const {
        const int pn = u.pn, row0 = u.pm * BM + wr * 64 + fr, cb = wc * 32 + 8 * fq;
        f32x4 bv[2][2];
#pragma unroll
        for (int bj = 0; bj < 2; ++bj)
#pragma unroll
            for (int n = 0; n < 2; ++n) bv[bj][n] = *(const f32x4*)(biasP + pn * BM + bj * HALF + cb + 4 * n);
        if (pn < 12) {
            bf16_t* base = q + (size_t)(pn >> 2) * slot; float sc = 1.0f; if (pn < 4) sc = qscale; const int colt = (pn & 3) * BM + cb;
#pragma unroll
            for (int ai = 0; ai < 2; ++ai)
#pragma unroll
                for (int m = 0; m < 4; ++m) { bf16_t* rowp = base + (size_t)(row0 + ai * HALF + m * 16) * D_ + colt;
#pragma unroll
                    for (int bj = 0; bj < 2; ++bj) { const f32x4 v0 = (acc[ai][bj][m][0] + bv[bj][0]) * sc, v1 = (acc[ai][bj][m][1] + bv[bj][1]) * sc; *(u32x4*)(rowp + bj * HALF) = pack8(v0, v1); } }
        } else if (pn < 20) {
            const int colt = (pn - 12) * HALF + cb;
#pragma unroll
            for (int ai = 0; ai < 2; ++ai)
#pragma unroll
                for (int m = 0; m < 4; ++m) { const size_t off = (size_t)(row0 + ai * HALF + m * 16) * D_ + colt;
                    const f32x4 a0 = acc[ai][0][m][0] + bv[0][0], a1 = acc[ai][0][m][1] + bv[0][1], b0 = sigm4(acc[ai][1][m][0] + bv[1][0]), b1 = sigm4(acc[ai][1][m][1] + bv[1][1]);
                    *(u32x4*)(ug + off) = pack8(a0 * b0, a1 * b1); }
        } else {
            const int colt = (pn - 20) * HALF + cb;
#pragma unroll
            for (int ai = 0; ai < 2; ++ai)
#pragma unroll
                for (int m = 0; m < 4; ++m) { const size_t off = (size_t)(row0 + ai * HALF + m * 16) * D_ + colt;
                    *(u32x4*)(sga + off) = pack8(sigm4(acc[ai][0][m][0] + bv[0][0]), sigm4(acc[ai][0][m][1] + bv[0][1]));
                    *(u32x4*)(sgb + off) = pack8(sigm4(acc[ai][1][m][0] + bv[1][0]), sigm4(acc[ai][1][m][1] + bv[1][1]));
                    }
        }
    }
};
struct EpiYa {
    static constexpr bool PERM = true, AFTER_DRAIN = false;
    const bf16_t* sga; bf16_t* ya;
    template <class U> __device__ __forceinline__ void operator()(PG8_EPI_ARGS) const {
        const int row0 = u.pm * BM + wr * 64 + fr, col0 = u.pn * BM + wc * 32 + 8 * fq;
#pragma unroll
        for (int ai = 0; ai < 2; ++ai)
#pragma unroll
            for (int m = 0; m < 4; ++m)
#pragma unroll
                for (int bj = 0; bj < 2; ++bj) { const size_t off = (size_t)(row0 + ai * HALF + m * 16) * D_ + col0 + bj * HALF;
                    f32x4 g0, g1; unpack8(*(const u32x4*)(sga + off), g0, g1);
                    *(u32x4*)(ya + off) = pack8(acc[ai][bj][m][0] * g0, acc[ai][bj][m][1] * g1); }
    }
};
struct EpiM {
    static constexpr bool PERM = true, AFTER_DRAIN = false;
    const bf16_t* sgb; const bf16_t* ya; bf16_t* mo; const float* bp;
    template <class U> __device__ __forceinline__ void operator()(PG8_EPI_ARGS) const {
        const int row0 = u.pm * BM + wr * 64 + fr, col0 = u.pn * BM + wc * 32 + 8 * fq;
#pragma unroll
        for (int bj = 0; bj < 2; ++bj) { const f32x4 b0 = *(const f32x4*)(bp + col0 + bj * HALF), b1 = *(const f32x4*)(bp + col0 + bj * HALF + 4);
#pragma unroll
            for (int ai = 0; ai < 2; ++ai)
#pragma unroll
                for (int m = 0; m < 4; ++m) { const size_t off = (size_t)(row0 + ai * HALF + m * 16) * D_ + col0 + bj * HALF;
                    f32x4 g0, g1, y0, y1; unpack8(*(const u32x4*)(sgb + off), g0, g1); unpack8(*(const u32x4*)(ya + off), y0, y1);
                    *(u32x4*)(mo + off) = pack8(y0 + g0 * (acc[ai][bj][m][0] + b0), y1 + g1 * (acc[ai][bj][m][1] + b1)); } }
    }
};
struct EpiZ {
    static constexpr bool PERM = true, AFTER_DRAIN = false;
    const float* x; const float* mod; float* z;
    template <class U> __device__ __forceinline__ void operator()(PG8_EPI_ARGS) const {
        const int row0 = u.pm * BM + wr * 64 + fr, col0 = u.pn * BM + wc * 32 + 8 * fq; const int b = (u.pm * BM) >> 12;
#pragma unroll
        for (int bj = 0; bj < 2; ++bj) { const float* gp = mod + b * 6144 + 2048 + col0 + bj * HALF; const f32x4 g0 = *(const f32x4*)gp, g1 = *(const f32x4*)(gp + 4);
#pragma unroll
            for (int ai = 0; ai < 2; ++ai)
#pragma unroll
                for (int m = 0; m < 4; ++m) { const size_t off = (size_t)(row0 + ai * HALF + m * 16) * D_ + col0 + bj * HALF;
                    const f32x4 x0 = *(const f32x4*)(x + off), x1 = *(const f32x4*)(x + off + 4);
                    *(f32x4*)(z + off) = x0 * DN_ALPHA_ + g0 * acc[ai][bj][m][0]; *(f32x4*)(z + off + 4) = x1 * DN_ALPHA_ + g1 * acc[ai][bj][m][1]; } }
    }
};
struct EpiLogit {
    static constexpr bool PERM = true, AFTER_DRAIN = false;
    float* lg;
    template <class U> __device__ __forceinline__ void operator()(PG8_EPI_ARGS) const {
        const int row0 = u.pm * BM + wr * 64 + fr, col0 = wc * 32 + 8 * fq;
#pragma unroll
        for (int ai = 0; ai < 2; ++ai)
#pragma unroll
            for (int m = 0; m < 4; ++m)
#pragma unroll
                for (int bj = 0; bj < 2; ++bj) { float* p = lg + (size_t)(row0 + ai * HALF + m * 16) * NE_ + col0 + bj * HALF; *(f32x4*)p = acc[ai][bj][m][0]; *(f32x4*)(p + 4) = acc[ai][bj][m][1]; }
    }
};
struct EpiSwiglu {
    static constexpr bool PERM = true, AFTER_DRAIN = false;
    bf16_t* hid;
    template <class U> __device__ __forceinline__ void operator()(PG8_EPI_ARGS) const {
        const int row0 = u.pm * BM + wr * 64 + fr, col0 = u.pn * HALF + wc * 32 + 8 * fq;
#pragma unroll
        for (int ai = 0; ai < 2; ++ai)
#pragma unroll
            for (int m = 0; m < 4; ++m) { const size_t off = (size_t)(row0 + ai * HALF + m * 16) * FE_ + col0;
                const f32x4 a0 = acc[ai][0][m][0], a1 = acc[ai][0][m][1];
                *(u32x4*)(hid + off) = pack8(a0 * sigm4(a0) * acc[ai][1][m][0], a1 * sigm4(a1) * acc[ai][1][m][1]); }
    }
};
struct EpiDown {
    static constexpr bool PERM = true, AFTER_DRAIN = false;
    const int* list; const float* gate; bf16_t* yslot; float* xb; const float* mod;
    template <class U> __device__ __forceinline__ void operator()(PG8_EPI_ARGS) const {
        const int rl0 = wr * 64 + fr, col0 = u.pn * BM + wc * 32 + 8 * fq;
        if (u.e < NE_) {
            const int* lp = list + (size_t)u.e * T_ + u.rt * BM;
#pragma unroll
            for (int ai = 0; ai < 2; ++ai)
#pragma unroll
                for (int m = 0; m < 4; ++m) { const int rl = rl0 + ai * HALF + m * 16;
                    if (rl < u.nrows) { const int a = lp[rl]; const float g = gate[a]; bf16_t* rowp = yslot + (size_t)a * D_ + col0;
#pragma unroll
                        for (int bj = 0; bj < 2; ++bj) *(u32x4*)(rowp + bj * HALF) = pack8(acc[ai][bj][m][0] * g, acc[ai][bj][m][1] * g); } }
        } else {
            const int t0 = u.rt * BM, b = t0 >> 12;
#pragma unroll
            for (int bj = 0; bj < 2; ++bj) { const float* gp = mod + b * 6144 + 5120 + col0 + bj * HALF; const f32x4 g0 = *(const f32x4*)gp, g1 = *(const f32x4*)(gp + 4);
#pragma unroll
                for (int ai = 0; ai < 2; ++ai)
#pragma unroll
                    for (int m = 0; m < 4; ++m) { float* p = xb + (size_t)(t0 + rl0 + ai * HALF + m * 16) * D_ + col0 + bj * HALF;
                        const f32x4 x0 = *(const f32x4*)p, x1 = *(const f32x4*)(p + 4);
                        *(f32x4*)p = x0 * DN_ALPHA_ + g0 * acc[ai][bj][m][0]; *(f32x4*)(p + 4) = x1 * DN_ALPHA_ + g1 * acc[ai][bj][m][1]; } }
        }
    }
};

template <int K, class Epi, class Sched, bool ALIGN_EPI = false, bool SP2 = false, bool GATHER = false>
__device__ __forceinline__ void gemm_phase(PG8_LAS unsigned char* lds, const Gemm g, const Sched& S, const Epi& E, const int wid) {
    const int lane = mk_lane_now(), tid = wid * 64 + lane, wr = wid >> 2, wc = wid & 3, fr = lane & 15, fq = lane >> 4;
    typedef typename Sched::Unit Unit;
    constexpr int nt = K / BK;
    unsigned voffA[2], voffB[2]; int RA[2], CA[2];
#pragma unroll
    for (int i = 0; i < 2; ++i) { int R, C; stage_rc(tid * 16 + i * 8192, R, C); const int Rb = Epi::PERM ? ((R & ~31) + perm32(R & 31)) : R;
        voffA[i] = (unsigned)(R * K + C) * 2u; voffB[i] = (unsigned)(Rb * K + C) * 2u; RA[i] = R; CA[i] = C; }
    constexpr size_t kstep = (size_t)(BK * 2);
    constexpr size_t hstep = (size_t)HALF * K * 2;
    constexpr size_t tstep = 2 * hstep;
    const unsigned ldsw = (unsigned)wid * 1024u;
    const int aoff = lds_byte(wr * 64 + fr, fq * 8), boff = lds_byte(wc * 32 + fr, fq * 8);
#define PG8_SA(b, h) (((b) * 2 + (h)) * HTB)
#define PG8_SB(b, h) ((4 + (b) * 2 + (h)) * HTB)
#define PG8_STAGE(bufoff, gbase, voff) do { _Pragma("unroll") for (int _i = 0; _i < 2; ++_i) \
        __builtin_amdgcn_global_load_lds((const unsigned*)((const char*)(gbase) + (voff)[_i]), (PG8_LAS unsigned*)(lds + (bufoff) + ldsw + _i * 8192), 16, 0, 0); } while (0)
#define PG8_STAGE_A(bufoff, base, h, nx) do { if constexpr (GATHER) { const unsigned _v[2] = {(nx) ? gn[h][0] : gc[h][0], (nx) ? gn[h][1] : gc[h][1]}; PG8_STAGE(bufoff, base, _v); } \
        else { PG8_STAGE(bufoff, (base) + (h) * hstep, voffA); } } while (0)
#define PG8_LDA(dst, b, h) do { _Pragma("unroll") for (int m = 0; m < 4; ++m) _Pragma("unroll") for (int k = 0; k < 2; ++k) dst[m][k] = *(const PG8_LAS bf16x8*)(lds + PG8_SA(b, h) + aoff + m * 2048 + k * 1024); } while (0)
#define PG8_LDB(dst, b, h) do { _Pragma("unroll") for (int n = 0; n < 2; ++n) _Pragma("unroll") for (int k = 0; k < 2; ++k) dst[n][k] = *(const PG8_LAS bf16x8*)(lds + PG8_SB(b, h) + boff + n * 2048 + k * 1024); } while (0)
#define PG8_MMA(ai, bj, At, Bt) do { __builtin_amdgcn_s_setprio(1); _Pragma("unroll") for (int m = 0; m < 4; ++m) _Pragma("unroll") for (int n = 0; n < 2; ++n) _Pragma("unroll") for (int k = 0; k < 2; ++k) \
        acc[ai][bj][m][n] = __builtin_amdgcn_mfma_f32_16x16x32_bf16(Bt[n][k], At[m][k], acc[ai][bj][m][n], 0, 0, 0); __builtin_amdgcn_s_setprio(0); } while (0)
#define PG8_WAIT_V(n) asm volatile("s_waitcnt vmcnt(" #n ")" ::: "memory")
#define PG8_WAIT_L(n) asm volatile("s_waitcnt lgkmcnt(" #n ")" ::: "memory")
#define PG8_BAR __builtin_amdgcn_s_barrier()
#define PG8_SCHED __builtin_amdgcn_sched_barrier(0)
    Unit cur, nxt; int ui = 0;
    if (!S.next(0, cur)) return;
    f32x4 acc[2][2][4][2];
#pragma unroll
    for (int a = 0; a < 2; ++a)
#pragma unroll
        for (int b = 0; b < 2; ++b)
#pragma unroll
            for (int m = 0; m < 4; ++m)
#pragma unroll
                for (int n = 0; n < 2; ++n) acc[a][b][m][n] = (f32x4){0.f, 0.f, 0.f, 0.f};
    bf16x8 At[4][2], B0[2][2], B1[2][2];
    unsigned gc[2][2] = {{0u, 0u}, {0u, 0u}}, gn[2][2] = {{0u, 0u}, {0u, 0u}};
    if constexpr (GATHER) {
#pragma unroll
        for (int h = 0; h < 2; ++h)
#pragma unroll
            for (int i = 0; i < 2; ++i) gc[h][i] = S.row_off(cur, h * HALF + RA[i], CA[i]);
    }
    const char* cA = (const char*)g.A + S.a_off(cur, tstep); const char* cB = (const char*)g.Bt + S.b_off(cur, tstep);
    S.a_ready(cur);
    if constexpr (SP2) {
        PG8_STAGE(PG8_SB(0, 0), cB, voffB); PG8_STAGE(PG8_SB(0, 1), cB + hstep, voffB); PG8_STAGE_A(PG8_SA(0, 0), cA, 0, false); PG8_STAGE_A(PG8_SA(0, 1), cA, 1, false);
        if (wr == 1) PG8_BAR;
        PG8_WAIT_V(2); PG8_BAR;
        PG8_STAGE(PG8_SB(1, 0), cB + kstep, voffB); PG8_STAGE_A(PG8_SA(1, 0), cA + kstep, 0, false); PG8_STAGE(PG8_SB(1, 1), cB + hstep + kstep, voffB);
        PG8_WAIT_V(6); PG8_BAR;
    } else {
        PG8_STAGE(PG8_SB(0, 0), cB, voffB); PG8_STAGE_A(PG8_SA(0, 0), cA, 0, false); PG8_STAGE(PG8_SB(0, 1), cB + hstep, voffB); PG8_STAGE_A(PG8_SA(0, 1), cA, 1, false);
        if (wr == 1) PG8_BAR;
        PG8_WAIT_V(4); PG8_BAR;
        PG8_STAGE(PG8_SB(1, 0), cB + kstep, voffB); PG8_STAGE_A(PG8_SA(1, 0), cA + kstep, 0, false); PG8_STAGE(PG8_SB(1, 1), cB + hstep + kstep, voffB);
        PG8_WAIT_V(6); PG8_BAR;
    }
    for (;;) {
        const bool has_next = S.next(ui + 1, nxt);
        const char* nA = has_next ? (const char*)g.A + S.a_off(nxt, tstep) : cA; const char* nB = has_next ? (const char*)g.Bt + S.b_off(nxt, tstep) : cB;
        if constexpr (GATHER) {
#pragma unroll
            for (int h = 0; h < 2; ++h)
#pragma unroll
                for (int i = 0; i < 2; ++i) gn[h][i] = has_next ? S.row_off(nxt, h * HALF + RA[i], CA[i]) : gc[h][i];
        }
        for (int t = 0; t < nt; t += 2) {
            const bool last = (t == nt - 2);
            const char* a1 = cA + (size_t)(t + 1) * kstep;
            const char* a2 = last ? nA : cA + (size_t)(t + 2) * kstep; const char* b2 = last ? nB : cB + (size_t)(t + 2) * kstep;
            const char* a3 = a2 + kstep; const char* b3 = b2 + kstep;
            if (last && has_next) S.a_ready(nxt);
            if constexpr (SP2) {
            PG8_LDB(B0, 0, 0); PG8_LDB(B1, 0, 1); PG8_SCHED; PG8_LDA(At, 0, 0); PG8_STAGE_A(PG8_SA(1, 1), a1, 1, false);
            PG8_WAIT_V(8); PG8_WAIT_L(0); PG8_BAR; PG8_MMA(0, 0, At, B0); PG8_MMA(0, 1, At, B1); PG8_BAR; PG8_SCHED;
            PG8_LDA(At, 0, 1); PG8_STAGE(PG8_SB(0, 0), b2, voffB); PG8_STAGE(PG8_SB(0, 1), b2 + hstep, voffB); PG8_STAGE_A(PG8_SA(0, 0), a2, 0, last);
            PG8_WAIT_V(8); PG8_WAIT_L(0); PG8_BAR; PG8_MMA(1, 0, At, B0); PG8_MMA(1, 1, At, B1); PG8_BAR; PG8_SCHED;
            PG8_LDB(B0, 1, 0); PG8_LDB(B1, 1, 1); PG8_SCHED; PG8_LDA(At, 1, 0); PG8_STAGE_A(PG8_SA(0, 1), a2, 1, last);
            PG8_WAIT_V(8); PG8_WAIT_L(0); PG8_BAR; PG8_MMA(0, 0, At, B0); PG8_MMA(0, 1, At, B1); PG8_BAR; PG8_SCHED;
            PG8_LDA(At, 1, 1); PG8_STAGE(PG8_SB(1, 0), b3, voffB); PG8_STAGE(PG8_SB(1, 1), b3 + hstep, voffB); PG8_STAGE_A(PG8_SA(1, 0), a3, 0, last);
            PG8_WAIT_V(8); PG8_WAIT_L(0); PG8_BAR; PG8_MMA(1, 0, At, B0); PG8_MMA(1, 1, At, B1); PG8_BAR; PG8_SCHED;
            } else {
            PG8_LDB(B0, 0, 0); PG8_SCHED; PG8_LDA(At, 0, 0); PG8_STAGE_A(PG8_SA(1, 1), a1, 1, false);
            PG8_WAIT_L(8); PG8_BAR; PG8_WAIT_L(0); PG8_MMA(0, 0, At, B0); PG8_BAR; PG8_SCHED;
            PG8_LDB(B1, 0, 1); PG8_STAGE(PG8_SB(0, 0), b2, voffB);
            PG8_BAR; PG8_WAIT_L(0); PG8_MMA(0, 1, At, B1); PG8_BAR;
            PG8_LDA(At, 0, 1); PG8_STAGE_A(PG8_SA(0, 0), a2, 0, last);
            PG8_BAR; PG8_WAIT_L(0); PG8_MMA(1, 0, At, B0); PG8_BAR; PG8_SCHED;
            PG8_STAGE(PG8_SB(0, 1), b2 + hstep, voffB);
            PG8_WAIT_V(6); PG8_BAR; PG8_MMA(1, 1, At, B1); PG8_BAR;
            PG8_LDB(B0, 1, 0); PG8_SCHED; PG8_LDA(At, 1, 0); PG8_STAGE_A(PG8_SA(0, 1), a2, 1, last);
            PG8_WAIT_L(8); PG8_BAR; PG8_WAIT_L(0); PG8_MMA(0, 0, At, B0); PG8_BAR; PG8_SCHED;
            PG8_LDB(B1, 1, 1); PG8_STAGE(PG8_SB(1, 0), b3, voffB);
            PG8_BAR; PG8_WAIT_L(0); PG8_MMA(0, 1, At, B1); PG8_BAR;
            PG8_LDA(At, 1, 1); PG8_STAGE_A(PG8_SA(1, 0), a3, 0, last);
            PG8_BAR; PG8_WAIT_L(0); PG8_MMA(1, 0, At, B0); PG8_BAR; PG8_SCHED;
            PG8_STAGE(PG8_SB(1, 1), b3 + hstep, voffB);
            PG8_WAIT_V(6); PG8_BAR; PG8_MMA(1, 1, At, B1); PG8_BAR;
            }
        }
        if constexpr (ALIGN_EPI) { if (wr == 0) PG8_BAR; }
        if constexpr (!Epi::AFTER_DRAIN) { E(acc, cur, wr, wc, fr, fq); S.done(cur); }
        if (!has_next) break;
#pragma unroll
        for (int a = 0; a < 2; ++a)
#pragma unroll
            for (int b = 0; b < 2; ++b)
#pragma unroll
                for (int m = 0; m < 4; ++m)
#pragma unroll
                    for (int n = 0; n < 2; ++n) acc[a][b][m][n] = (f32x4){0.f, 0.f, 0.f, 0.f};
        cur = nxt; cA = nA; cB = nB; ++ui;
        if constexpr (GATHER) {
#pragma unroll
            for (int h = 0; h < 2; ++h)
#pragma unroll
                for (int i = 0; i < 2; ++i) gc[h][i] = gn[h][i];
        }
        if constexpr (ALIGN_EPI) { if (wr == 1) PG8_BAR; }
    }
    PG8_WAIT_V(0);
    if constexpr (!ALIGN_EPI) { if (wr == 0) PG8_BAR; }
    PG8_BAR;
#undef PG8_SA
#undef PG8_SB
#undef PG8_STAGE
#undef PG8_STAGE_A
#undef PG8_LDA
#undef PG8_LDB
#undef PG8_MMA
#undef PG8_WAIT_V
#undef PG8_WAIT_L
#undef PG8_BAR
#undef PG8_SCHED
}
}
#define PG8_SP2 true
#define PG8_ALIGN true
#include <hip/hip_bf16.h>
#include <cmath>
namespace attn_body {
using bf16=__hip_bfloat16;
using bf16x8=__attribute__((ext_vector_type(8)))short;
using s16x4=__attribute__((ext_vector_type(4)))short;
using f32x16=__attribute__((ext_vector_type(16)))float;
using u32x4=__attribute__((ext_vector_type(4)))unsigned;
constexpr int BATCH=8,NHEAD=16,SEQ=4096,D=64,DM=1024,OP=2048;
constexpr int NW=8,QBLK=32,QB=QBLK*NW,KVBLK=64,NQB=SEQ/QB;
constexpr int ATTN_PITCH=DM, ATTN_UNIT_ROWS=QB;
__device__ __forceinline__ int crow(int r,int hi){return (r&3)+8*(r>>2)+4*hi;}
#define SBAR() __builtin_amdgcn_sched_barrier(0)
__device__ __forceinline__ void cmask(f32x16&p0,f32x16&p1,int jb,int qrel,int hi){
  const float NEG=-INFINITY; int kb=64*jb+4*hi;
  #pragma unroll
  for(int r=0;r<16;++r){int kv=kb+(r&3)+8*(r>>2); if(kv>qrel)p0[r]=NEG; if(kv+32>qrel)p1[r]=NEG;}
}

constexpr int NSLOT=3, SLOTB=8192;
constexpr int LDS_K=0, LDS_V=NSLOT*SLOTB, LDS_WS=2*NSLOT*SLOTB, LDS_OST=LDS_WS+NW*64*4, LDS_BYTES=LDS_OST+NW*4096;
constexpr float C2=0.125f*1.4426950408889634f;
__device__ __forceinline__ void glds16(const void*gsrc,unsigned lds_dst){unsigned keep;
  asm volatile("s_mov_b32 %0, m0\n\ts_mov_b32 m0, %2\n\ts_nop 0\n\tglobal_load_lds_dwordx4 %1, off\n\ts_mov_b32 m0, %0":"=&s"(keep):"v"(gsrc),"s"(lds_dst):"memory");}
__device__ __forceinline__ float max3f(float a,float b,float c){float r;asm("v_max3_f32 %0, %1, %2, %3":"=v"(r):"v"(a),"v"(b),"v"(c));return r;}
__device__ __forceinline__ float max2f(float a,float b){float r;asm("v_max_f32_e32 %0, %1, %2":"=v"(r):"v"(a),"v"(b));return r;}
__device__ __forceinline__ float fadd_s(float a,float b){float r;asm("v_add_f32_e32 %0, %1, %2":"=v"(r):"v"(a),"v"(b));return r;}
__device__ __forceinline__ float fsub_s(float a,float b){float r;asm("v_sub_f32_e32 %0, %1, %2":"=v"(r):"v"(a),"v"(b));return r;}
typedef float f32x2_t __attribute__((ext_vector_type(2))); typedef __bf16 bf16x2_t __attribute__((ext_vector_type(2)));
__device__ __forceinline__ unsigned cvtpk_s(float lo,float hi){f32x2_t v={lo,hi};bf16x2_t b=__builtin_convertvector(v,bf16x2_t);return __builtin_bit_cast(unsigned,b);}
#define WAIT_BAR(N) asm volatile("s_waitcnt vmcnt(" #N ") lgkmcnt(0)\n\ts_barrier":::"memory")

__device__ __forceinline__ void qkt(f32x16&p0,f32x16&p1,const char*Kslot,const bf16x8*qr,const f32x16&negm,int r32,int hi){
  const char*kb=Kslot+hi*1024+r32*16;
  #pragma unroll
  for(int d0=0;d0<4;++d0){
    const bf16x8 b0=*reinterpret_cast<const bf16x8*>(kb+d0*2048);
    const bf16x8 b1=*reinterpret_cast<const bf16x8*>(kb+d0*2048+512);
    if(d0==0){p0=__builtin_amdgcn_mfma_f32_32x32x16_bf16(b0,qr[0],negm,0,0,0);p1=__builtin_amdgcn_mfma_f32_32x32x16_bf16(b1,qr[0],negm,0,0,0);}
    else{p0=__builtin_amdgcn_mfma_f32_32x32x16_bf16(b0,qr[d0],p0,0,0,0);p1=__builtin_amdgcn_mfma_f32_32x32x16_bf16(b1,qr[d0],p1,0,0,0);}}
}
typedef __attribute__((address_space(3))) const char* lds_cptr;
typedef short v4i16_t __attribute__((ext_vector_type(4)));
__device__ __forceinline__ void kload8(bf16x8*kf,lds_cptr kp){
  kf[0]=*(const __attribute__((address_space(3))) bf16x8*)(kp);      kf[1]=*(const __attribute__((address_space(3))) bf16x8*)(kp+512);
  kf[2]=*(const __attribute__((address_space(3))) bf16x8*)(kp+2048); kf[3]=*(const __attribute__((address_space(3))) bf16x8*)(kp+2560);
  kf[4]=*(const __attribute__((address_space(3))) bf16x8*)(kp+4096); kf[5]=*(const __attribute__((address_space(3))) bf16x8*)(kp+4608);
  kf[6]=*(const __attribute__((address_space(3))) bf16x8*)(kp+6144); kf[7]=*(const __attribute__((address_space(3))) bf16x8*)(kp+6656);
}
__device__ __forceinline__ void kload2(bf16x8*kf,lds_cptr kp,int j){ kf[2*j]=*(const __attribute__((address_space(3))) bf16x8*)(kp+j*2048); kf[2*j+1]=*(const __attribute__((address_space(3))) bf16x8*)(kp+j*2048+512); }
__device__ __forceinline__ s16x4 vtr(lds_cptr p){ return __builtin_bit_cast(s16x4,__builtin_amdgcn_ds_read_tr16_b64_v4i16((__attribute__((address_space(3))) v4i16_t*)p)); }
__device__ __forceinline__ float rowmax(const f32x16&p0,const f32x16&p1){
  float a=max3f(p0[0],p0[1],p1[0]),b=max3f(p0[2],p0[3],p1[1]);a=max3f(a,p1[2],p1[3]);
  #pragma unroll
  for(int r=4;r<16;r+=4){a=max3f(a,p0[r],p0[r+1]);b=max3f(b,p0[r+2],p0[r+3]);a=max3f(a,p1[r],p1[r+1]);b=max3f(b,p1[r+2],p1[r+3]);}
  const float m=max2f(a,b);
  auto rr=__builtin_amdgcn_permlane32_swap(__float_as_uint(m),__float_as_uint(m),false,false);
  return max2f(__uint_as_float(rr[0]),__uint_as_float(rr[1]));
}
__device__ __forceinline__ void pv(f32x16*o,int vb,bf16x8 pa0,bf16x8 pa1,bf16x8 pa2,bf16x8 pa3){
  #pragma unroll
  for(int d0=0;d0<2;++d0){s16x4 lo[4],hi[4];
    #pragma unroll
    for(int ks=0;ks<4;++ks){
      asm volatile("ds_read_b64_tr_b16 %0,%1 offset:%c2":"=&v"(lo[ks]):"v"(vb),"i"(d0*4096+ks*1024):"memory");
      asm volatile("ds_read_b64_tr_b16 %0,%1 offset:%c2":"=&v"(hi[ks]):"v"(vb),"i"(d0*4096+ks*1024+512):"memory");}
    asm volatile("s_waitcnt lgkmcnt(0)":::"memory");SBAR();
    #define PK(k) (bf16x8){lo[k][0],lo[k][1],lo[k][2],lo[k][3],hi[k][0],hi[k][1],hi[k][2],hi[k][3]}
    o[d0]=__builtin_amdgcn_mfma_f32_32x32x16_bf16(pa0,PK(0),o[d0],0,0,0);
    o[d0]=__builtin_amdgcn_mfma_f32_32x32x16_bf16(pa1,PK(1),o[d0],0,0,0);
    o[d0]=__builtin_amdgcn_mfma_f32_32x32x16_bf16(pa2,PK(2),o[d0],0,0,0);
    o[d0]=__builtin_amdgcn_mfma_f32_32x32x16_bf16(pa3,PK(3),o[d0],0,0,0);
    #undef PK
  }
}

#ifndef ATTN_STORE16
#define ATTN_STORE16(p,v) (*(u32x4*)(p)=(v))
#endif
template<int THRL> __device__ __forceinline__ void attn_unit(const int wid,int b,int cq,int cv,int co,int qb,const bf16*Q,const bf16*__restrict__ K,const bf16*__restrict__ V,bf16*O,char*shm){
  const int lane=mk_lane_now(),r32=lane&31,hi=lane>>5;
  const long rowbase=(long)b*SEQ; const int q0=qb*QB;
  const bf16*Qw=Q+(rowbase+q0+wid*QBLK)*DM+cq;
  const bf16*Kh=K+rowbase*DM+cq,*Vh=V+rowbase*DM+cv;
  const unsigned lds0=(unsigned)(uintptr_t)shm;
  float*wsf=(float*)(shm+LDS_WS)+wid*64;
  const bf16*ksrc=Kh+(long)lane*DM+wid*8;
  const bf16*vsrc=Vh+(long)(16*(wid&3)+(lane>>2))*DM+(wid>>2)*32+(lane&3)*8;
  const unsigned kdst=lds0+LDS_K+wid*1024, vdst=lds0+LDS_V+wid*1024;
  #define DMA_K(t,slot) glds16(ksrc+(long)(t)*KVBLK*DM,(unsigned)__builtin_amdgcn_readfirstlane(kdst+(slot)))
  #define DMA_V(t,slot) glds16(vsrc+(long)(t)*KVBLK*DM,(unsigned)__builtin_amdgcn_readfirstlane(vdst+(slot)))
  const int vb0=(int)(lds0+LDS_V)+((lane>>4)&1)*32+(lane&3)*8+(4*hi+((lane&15)>>2))*64;
  const char*Kbase=shm+LDS_K; bf16x8 kf[8];
  const lds_cptr shm3=(lds_cptr)shm; const lds_cptr kp0=shm3+LDS_K+hi*1024+r32*16; const lds_cptr vp0=shm3+LDS_V+((lane>>4)&1)*32+(lane&3)*8+(4*hi+((lane&15)>>2))*64;
  const int NT=(q0+QB)/KVBLK;
  DMA_K(0,0);DMA_V(0,0);DMA_K(1,SLOTB);
  bf16x8 qr[4];
  #pragma unroll
  for(int d0=0;d0<4;++d0)qr[d0]=*reinterpret_cast<const bf16x8*>(&Qw[(long)r32*DM+d0*16+hi*8]);
  float zf_=0.f;asm volatile("":"+v"(zf_));f32x16 zv_;
  #pragma unroll
  for(int r=0;r<16;++r)zv_[r]=zf_;
  float mhat=0.f,l_reg=0.f;f32x16 o[2];o[0]=zv_;o[1]=zv_;f32x16 negm=zv_;asm volatile("":"+v"(negm));
  const int qrel=wid*QBLK+r32;
  #define CMASK(P0,P1,t) do{int jb_=(t)-(NT-4); if(jb_>=0)cmask(P0,P1,jb_,qrel,hi);}while(0)
  bool resc=false;
  #define START(P0,P1) do{ const float rm=rowmax(P0,P1); resc=false; \
    { const float dl=rm; mhat=fadd_s(mhat,dl); \
      _Pragma("unroll") for(int r=0;r<16;++r){P0[r]=fsub_s(P0[r],dl);P1[r]=fsub_s(P1[r],dl);} \
      _Pragma("unroll") for(int r=0;r<16;++r)negm[r]=-mhat; asm volatile("":"+v"(negm)); } \
    _Pragma("unroll") for(int r=0;r<16;++r)P0[r]=__builtin_amdgcn_exp2f(P0[r]); }while(0)
  #define RESC() do{ if(resc){ asm volatile("s_waitcnt lgkmcnt(0)":::"memory"); \
      _Pragma("unroll") for(int d_=0;d_<2;++d_) _Pragma("unroll") for(int r=0;r<16;++r)o[d_][r]*=wsf[crow(r,hi)]; } }while(0)
  f32x16 pA0,pA1,pB0,pB1;
  int sl_prev=0,sl_cur=0,sl_next=SLOTB;
  #define ROT() do{sl_prev=sl_cur;sl_cur=sl_next;sl_next=(sl_next==(NSLOT-1)*SLOTB)?0:sl_next+SLOTB;}while(0)
  DMA_K(2,2*SLOTB);
  WAIT_BAR(3);
  qkt(pA0,pA1,Kbase,qr,negm,r32,hi);asm volatile("s_nop 15\n\ts_nop 7":"+v"(pA0),"+v"(pA1));CMASK(pA0,pA1,0);
  START(pA0,pA1);
  _Pragma("unroll") for(int r=0;r<16;++r)pA1[r]=__builtin_amdgcn_exp2f(pA1[r]);
  WAIT_BAR(0);
  DMA_K(3,0);DMA_V(1,SLOTB);
  ROT();
  kload8(kf,kp0+sl_cur);
  WAIT_BAR(2);
  s16x4 vlo[8],vhi[8]; u32x4 pw0,pw1,pw2,pw3;
  #define PKW(P,B) cvtpk_s(P[B],P[B+1])
  #define PAF(k) __builtin_bit_cast(bf16x8,pw##k)
  #define VFR(i) (bf16x8){vlo[i][0],vlo[i][1],vlo[i][2],vlo[i][3],vhi[i][0],vhi[i][1],vhi[i][2],vhi[i][3]}
  #define PIN(x) asm volatile("":"+v"(x))
  #define MX3(a,b,c) __builtin_fmaxf(__builtin_fmaxf((a),(b)),(c))
  #define GAPA(MF,A0,A1,A2,A3,W0,W1,PW) do{ MF; sacc+=A0; sacc+=A1; sacc+=A2; sacc+=A3; PIN(sacc); W0; W1; PIN(PW); SBAR(); }while(0)
  #define EX(v) __builtin_amdgcn_exp2f(v)
  #define GAPB(MF,X,B) do{ MF; X[B]=EX(X[B]); X[B+1]=EX(X[B+1]); X[B+2]=EX(X[B+2]); X[B+3]=EX(X[B+3]); PIN(X); SBAR(); }while(0)
  #define VRD(i) do{ vlo[i]=vtr(vp_+(((i)>>2)*4096+((i)&3)*1024)); vhi[i]=vtr(vp_+(((i)>>2)*4096+((i)&3)*1024+512)); }while(0)
  #define KRD(G,j) do{ if(G){ kload2(kf,kp0+sl_next,j); SBAR(); } }while(0)
  #define STEP(C0,C1,P0,P1,t,GK,GV,GL) do{ SBAR(); \
    const lds_cptr vp_=vp0+sl_prev; \
    VRD(0); SBAR(); float sacc=(P0[0]+P0[1]); \
    GAPA(C0=__builtin_amdgcn_mfma_f32_32x32x16_bf16(kf[0],qr[0],negm,0,0,0), P0[2],P0[3],P0[4],P0[5],     pw0[0]=PKW(P0,0), pw0[1]=PKW(P0,2), pw0); \
    VRD(4); SBAR(); GAPA(C1=__builtin_amdgcn_mfma_f32_32x32x16_bf16(kf[1],qr[0],negm,0,0,0), P0[6],P0[7],P0[8],P0[9],     pw0[2]=PKW(P0,4), pw0[3]=PKW(P0,6), pw0); \
    VRD(1); SBAR(); GAPA(C0=__builtin_amdgcn_mfma_f32_32x32x16_bf16(kf[2],qr[1],C0,0,0,0),   P0[10],P0[11],P0[12],P0[13], pw1[0]=PKW(P0,8), pw1[1]=PKW(P0,10), pw1); \
    VRD(5); SBAR(); GAPA(C1=__builtin_amdgcn_mfma_f32_32x32x16_bf16(kf[3],qr[1],C1,0,0,0),   P0[14],P0[15],P1[0],P1[1],   pw1[2]=PKW(P0,12),pw1[3]=PKW(P0,14), pw1); \
    VRD(2); SBAR(); GAPA(C0=__builtin_amdgcn_mfma_f32_32x32x16_bf16(kf[4],qr[2],C0,0,0,0),   P1[2],P1[3],P1[4],P1[5],     pw2[0]=PKW(P1,0), pw2[1]=PKW(P1,2), pw2); \
    VRD(6); SBAR(); GAPA(C1=__builtin_amdgcn_mfma_f32_32x32x16_bf16(kf[5],qr[2],C1,0,0,0),   P1[6],P1[7],P1[8],P1[9],     pw2[2]=PKW(P1,4), pw2[3]=PKW(P1,6), pw2); \
    VRD(3); SBAR(); GAPA(C0=__builtin_amdgcn_mfma_f32_32x32x16_bf16(kf[6],qr[3],C0,0,0,0),   P1[10],P1[11],P1[12],P1[13], pw3[0]=PKW(P1,8), pw3[1]=PKW(P1,10), pw3); \
    VRD(7); SBAR(); GAPA(C1=__builtin_amdgcn_mfma_f32_32x32x16_bf16(kf[7],qr[3],C1,0,0,0),   P1[14],P1[15],0.f,0.f,       pw3[2]=PKW(P1,12),pw3[3]=PKW(P1,14), pw3); \
    l_reg+=sacc; \
    if(GK){DMA_K((t)+3,sl_cur);} if(GV){DMA_V((t)+1,sl_next);} \
    CMASK(C0,C1,t); \
    { float a=MX3(C0[0],C0[1],C1[0]),b=MX3(C0[2],C0[3],C1[1]); a=MX3(a,C1[2],C1[3]); \
      _Pragma("unroll") for(int r=4;r<16;r+=4){a=MX3(a,C0[r],C0[r+1]);b=MX3(b,C0[r+2],C0[r+3]);a=MX3(a,C1[r],C1[r+1]);b=MX3(b,C1[r+2],C1[r+3]);} \
      float rm=__builtin_fmaxf(a,b); { auto rr=__builtin_amdgcn_permlane32_swap(__float_as_uint(rm),__float_as_uint(rm),false,false); rm=__builtin_fmaxf(__uint_as_float(rr[0]),__uint_as_float(rr[1])); } \
      resc=false; \
      if(__builtin_expect(__any(rm>(float)THRL),0)){ const float dl=__builtin_fmaxf(rm,0.f); mhat+=dl; \
        _Pragma("unroll") for(int r=0;r<16;++r){C0[r]-=dl;C1[r]-=dl;} \
        _Pragma("unroll") for(int r=0;r<16;++r)negm[r]=-mhat; asm volatile("":"+v"(negm)); \
        const float f=__builtin_amdgcn_exp2f(-dl); l_reg*=f; if(hi==0)wsf[r32]=f; resc=true; } } \
    SBAR(); \
    GAPB(o[0]=__builtin_amdgcn_mfma_f32_32x32x16_bf16(PAF(0),VFR(0),o[0],0,0,0), C0,0); \
    GAPB(o[1]=__builtin_amdgcn_mfma_f32_32x32x16_bf16(PAF(0),VFR(4),o[1],0,0,0), C0,4); \
    KRD(GL,0); GAPB(o[0]=__builtin_amdgcn_mfma_f32_32x32x16_bf16(PAF(1),VFR(1),o[0],0,0,0), C0,8); \
    KRD(GL,1); GAPB(o[1]=__builtin_amdgcn_mfma_f32_32x32x16_bf16(PAF(1),VFR(5),o[1],0,0,0), C0,12); \
    KRD(GL,2); GAPB(o[0]=__builtin_amdgcn_mfma_f32_32x32x16_bf16(PAF(2),VFR(2),o[0],0,0,0), C1,0); \
    KRD(GL,3); GAPB(o[1]=__builtin_amdgcn_mfma_f32_32x32x16_bf16(PAF(2),VFR(6),o[1],0,0,0), C1,4); \
    GAPB(o[0]=__builtin_amdgcn_mfma_f32_32x32x16_bf16(PAF(3),VFR(3),o[0],0,0,0), C1,8); \
    GAPB(o[1]=__builtin_amdgcn_mfma_f32_32x32x16_bf16(PAF(3),VFR(7),o[1],0,0,0), C1,12); \
    }while(0)
  int t=1;
  #undef CMASK
  #define CMASK(P0,P1,t) do{}while(0)
  for(;t+5<NT;t+=2){
    STEP(pB0,pB1,pA0,pA1,t,true,true,true);     WAIT_BAR(2); RESC(); ROT();
    STEP(pA0,pA1,pB0,pB1,t+1,true,true,true);   WAIT_BAR(2); RESC(); ROT();
  }
  #undef CMASK
  #define CMASK(P0,P1,t) do{int jb_=(t)-(NT-4); if(jb_>=0)cmask(P0,P1,jb_,qrel,hi);}while(0)
  #define ENDW(tt) do{ if((tt)+3<NT){WAIT_BAR(2);} else if((tt)+2<NT){WAIT_BAR(1);} else {WAIT_BAR(0);} }while(0)
  for(;t+1<NT;t+=2){
    STEP(pB0,pB1,pA0,pA1,t,(t+3<NT),(t+1<NT),(t+1<NT));       ENDW(t);   RESC(); ROT();
    STEP(pA0,pA1,pB0,pB1,t+1,(t+4<NT),(t+2<NT),(t+2<NT));     ENDW(t+1); RESC(); ROT();
  }
  STEP(pB0,pB1,pA0,pA1,NT-1,false,false,false); RESC();
  { float sacc=pB0[0]+pB0[1]; _Pragma("unroll") for(int r=2;r<16;++r)sacc+=pB0[r]; _Pragma("unroll") for(int r=0;r<16;++r)sacc+=pB1[r]; l_reg+=sacc;
    pw0=(u32x4){PKW(pB0,0),PKW(pB0,2),PKW(pB0,4),PKW(pB0,6)};pw1=(u32x4){PKW(pB0,8),PKW(pB0,10),PKW(pB0,12),PKW(pB0,14)};pw2=(u32x4){PKW(pB1,0),PKW(pB1,2),PKW(pB1,4),PKW(pB1,6)};pw3=(u32x4){PKW(pB1,8),PKW(pB1,10),PKW(pB1,12),PKW(pB1,14)};
    SBAR(); pv(o,vb0+sl_cur,PAF(0),PAF(1),PAF(2),PAF(3)); }
  #undef PKW
  #undef PAF
  #undef VFR
  #undef PIN
  #undef MX3
  #undef GAPA
  #undef GAPB
  #undef EX
  #undef VRD
  #undef KRD
  #undef STEP
  #undef ENDW
  {auto rr=__builtin_amdgcn_permlane32_swap(__float_as_uint(l_reg),__float_as_uint(l_reg),false,false);l_reg=__uint_as_float(rr[0])+__uint_as_float(rr[1]);}
  if(hi==0)wsf[32+r32]=l_reg;asm volatile("s_waitcnt lgkmcnt(0)":::"memory");
  float rli[16];
  #pragma unroll
  for(int r=0;r<16;++r)rli[r]=__builtin_amdgcn_rcpf(wsf[32+crow(r,hi)]);
  bf16*Ow=O+(rowbase+q0+wid*QBLK)*OP+co;
  { bf16*stg=(bf16*)(shm+LDS_OST)+wid*2048;
    #pragma unroll
    for(int r=0;r<16;++r){const int orow=crow(r,hi);
      #pragma unroll
      for(int d0=0;d0<2;++d0)stg[orow*64+d0*32+r32]=__float2bfloat16(o[d0][r]*rli[r]);}
    asm volatile("s_waitcnt lgkmcnt(0)":::"memory");
    #pragma unroll
    for(int i=0;i<4;++i){const int row=i*8+(lane>>3),ch=lane&7; const u32x4 v=*(const u32x4*)(stg+row*64+ch*8); ATTN_STORE16(Ow+(long)row*OP+ch*8,v);} }
  asm volatile("s_waitcnt lgkmcnt(0)\n\ts_barrier":::"memory");
  #undef DMA_K
  #undef DMA_V
  #undef CMASK
  #undef START
  #undef RESC
  #undef ROT
}
constexpr int ATTN_LDS_BYTES=LDS_BYTES;
struct AttnTensors { const bf16* Q; const bf16* K; const bf16* V; bf16* O; };
struct AttnUnit { int combo; int qb; };
struct StaticOrder {
  int vcu, G;
  __device__ __forceinline__ explicit StaticOrder(int grid,int v):vcu(v),G(grid){}
  __device__ __forceinline__ bool next(int i,AttnUnit&u)const{ const int c=vcu+(i>>4)*G; if(c>=256)return false; u.combo=c; u.qb=15-(i&15); return true; }
};
template<class Sched,int THRL=8> __device__ __forceinline__ void attn_phase(char*lds,const AttnTensors&T,const Sched&S,const int wid){
  AttnUnit u;
  for(int i=0;S.next(i,u);++i){ const int vh=u.combo&1,hm=(u.combo>>1)&15,b=u.combo>>5;
    attn_unit<THRL>(wid,b,hm*64,(hm>>1)*128+vh*64,(hm*2+vh)*64,u.qb,T.Q,T.K,T.V,T.O,lds); }
}
#undef SBAR
#undef WAIT_BAR
}
#define GAS __attribute__((address_space(1)))
#define LAS __attribute__((address_space(3)))
typedef unsigned short bf16;
typedef unsigned v4u __attribute__((ext_vector_type(4)));
typedef float f32x4 __attribute__((ext_vector_type(4)));
typedef short bf16x8 __attribute__((ext_vector_type(8)));
typedef GAS unsigned gu32;
typedef GAS unsigned long long gu64;
#define RLX_AGENT __ATOMIC_RELAXED, __HIP_MEMORY_SCOPE_AGENT
#define LDS_WAIT() asm volatile("s_waitcnt lgkmcnt(0)" ::: "memory")
#define VM_WAIT() asm volatile("s_waitcnt vmcnt(0)" ::: "memory")
__device__ __forceinline__ unsigned long long rt() { return __builtin_amdgcn_s_memrealtime(); }
__device__ __forceinline__ unsigned f2bf(float f) { unsigned u = __builtin_bit_cast(unsigned, f); return (u + 0x7fffu + ((u >> 16) & 1u)) >> 16; }
__device__ __forceinline__ unsigned pk2(float lo, float hi) { return f2bf(lo) | (f2bf(hi) << 16); }

#define XB_TMO      128
#define XB_XCNT(j)  (256  + 64 * (j))
#define XB_XSUB(j)  (1280 + 64 * (j))
#define XB_XGEN(j)  (2304 + 64 * (j))
#define XB_TOP      3328
#define XB_TOPGEN   3392
#define XCD_BAR_WORDS 3456
#define XB_SPIN_CAP (1u << 18)

__device__ __forceinline__ unsigned xb_ld(unsigned* p)              { return __hip_atomic_load(p, __ATOMIC_RELAXED, __HIP_MEMORY_SCOPE_AGENT); }
__device__ __forceinline__ unsigned xb_add(unsigned* p, unsigned v) { return __hip_atomic_fetch_add(p, v, __ATOMIC_RELAXED, __HIP_MEMORY_SCOPE_AGENT); }
__device__ __forceinline__ unsigned xb_xcc_id() { return (unsigned)__builtin_amdgcn_s_getreg((3 << 11) | 20) & 0xFu; }
#define XB_SPIN(cond, bar) do { unsigned _sp = 0; while (cond) { __builtin_amdgcn_s_sleep(1); \
    if ((++_sp & 255u) == 0u) { if (xb_ld(&(bar)[XB_TMO])) break; if (_sp > XB_SPIN_CAP) { atomicAdd(&(bar)[XB_TMO], 1u); break; } } } } while (0)

struct XcdBarrier {
    unsigned* bar; unsigned x; int wave;
    volatile LAS unsigned* st;
};

__device__ __forceinline__ XcdBarrier xcd_barrier_post(unsigned* bar, volatile LAS unsigned* st) {
    XcdBarrier b; b.bar = bar; b.x = xb_xcc_id(); b.st = st; b.wave = 0;
    if (threadIdx.x == 0) (void)xb_add(&bar[XB_XCNT(b.x)], 1u);
    return b;
}
__device__ __forceinline__ void xcd_barrier_complete(unsigned* bar, unsigned x, unsigned& nloc, unsigned& nx) {
    const unsigned G = gridDim.x * gridDim.y * gridDim.z;
    unsigned sum, cnt, mine, sp = 0u;
    for (;;) {
        sum = 0u; cnt = 0u; mine = 0u;
#pragma unroll
        for (unsigned j = 0; j < 16; ++j) { const unsigned c = xb_ld(&bar[XB_XCNT(j)]); sum += c; cnt += (c > 0u) ? 1u : 0u; mine = (j == x) ? c : mine; }
        if (sum == G) break;
        __builtin_amdgcn_s_sleep(1);
        if ((++sp & 255u) == 0u) { if (xb_ld(&bar[XB_TMO])) break; if (sp > XB_SPIN_CAP) { atomicAdd(&bar[XB_TMO], 1u); break; } }
    }
    nloc = mine > 0u ? mine : 1u; nx = cnt > 0u ? cnt : 1u;
}

__device__ __forceinline__ void xcd_barrier(const XcdBarrier& b) {
    asm volatile("s_waitcnt vmcnt(0)" ::: "memory");
    __syncthreads();
    if (b.wave == 0 && mk_lane_now() == 0) {
        unsigned* bar = b.bar;
        __builtin_amdgcn_s_waitcnt(0);
        unsigned nloc = b.st[0], nx = b.st[1];
        if (nloc == 0u) { xcd_barrier_complete(bar, b.x, nloc, nx); b.st[0] = nloc; b.st[1] = nx; }
        const unsigned old = xb_add(&bar[XB_XSUB(b.x)], 1u);
        const unsigned gen = old / nloc;
        if (old + 1u == (gen + 1u) * nloc) {
            __builtin_amdgcn_fence(__ATOMIC_RELEASE, "agent");
            asm volatile("s_waitcnt vmcnt(0)" ::: "memory");
            const unsigned og = xb_add(&bar[XB_TOP], 1u);
            const unsigned tg = og / nx;
            if (og + 1u == (tg + 1u) * nx) xb_add(&bar[XB_TOPGEN], 1u);
            else XB_SPIN(xb_ld(&bar[XB_TOPGEN]) == tg, bar);
            __builtin_amdgcn_fence(__ATOMIC_ACQUIRE, "agent");
            xb_add(&bar[XB_XGEN(b.x)], 1u);
            asm volatile("s_waitcnt vmcnt(0)" ::: "memory");
        } else {
            XB_SPIN(xb_ld(&bar[XB_XGEN(b.x)]) == gen, bar);
            __builtin_amdgcn_fence(__ATOMIC_ACQUIRE, "agent");
            asm volatile("s_waitcnt vmcnt(0)" ::: "memory");
        }
    }
    __syncthreads();
}


constexpr int NWAVES = 8;
constexpr size_t MiB = 1u << 20;
constexpr size_t WS_CTL = 0, CTL_ZERO_BYTES = 1 * MiB;
constexpr size_t WS_MOD = 1 * MiB;
constexpr size_t WS_BINP = 1 * MiB + 256 * 1024;
constexpr size_t WS_TOPI = 2 * MiB, WS_TOPG = 3 * MiB;
constexpr size_t WS_LIST = 4 * MiB;
constexpr size_t WS_WIN = 36 * MiB, WS_WA = 50 * MiB, WS_WP = 52 * MiB, WS_WO = 54 * MiB, WS_WR = 56 * MiB;
constexpr size_t WS_WDN = 60 * MiB;
constexpr size_t WS_WUP = 190 * MiB;
constexpr size_t WS_YS = 190 * MiB;
constexpr size_t WS_S0 = 448 * MiB, WS_SLOT = 64 * MiB;
constexpr size_t WS_Q = WS_S0, WS_K = WS_S0 + WS_SLOT, WS_V = WS_S0 + 2 * WS_SLOT, WS_U = WS_S0 + 3 * WS_SLOT, WS_SGA = WS_S0 + 4 * WS_SLOT, WS_SGB = WS_S0 + 5 * WS_SLOT;
constexpr size_t WS_CACT = WS_S0 + 6 * WS_SLOT, WS_H = WS_S0 + 7 * WS_SLOT, WS_OATT = WS_S0 + 7 * WS_SLOT;
constexpr size_t WS_ON = WS_S0, WS_YA = WS_S0 + WS_SLOT, WS_M = WS_S0 + 2 * WS_SLOT, WS_Z = WS_S0 + 7 * WS_SLOT, WS_H2 = WS_S0, WS_LG = WS_S0 + WS_SLOT, WS_HID = WS_S0 + 4 * WS_SLOT;
constexpr size_t WS_END = 1024 * MiB;
static_assert(WS_WDN + (size_t)NEX_ * 1024 * 256 * 2 <= WS_WUP && WS_WUP + (size_t)NEX_ * 512 * 1024 * 2 <= WS_S0 && WS_YS + (size_t)T_ * 8 * 1024 * 2 <= WS_HID, "d_ws map");
static_assert(WS_HID + (size_t)1408 * 256 * 256 * 2 <= WS_Z && WS_Z + (size_t)T_ * D_ * 4 <= WS_END, "d_ws map 2");
constexpr int CW_TMO = 0, CW_CODE = 1;
constexpr int CW_BAR = 4096;
constexpr int CW_CNT = 32768;
constexpr int CW_ERR = 65536;
constexpr int RING_OFF = 0, RING_BYTES = 131072;
constexpr int LDSCTL_OFF = RING_BYTES, MISC_OFF = LDSCTL_OFF + 320;
constexpr int UT_OFF = 132096, TAB_OFF = 133120, TOK_OFF = 137216, MAXU = 32, MAXTOK = 16;
constexpr int LDS_BYTES = TOK_OFF + MAXTOK * 1024;
static_assert(MISC_OFF + 128 <= UT_OFF && UT_OFF + MAXU * 32 <= TAB_OFF && TAB_OFF + 3 * 260 * 4 <= TOK_OFF && LDS_BYTES <= 163840, "LDS map");

enum { I_X = 0, I_C, I_ADAW, I_ADAB, I_WIN, I_BIN, I_LQ1, I_LK1, I_LQ2, I_LK2, I_SUBG, I_WAO, I_CW, I_CB, I_CLG, I_CLB, I_PWW, I_PWB, I_WOUT, I_LN1G, I_LN1B,
       I_RW, I_RB, I_W1, I_W3, I_W2, I_WS1, I_WS3, I_WS2, I_LN2G, I_LN2B, N_IN };
struct Args { const float* in[N_IN]; float* out; unsigned char* ws; int ph_lo, ph_hi; };
static_assert(sizeof(Args) == N_IN * 8 + 24, "Args has no padding");
typedef const __attribute__((address_space(4))) Args* CArgs;
__device__ __forceinline__ CArgs args_now() { auto p = __builtin_amdgcn_kernarg_segment_ptr(); asm volatile("" : "+s"(p)); return (CArgs)p; }
struct Frame {
    LAS unsigned char* lds; volatile LAS unsigned* MISC; gu32* ctl;
    int tid, lane, wave, vcu, G;
};
__device__ __forceinline__ float wave_sum(float v) {
#pragma unroll
    for (int o = 1; o < 64; o <<= 1) v += __shfl_xor(v, o);
    return v;
}
__device__ __forceinline__ float sigm_f(float x) { return __builtin_amdgcn_rcpf(1.0f + __builtin_amdgcn_exp2f(-x * LOG2E_)); }
__device__ __forceinline__ unsigned pkbf(float lo, float hi) { return pg8::cvt_pk_bf16(lo, hi); }
__device__ __forceinline__ float bflo(unsigned w) { return __uint_as_float(w << 16); }
__device__ __forceinline__ float bfhi(unsigned w) { return __uint_as_float(w & 0xffff0000u); }

__host__ __device__ __forceinline__ int in_dest_row(int col) {
    if (col < 3072) return col;
    if (col < 5120) { const int r = col - 3072, half = r >> 10, rr = r & 1023; return 3072 + (rr >> 7) * 256 + half * 128 + (rr & 127); }
    const int r = col - 5120, half = r >> 10, rr = r & 1023; return 5120 + (rr >> 7) * 256 + half * 128 + (rr & 127);
}
__host__ __device__ __forceinline__ int in_orig_col(int rho) {
    if (rho < 3072) return rho;
    if (rho < 5120) { const int r = rho - 3072, j = r >> 8, w = r & 255; return 3072 + (w >> 7) * 1024 + j * 128 + (w & 127); }
    const int r = rho - 5120, j = r >> 8, w = r & 255; return 5120 + (w >> 7) * 1024 + j * 128 + (w & 127);
}

__device__ __forceinline__ void p0_transpose_item(const float* W, int K, int N, bf16* WTrow0, int k0, int n0, int lane) {
    const int n4 = (lane & 15) * 4, kb = (lane >> 4) * 8;
    const GAS f32x4* src = (const GAS f32x4*)(W + (size_t)(k0 + kb) * N + n0 + n4);
    f32x4 v[2][8];
#pragma unroll
    for (int p = 0; p < 2; ++p)
#pragma unroll
        for (int j = 0; j < 8; ++j) v[p][j] = src[((size_t)(32 * p + j) * N) >> 2];
#pragma unroll
    for (int p = 0; p < 2; ++p)
#pragma unroll
        for (int c = 0; c < 4; ++c) { v4u o; o.x = pkbf(v[p][0][c], v[p][1][c]); o.y = pkbf(v[p][2][c], v[p][3][c]); o.z = pkbf(v[p][4][c], v[p][5][c]); o.w = pkbf(v[p][6][c], v[p][7][c]);
            *(GAS v4u*)(WTrow0 + (size_t)(n4 + c) * K + k0 + 32 * p + kb) = o; }
}

__device__ __forceinline__ void p0_prologue(Frame& F, CArgs A) {
    unsigned char* ws = A->ws;
    if (blockIdx.x < 192) {
        LAS float* sc = (LAS float*)(F.lds); LAS float* part = (LAS float*)(F.lds + 32768);
        const float* c = A->in[I_C];
        for (int i = F.tid; i < 8192; i += 512) { const float v = c[i]; sc[i] = v * sigm_f(v); }
        __syncthreads();
        const int j0 = blockIdx.x * 32, kg = F.tid >> 5, col = F.tid & 31;
        const float* w = A->in[I_ADAW] + (size_t)(kg * 64) * 6144 + j0 + col;
        float acc[8] = {0.f, 0.f, 0.f, 0.f, 0.f, 0.f, 0.f, 0.f};
#pragma unroll 8
        for (int kk = 0; kk < 64; ++kk) { const float wv = w[(size_t)kk * 6144]; const int k = kg * 64 + kk;
#pragma unroll
            for (int b = 0; b < 8; ++b) acc[b] += sc[b * 1024 + k] * wv; }
#pragma unroll
        for (int b = 0; b < 8; ++b) part[(kg * 8 + b) * 32 + col] = acc[b];
        __syncthreads();
        if (F.tid < 256) { const int b = F.tid >> 5, cc = F.tid & 31; float s = A->in[I_ADAB][j0 + cc];
            for (int g = 0; g < 16; ++g) s += part[(g * 8 + b) * 32 + cc];
            ((float*)(ws + WS_MOD))[b * 6144 + j0 + cc] = s; }
        __syncthreads();
    }
    { const int gt = blockIdx.x * 512 + F.tid; if (gt < NIN_) ((float*)(ws + WS_BINP))[gt] = A->in[I_BIN][in_orig_col(gt)]; }
    const int gw = F.vcu * NWAVES + F.wave, NGW = F.G * NWAVES;
    constexpr int I_IN = 16 * 112, I_SQ = 16 * 16, I_R = 16 * 4, I_EX = NEX_ * 64;
    constexpr int NITEMS = I_IN + 3 * I_SQ + I_R + 3 * I_EX;
    for (int it = gw; it < NITEMS; it += NGW) {
        int r = it;
        if (r < I_IN) { const int kb = r / 112, nb = r % 112, n0 = nb * 64; p0_transpose_item(A->in[I_WIN], 1024, NIN_, (bf16*)(ws + WS_WIN) + (size_t)in_dest_row(n0) * 1024, kb * 64, n0, F.lane); continue; } r -= I_IN;
        if (r < 3 * I_SQ) { const int w = r / I_SQ, q = r % I_SQ, kb = q / 16, nb = q % 16;
            const float* src = w == 0 ? A->in[I_WAO] : (w == 1 ? A->in[I_PWW] : A->in[I_WOUT]); bf16* dst = (bf16*)(ws + (w == 0 ? WS_WA : (w == 1 ? WS_WP : WS_WO)));
            p0_transpose_item(src, 1024, 1024, dst + (size_t)(nb * 64) * 1024, kb * 64, nb * 64, F.lane); continue; } r -= 3 * I_SQ;
        if (r < I_R) { const int kb = r / 4, nb = r % 4; p0_transpose_item(A->in[I_RW], 1024, 256, (bf16*)(ws + WS_WR) + (size_t)(nb * 64) * 1024, kb * 64, nb * 64, F.lane); continue; } r -= I_R;
        if (r < 2 * I_EX) { const int w3 = r >= I_EX; if (w3) r -= I_EX; const int e = r / 64, q = r % 64, kb = q / 4, nb = q % 4, n0 = nb * 64;
            const float* src = e < NE_ ? (w3 ? A->in[I_W3] : A->in[I_W1]) + (size_t)e * 262144 : (w3 ? A->in[I_WS3] : A->in[I_WS1]);
            bf16* dst = (bf16*)(ws + WS_WUP) + ((size_t)e * 512 + (n0 >> 7) * 256 + w3 * 128 + (n0 & 127)) * 1024;
            p0_transpose_item(src, 1024, 256, dst, kb * 64, n0, F.lane); continue; } r -= 2 * I_EX;
        { const int e = r / 64, q = r % 64, kb = q / 16, nb = q % 16, n0 = nb * 64;
            const float* src = e < NE_ ? A->in[I_W2] + (size_t)e * 262144 : A->in[I_WS2];
            p0_transpose_item(src, 256, 1024, (bf16*)(ws + WS_WDN) + ((size_t)e * 1024 + n0) * 256, kb * 64, n0, F.lane); }
    }
}
__device__ __forceinline__ void p1_modulate(Frame& F, CArgs A) {
    const int gw = F.vcu * NWAVES + F.wave, NGW = F.G * NWAVES;
    const float* mod = (const float*)(A->ws + WS_MOD); bf16* H = (bf16*)(A->ws + WS_H);
    for (int m = gw; m < T_; m += NGW) { const int b = m >> 12;
        const GAS f32x4* xr = (const GAS f32x4*)(A->in[I_X] + (size_t)m * D_) + F.lane;
        const f32x4* sh = (const f32x4*)(mod + b * 6144) + F.lane; const f32x4* sc = (const f32x4*)(mod + b * 6144 + 1024) + F.lane;
        GAS unsigned long long* o8 = (GAS unsigned long long*)(H + (size_t)m * D_) + F.lane;
#pragma unroll
        for (int j = 0; j < 4; ++j) { const f32x4 v = xr[64 * j], s = sc[64 * j], h = sh[64 * j]; const f32x4 o = v * (s + 1.0f) + h;
            o8[64 * j] = (unsigned long long)pkbf(o.x, o.y) | ((unsigned long long)pkbf(o.z, o.w) << 32); } }
}
__device__ __forceinline__ void p3_conv(Frame& F, CArgs A) {
    LAS unsigned* U = (LAS unsigned*)(F.lds);
    LAS v4u* U16 = (LAS v4u*)(F.lds);
    LAS float* ST = (LAS float*)(F.lds + 98304);
    LAS float* MS = ST + 256;
    const bf16* ug = (const bf16*)(A->ws + WS_U); unsigned* co = (unsigned*)(A->ws + WS_CACT);
    const int c0 = 2 * F.tid;
    float w0[31], w1[31];
#pragma unroll
    for (int j = 0; j < 31; ++j) { w0[j] = A->in[I_CW][j * 1024 + c0]; w1[j] = A->in[I_CW][j * 1024 + c0 + 1]; }
    const float cb0 = A->in[I_CB][c0], cb1 = A->in[I_CB][c0 + 1], g0 = A->in[I_CLG][c0], g1 = A->in[I_CLG][c0 + 1], be0 = A->in[I_CLB][c0], be1 = A->in[I_CLB][c0 + 1];
    for (int tile = F.vcu; tile < T_ / 16; tile += F.G) {
        const int t0 = tile * 16, tb = t0 & (SEQ_ - 1);
        {
            v4u sv[12];
#pragma unroll
            for (int i = 0; i < 12; ++i) { const int ch = F.tid + 512 * i, r = ch >> 7, cc = ch & 127; const int pos = tb - 30 + r;
                sv[i] = (v4u){0u, 0u, 0u, 0u}; if (ch < 46 * 128 && pos >= 0) sv[i] = *(const GAS v4u*)(ug + (size_t)(t0 - 30 + r) * D_ + cc * 8); }
#pragma unroll
            for (int i = 0; i < 12; ++i) { const int ch = F.tid + 512 * i; if (ch < 46 * 128) U16[ch] = sv[i]; }
        }
        __syncthreads();
        float y0[16], y1[16];
#pragma unroll
        for (int chunk = 0; chunk < 2; ++chunk) {
            float v0[38], v1[38];
#pragma unroll
            for (int r = 0; r < 38; ++r) { const unsigned w = U[(chunk * 8 + r) * 512 + F.tid]; v0[r] = bflo(w); v1[r] = bfhi(w); }
#pragma unroll
            for (int tt = 0; tt < 8; ++tt) { float a0 = cb0, a1 = cb1;
#pragma unroll
                for (int j = 0; j < 31; ++j) { a0 += w0[j] * v0[tt + j]; a1 += w1[j] * v1[tt + j]; }
                y0[chunk * 8 + tt] = a0; y1[chunk * 8 + tt] = a1; }
        }
#pragma unroll
        for (int tt = 0; tt < 16; ++tt) { const float s = wave_sum(y0[tt] + y1[tt]), q = wave_sum(y0[tt] * y0[tt] + y1[tt] * y1[tt]);
            if (F.lane == 0) { ST[(F.wave * 16 + tt) * 2] = s; ST[(F.wave * 16 + tt) * 2 + 1] = q; } }
        __syncthreads();
        if (F.tid < 16) { float s = 0.f, q = 0.f;
            for (int w = 0; w < 8; ++w) { s += ST[(w * 16 + F.tid) * 2]; q += ST[(w * 16 + F.tid) * 2 + 1]; }
            const float mean = s * (1.f / 1024.f), var = q * (1.f / 1024.f) - mean * mean;
            MS[F.tid * 2] = mean; MS[F.tid * 2 + 1] = 1.0f / sqrtf(fmaxf(var, 0.f) + LN_EPS_); }
        __syncthreads();
#pragma unroll
        for (int tt = 0; tt < 16; ++tt) { const float mean = MS[tt * 2], rstd = MS[tt * 2 + 1];
            const float z0 = (y0[tt] - mean) * rstd * g0 + be0, z1 = (y1[tt] - mean) * rstd * g1 + be1;
            co[((size_t)(t0 + tt) * D_ + c0) >> 1] = pkbf(z0 * sigm_f(z0), z1 * sigm_f(z1)); }
        __syncthreads();
    }
}
__device__ __forceinline__ void p4_onorm(Frame& F, CArgs A) {
    const int gw = F.vcu * NWAVES + F.wave, NGW = F.G * NWAVES;
    const float s1 = wave_sum(A->in[I_LQ1][F.lane] * A->in[I_LK1][F.lane]), s2 = wave_sum(A->in[I_LQ2][F.lane] * A->in[I_LK2][F.lane]);
    const float lam = expf(s1) - expf(s2) + LAM_INIT_;
    const int h = F.lane >> 3, dv0 = (F.lane & 7) * 16;
    float g[16];
#pragma unroll
    for (int i = 0; i < 16; ++i) g[i] = A->in[I_SUBG][dv0 + i] * (1.0f - LAM_INIT_);
    const bf16* O = (const bf16*)(A->ws + WS_OATT); bf16* ON = (bf16*)(A->ws + WS_ON);
    for (int m = gw; m < T_; m += NGW) {
        const GAS v4u* p0 = (const GAS v4u*)(O + (size_t)m * 2048 + h * 256 + dv0); const GAS v4u* p1 = (const GAS v4u*)(O + (size_t)m * 2048 + h * 256 + 128 + dv0);
        const v4u a0 = p0[0], a1 = p0[1], b0 = p1[0], b1 = p1[1];
        float o[16];
#define P4_UNP(dst, A_, B_, k) { o[dst] = bflo(A_[k]) - lam * bflo(B_[k]); o[dst + 1] = bfhi(A_[k]) - lam * bfhi(B_[k]); }
        P4_UNP(0, a0, b0, 0) P4_UNP(2, a0, b0, 1) P4_UNP(4, a0, b0, 2) P4_UNP(6, a0, b0, 3) P4_UNP(8, a1, b1, 0) P4_UNP(10, a1, b1, 1) P4_UNP(12, a1, b1, 2) P4_UNP(14, a1, b1, 3)
#undef P4_UNP
        float ss = 0.f;
#pragma unroll
        for (int i = 0; i < 16; ++i) ss += o[i] * o[i];
        ss += __shfl_xor(ss, 1); ss += __shfl_xor(ss, 2); ss += __shfl_xor(ss, 4);
        const float r = 1.0f / sqrtf(ss * (1.f / 128.f) + RMS_EPS_);
        v4u w0, w1;
        w0.x = pkbf(o[0] * r * g[0], o[1] * r * g[1]); w0.y = pkbf(o[2] * r * g[2], o[3] * r * g[3]); w0.z = pkbf(o[4] * r * g[4], o[5] * r * g[5]); w0.w = pkbf(o[6] * r * g[6], o[7] * r * g[7]);
        w1.x = pkbf(o[8] * r * g[8], o[9] * r * g[9]); w1.y = pkbf(o[10] * r * g[10], o[11] * r * g[11]); w1.z = pkbf(o[12] * r * g[12], o[13] * r * g[13]); w1.w = pkbf(o[14] * r * g[14], o[15] * r * g[15]);
        GAS v4u* q = (GAS v4u*)(ON + (size_t)m * D_ + h * 128 + dv0); q[0] = w0; q[1] = w1;
    }
}
__device__ __forceinline__ void p7_ln1(Frame& F, CArgs A) {
    const int gw = F.vcu * NWAVES + F.wave, NGW = F.G * NWAVES;
    const float* mod = (const float*)(A->ws + WS_MOD); float* Z = (float*)(A->ws + WS_Z); bf16* H2 = (bf16*)(A->ws + WS_H2);
    f32x4 lg[4], lb[4];
#pragma unroll
    for (int j = 0; j < 4; ++j) { lg[j] = ((const f32x4*)A->in[I_LN1G])[F.lane + 64 * j]; lb[j] = ((const f32x4*)A->in[I_LN1B])[F.lane + 64 * j]; }
    for (int m = gw; m < T_; m += NGW) { const int b = m >> 12;
        GAS f32x4* zr = (GAS f32x4*)(Z + (size_t)m * D_) + F.lane;
        f32x4 v[4]; float s = 0.f;
#pragma unroll
        for (int j = 0; j < 4; ++j) { v[j] = zr[64 * j]; s += (v[j].x + v[j].y) + (v[j].z + v[j].w); }
        const float mean = wave_sum(s) * (1.f / D_); float s2 = 0.f;
#pragma unroll
        for (int j = 0; j < 4; ++j) { v[j] = v[j] - mean; s2 += (v[j].x * v[j].x + v[j].y * v[j].y) + (v[j].z * v[j].z + v[j].w * v[j].w); }
        const float rstd = 1.f / sqrtf(wave_sum(s2) * (1.f / D_) + LN_EPS_);
        const f32x4* sh = (const f32x4*)(mod + b * 6144 + 3072) + F.lane; const f32x4* sc = (const f32x4*)(mod + b * 6144 + 4096) + F.lane;
        GAS unsigned long long* o8 = (GAS unsigned long long*)(H2 + (size_t)m * D_) + F.lane;
#pragma unroll
        for (int j = 0; j < 4; ++j) { const f32x4 x1 = v[j] * rstd * lg[j] + lb[j]; zr[64 * j] = x1;
            const f32x4 o = x1 * (sc[64 * j] + 1.0f) + sh[64 * j];
            o8[64 * j] = (unsigned long long)pkbf(o.x, o.y) | ((unsigned long long)pkbf(o.z, o.w) << 32); }
    }
}
__device__ __forceinline__ void p9_route(Frame& F, CArgs A) {
    const float* lg = (const float*)(A->ws + WS_LG); int* topi = (int*)(A->ws + WS_TOPI); float* topg = (float*)(A->ws + WS_TOPG); int* list = (int*)(A->ws + WS_LIST);
    gu32* gcnt = F.ctl + CW_CNT;
    LAS int* hist = (LAS int*)(F.lds); LAS int* basel = hist + 256; LAS int* sel = basel + 256;
    float rb[4];
#pragma unroll
    for (int j = 0; j < 4; ++j) rb[j] = A->in[I_RB][F.lane + 64 * j];
    const int hf = F.lane >> 5;
    for (int tb = F.vcu; tb < T_ / 128; tb += F.G) {
        if (F.tid < 256) hist[F.tid] = 0;
        __syncthreads();
        for (int i = 0; i < 16; ++i) { const int t = tb * 128 + F.wave * 16 + i;
            float s[4], c[4], gs[4];
#pragma unroll
            for (int j = 0; j < 4; ++j) { s[j] = sigm_f(lg[(size_t)t * NE_ + F.lane + 64 * j]); c[j] = s[j] + rb[j]; }
#pragma unroll
            for (int j = 0; j < 4; ++j) { float m1 = c[j];
#pragma unroll
                for (int o = 1; o < 32; o <<= 1) m1 = fmaxf(m1, __shfl_xor(m1, o));
                const unsigned long long bal = __ballot(c[j] == m1); const unsigned hb = hf ? (unsigned)(bal >> 32) : (unsigned)bal; const int first = (__ffs((int)hb) - 1) + (F.lane & 32);
                float m2 = (F.lane == first) ? -INFINITY : c[j];
#pragma unroll
                for (int o = 1; o < 32; o <<= 1) m2 = fmaxf(m2, __shfl_xor(m2, o));
                gs[j] = m1 + m2; }
            float G8[8];
#pragma unroll
            for (int j = 0; j < 4; ++j) { G8[2 * j] = __uint_as_float(__builtin_amdgcn_readlane(__float_as_uint(gs[j]), 0)); G8[2 * j + 1] = __uint_as_float(__builtin_amdgcn_readlane(__float_as_uint(gs[j]), 32)); }
#pragma unroll
            for (int j = 0; j < 4; ++j) { const float mine = hf ? G8[2 * j + 1] : G8[2 * j]; const int g = 2 * j + hf; int rank = 0;
#pragma unroll
                for (int gp = 0; gp < 8; ++gp) rank += (G8[gp] > mine || (G8[gp] == mine && gp < g)) ? 1 : 0;
                if (rank >= 4) c[j] = -INFINITY; }
            int ek = 0; float sk = 0.f, ssum = 0.f;
#pragma unroll
            for (int k = 0; k < 8; ++k) { float wm = fmaxf(fmaxf(c[0], c[1]), fmaxf(c[2], c[3]));
#pragma unroll
                for (int o = 1; o < 64; o <<= 1) wm = fmaxf(wm, __shfl_xor(wm, o));
                int e = 0x7fffffff;
#pragma unroll
                for (int j = 3; j >= 0; --j) if (c[j] == wm) e = F.lane + 64 * j;
#pragma unroll
                for (int o = 1; o < 64; o <<= 1) e = min(e, __shfl_xor(e, o));
                float sv = 0.f;
#pragma unroll
                for (int j = 0; j < 4; ++j) if (F.lane + 64 * j == e) { sv = s[j]; c[j] = -INFINITY; }
                sv = __shfl(sv, e & 63);
                ssum += sv; if (F.lane == k) { ek = e; sk = sv; } }
            if (F.lane < 8) { const int a = t * 8 + F.lane; topi[a] = ek; topg[a] = sk / ssum * ROUTED_SCALE_;
                const int lr = __hip_atomic_fetch_add(&hist[ek], 1, __ATOMIC_RELAXED, __HIP_MEMORY_SCOPE_WORKGROUP); sel[(F.wave * 16 + i) * 8 + F.lane] = ek | (lr << 16); }
        }
        __syncthreads();
        if (F.tid < 256) { const int h = hist[F.tid]; int base = 0; if (h > 0) base = (int)__hip_atomic_fetch_add(gcnt + 64 * F.tid, (unsigned)h, __ATOMIC_RELAXED, __HIP_MEMORY_SCOPE_AGENT); basel[F.tid] = base; }
        __syncthreads();
        for (int q = F.lane; q < 128; q += 64) { const int i = q >> 3, k = q & 7, v = sel[(F.wave * 16 + i) * 8 + k], e = v & 0xffff, lr = v >> 16, t = tb * 128 + F.wave * 16 + i;
            list[(size_t)e * T_ + basel[e] + lr] = t * 8 + k; }
        __syncthreads();
    }
}
template <int NP, bool FILL_TOK>
__device__ __forceinline__ int moe_setup(Frame& F, CArgs A) {
    LAS int* UT = (LAS int*)(F.lds + UT_OFF); LAS int* NT = (LAS int*)(F.lds + TAB_OFF); LAS int* TS = NT + 260; LAS int* CN = TS + 260; LAS int* TOK = (LAS int*)(F.lds + TOK_OFF);
    const int* list = (const int*)(A->ws + WS_LIST);
    if (F.tid < NEX_) { int c = T_; if (F.tid < NE_) { c = (int)__hip_atomic_load(F.ctl + CW_CNT + 64 * F.tid, __ATOMIC_RELAXED, __HIP_MEMORY_SCOPE_AGENT); c = c < 0 ? 0 : (c > T_ ? T_ : c); } CN[F.tid] = c; NT[F.tid] = (c + 255) >> 8; }
    __syncthreads();
    if (F.wave == 0) { int loc[5]; int s = 0;
#pragma unroll
        for (int i = 0; i < 5; ++i) { const int idx = 5 * F.lane + i; loc[i] = s; s += (idx < NEX_) ? NT[idx] : 0; }
        int incl = s;
#pragma unroll
        for (int o = 1; o < 64; o <<= 1) { const int n = __shfl_up(incl, o); if (F.lane >= o) incl += n; }
        const int excl = incl - s;
#pragma unroll
        for (int i = 0; i < 5; ++i) { const int idx = 5 * F.lane + i; if (idx < NEX_) TS[idx] = excl + loc[i]; }
        if (F.lane == 63) TS[NEX_] = incl; }
    __syncthreads();
    const int total = TS[NEX_] * NP;
    int nun = (F.vcu < total) ? (total - F.vcu + F.G - 1) / F.G : 0;
    if (nun > (FILL_TOK ? MAXTOK : MAXU)) { nun = FILL_TOK ? MAXTOK : MAXU; if (F.tid == 0) __hip_atomic_store(F.ctl + CW_TMO, 0xBAD0u, RLX_AGENT); }
    if (F.tid < nun) { const int L = F.tid * F.G + F.vcu, rtg = L / NP, pn = L % NP; int lo = 0, hi = NE_;
        while (lo < hi) { const int mid = (lo + hi + 1) >> 1; if (TS[mid] <= rtg) lo = mid; else hi = mid - 1; }
        const int e = lo, rt = rtg - TS[e]; int nr = CN[e] - rt * 256; nr = nr > 256 ? 256 : nr;
        UT[F.tid * 8 + 0] = e; UT[F.tid * 8 + 1] = rt; UT[F.tid * 8 + 2] = pn; UT[F.tid * 8 + 3] = nr; UT[F.tid * 8 + 4] = rtg; }
    __syncthreads();
    if (FILL_TOK) {
        for (int sl = 0; sl < nun; ++sl) if (F.tid < 256) { const int e = UT[sl * 8], rt = UT[sl * 8 + 1], nr = UT[sl * 8 + 3]; int tok = 0;
            if (F.tid < nr) tok = (e < NE_) ? (list[(size_t)e * T_ + rt * 256 + F.tid] >> 3) : (rt * 256 + F.tid);
            TOK[sl * 256 + F.tid] = tok; }
        __syncthreads();
    }
    return nun;
}
__device__ __forceinline__ void p12_final(Frame& F, CArgs A, bool poison) {
    const int gw = F.vcu * NWAVES + F.wave, NGW = F.G * NWAVES;
    const float* mod = (const float*)(A->ws + WS_MOD); const float* XB = (const float*)(A->ws + WS_Z); const bf16* YS = (const bf16*)(A->ws + WS_YS);
    const float qnan = __builtin_nanf("");
    for (int m = gw; m < T_; m += NGW) { const int b = m >> 12;
        f32x4 v[2][2]; float s = 0.f;
#pragma unroll
        for (int j = 0; j < 2; ++j) { const int c = 8 * F.lane + 512 * j;
            f32x4 a0 = (f32x4){0.f, 0.f, 0.f, 0.f}, a1 = a0;
#pragma unroll
            for (int k = 0; k < 8; ++k) { const v4u w = *(const GAS v4u*)(YS + ((size_t)m * 8 + k) * D_ + c);
                a0 += (f32x4){bflo(w.x), bfhi(w.x), bflo(w.y), bfhi(w.y)}; a1 += (f32x4){bflo(w.z), bfhi(w.z), bflo(w.w), bfhi(w.w)}; }
            const f32x4 g0 = *(const f32x4*)(mod + b * 6144 + 5120 + c), g1 = *(const f32x4*)(mod + b * 6144 + 5120 + c + 4);
            v[j][0] = *(const GAS f32x4*)(XB + (size_t)m * D_ + c) + g0 * a0; v[j][1] = *(const GAS f32x4*)(XB + (size_t)m * D_ + c + 4) + g1 * a1;
            s += (v[j][0].x + v[j][0].y) + (v[j][0].z + v[j][0].w) + (v[j][1].x + v[j][1].y) + (v[j][1].z + v[j][1].w); }
        const float mean = wave_sum(s) * (1.f / D_); float s2 = 0.f;
#pragma unroll
        for (int j = 0; j < 2; ++j)
#pragma unroll
            for (int q = 0; q < 2; ++q) { v[j][q] = v[j][q] - mean; s2 += (v[j][q].x * v[j][q].x + v[j][q].y * v[j][q].y) + (v[j][q].z * v[j][q].z + v[j][q].w * v[j][q].w); }
        const float rstd = 1.f / sqrtf(wave_sum(s2) * (1.f / D_) + LN_EPS_);
#pragma unroll
        for (int j = 0; j < 2; ++j)
#pragma unroll
            for (int q = 0; q < 2; ++q) { const int c = 8 * F.lane + 512 * j + 4 * q;
                f32x4 o = v[j][q] * rstd * *(const f32x4*)(A->in[I_LN2G] + c) + *(const f32x4*)(A->in[I_LN2B] + c);
                if (poison) o = (f32x4){qnan, qnan, qnan, qnan};
                *(GAS f32x4*)(A->out + (size_t)m * D_ + c) = o; }
    }
}

constexpr int NPH = 13;
#ifndef REP_PH
#define REP_PH (-1)
#endif
#ifndef REP_N
#define REP_N 2
#endif
#define NREP(k) ((k) == REP_PH ? REP_N : 1)
__global__ void __launch_bounds__(NWAVES * 64, 2) mk_fwd(Args args) {
    extern __shared__ __attribute__((aligned(16))) unsigned char lds[];
    Frame F;
    F.lds = (LAS unsigned char*)lds;
    F.MISC = (volatile LAS unsigned*)(F.lds + MISC_OFF);
    #define REFRESH() do { F.lane = mk_lane_now(); F.tid = F.wave * 64 + F.lane; } while (0)
    F.wave = __builtin_amdgcn_readfirstlane((int)threadIdx.x >> 6); REFRESH();
    F.G = gridDim.x; { const int bx = blockIdx.x; F.vcu = (F.G % 8 == 0) ? (bx % 8) * (F.G / 8) + bx / 8 : bx; }
    F.ctl = (gu32*)(args.ws + WS_CTL);
    for (int u = F.tid; u < (LDS_BYTES - LDSCTL_OFF) / 4; u += NWAVES * 64) ((LAS unsigned*)(F.lds + LDSCTL_OFF))[u] = 0u;
    __syncthreads();
    const int lo = args.ph_lo, hi = args.ph_hi;
    XcdBarrier bar; bar.bar = (unsigned*)(F.ctl + CW_BAR); bar.x = 0; bar.st = nullptr; bar.wave = F.wave;
    if (hi - lo > 1) { bar = xcd_barrier_post((unsigned*)(F.ctl + CW_BAR), F.MISC + 8); bar.wave = F.wave; }
#define IN(k) (lo <= (k) && (k) < hi)
#define BOTH(k) (IN(k) && IN((k) + 1))
#define GRID_BAR() xcd_barrier(bar)

    if (IN(0)) _Pragma("unroll") for (int rep_ = 0; rep_ < NREP(0); ++rep_) { if (rep_ > 0) GRID_BAR(); REFRESH(); CArgs A = args_now(); unsigned char* ws = A->ws; p0_prologue(F, A); if (BOTH(0)) GRID_BAR(); }
    if (IN(1)) _Pragma("unroll") for (int rep_ = 0; rep_ < NREP(1); ++rep_) { if (rep_ > 0) GRID_BAR(); REFRESH(); CArgs A = args_now(); unsigned char* ws = A->ws; p1_modulate(F, A); if (BOTH(1)) GRID_BAR(); }
    if (IN(2)) _Pragma("unroll") for (int rep_ = 0; rep_ < NREP(2); ++rep_) { if (rep_ > 0) GRID_BAR(); REFRESH(); CArgs A = args_now(); unsigned char* ws = A->ws;
        pg8::Gemm g{(const pg8::bf16_t*)(ws + WS_H), (const pg8::bf16_t*)(ws + WS_WIN)}; pg8::StaticOrder S; S.init(T_, NIN_, F.G, (int)blockIdx.x);
        pg8::EpiInproj E{(pg8::bf16_t*)(ws + WS_Q), (size_t)(WS_SLOT / 2), (pg8::bf16_t*)(ws + WS_U), (pg8::bf16_t*)(ws + WS_SGA), (pg8::bf16_t*)(ws + WS_SGB),
                         (const float*)(ws + WS_BINP), attn_body::C2};
        pg8::gemm_phase<D_, pg8::EpiInproj, pg8::StaticOrder, PG8_ALIGN, PG8_SP2, false>(F.lds + RING_OFF, g, S, E, F.wave);
        if (BOTH(2)) GRID_BAR();
    }
    if (IN(3)) _Pragma("unroll") for (int rep_ = 0; rep_ < NREP(3); ++rep_) { if (rep_ > 0) GRID_BAR(); REFRESH(); CArgs A = args_now(); unsigned char* ws = A->ws;
#ifndef REP_CONV
#define REP_CONV 1
#endif
        p3_conv(F, A); __syncthreads();
        const attn_body::AttnTensors AT{(const attn_body::bf16*)(ws + WS_Q), (const attn_body::bf16*)(ws + WS_K), (const attn_body::bf16*)(ws + WS_V), (attn_body::bf16*)(ws + WS_OATT)};
        const attn_body::StaticOrder S((int)F.G, F.vcu);
        attn_body::attn_phase<attn_body::StaticOrder>((char*)lds + RING_OFF, AT, S, F.wave);
        if (BOTH(3)) GRID_BAR();
    }
    if (IN(4)) _Pragma("unroll") for (int rep_ = 0; rep_ < NREP(4); ++rep_) { if (rep_ > 0) GRID_BAR(); REFRESH(); CArgs A = args_now(); unsigned char* ws = A->ws; if (REP_CONV > 1) { p3_conv(F, A); __syncthreads(); } p4_onorm(F, A); if (BOTH(4)) GRID_BAR(); }
    if (IN(5)) _Pragma("unroll") for (int rep_ = 0; rep_ < NREP(5); ++rep_) { if (rep_ > 0) GRID_BAR(); REFRESH(); CArgs A = args_now(); unsigned char* ws = A->ws;
        { pg8::Gemm g{(const pg8::bf16_t*)(ws + WS_ON), (const pg8::bf16_t*)(ws + WS_WA)}; pg8::StaticOrder S; S.init(T_, D_, F.G, (int)blockIdx.x);
          pg8::EpiYa E{(const pg8::bf16_t*)(ws + WS_SGA), (pg8::bf16_t*)(ws + WS_YA)};
          pg8::gemm_phase<D_, pg8::EpiYa, pg8::StaticOrder, PG8_ALIGN, PG8_SP2, false>(F.lds + RING_OFF, g, S, E, F.wave); }
        asm volatile("s_waitcnt vmcnt(0)" ::: "memory"); __syncthreads();
        { pg8::Gemm g{(const pg8::bf16_t*)(ws + WS_CACT), (const pg8::bf16_t*)(ws + WS_WP)}; pg8::StaticOrder S; S.init(T_, D_, F.G, (int)blockIdx.x);
          pg8::EpiM E{(const pg8::bf16_t*)(ws + WS_SGB), (const pg8::bf16_t*)(ws + WS_YA), (pg8::bf16_t*)(ws + WS_M), A->in[I_PWB]};
          pg8::gemm_phase<D_, pg8::EpiM, pg8::StaticOrder, PG8_ALIGN, PG8_SP2, false>(F.lds + RING_OFF, g, S, E, F.wave); }
        if (BOTH(5)) GRID_BAR();
    }
    if (IN(6)) _Pragma("unroll") for (int rep_ = 0; rep_ < NREP(6); ++rep_) { if (rep_ > 0) GRID_BAR(); REFRESH(); CArgs A = args_now(); unsigned char* ws = A->ws;
        pg8::Gemm g{(const pg8::bf16_t*)(ws + WS_M), (const pg8::bf16_t*)(ws + WS_WO)}; pg8::StaticOrder S; S.init(T_, D_, F.G, (int)blockIdx.x);
        pg8::EpiZ E{A->in[I_X], (const float*)(ws + WS_MOD), (float*)(ws + WS_Z)};
        pg8::gemm_phase<D_, pg8::EpiZ, pg8::StaticOrder, PG8_ALIGN, PG8_SP2, false>(F.lds + RING_OFF, g, S, E, F.wave);
        if (BOTH(6)) GRID_BAR();
    }
    if (IN(7)) _Pragma("unroll") for (int rep_ = 0; rep_ < NREP(7); ++rep_) { if (rep_ > 0) GRID_BAR(); REFRESH(); CArgs A = args_now(); unsigned char* ws = A->ws; p7_ln1(F, A); if (BOTH(7)) GRID_BAR(); }
    if (IN(8)) _Pragma("unroll") for (int rep_ = 0; rep_ < NREP(8); ++rep_) { if (rep_ > 0) GRID_BAR(); REFRESH(); CArgs A = args_now(); unsigned char* ws = A->ws;
        pg8::Gemm g{(const pg8::bf16_t*)(ws + WS_H2), (const pg8::bf16_t*)(ws + WS_WR)}; pg8::StaticOrder S; S.init(T_, NE_, F.G, (int)blockIdx.x);
        pg8::EpiLogit E{(float*)(ws + WS_LG)};
        pg8::gemm_phase<D_, pg8::EpiLogit, pg8::StaticOrder, PG8_ALIGN, PG8_SP2, false>(F.lds + RING_OFF, g, S, E, F.wave);
        if (BOTH(8)) GRID_BAR();
    }
    if (IN(9)) _Pragma("unroll") for (int rep_ = 0; rep_ < NREP(9); ++rep_) { if (rep_ > 0) GRID_BAR(); REFRESH(); CArgs A = args_now(); unsigned char* ws = A->ws; p9_route(F, A); if (BOTH(9)) GRID_BAR(); }
    if (IN(10)) _Pragma("unroll") for (int rep_ = 0; rep_ < NREP(10); ++rep_) { if (rep_ > 0) GRID_BAR(); REFRESH(); CArgs A = args_now(); unsigned char* ws = A->ws;
        const int nun = moe_setup<2, true>(F, A);
        pg8::Gemm g{(const pg8::bf16_t*)(ws + WS_H2), (const pg8::bf16_t*)(ws + WS_WUP)};
        typedef pg8::MoeOrder<2, false, (unsigned)(D_ * 2)> OrdUp; OrdUp S{(const PG8_LAS int*)(F.lds + UT_OFF), (const PG8_LAS int*)(F.lds + TOK_OFF), nun};
        pg8::EpiSwiglu E{(pg8::bf16_t*)(ws + WS_HID)};
        pg8::gemm_phase<D_, pg8::EpiSwiglu, OrdUp, PG8_ALIGN, PG8_SP2, true>(F.lds + RING_OFF, g, S, E, F.wave);
        if (BOTH(10)) GRID_BAR();
    }
    if (IN(11)) _Pragma("unroll") for (int rep_ = 0; rep_ < NREP(11); ++rep_) { if (rep_ > 0) GRID_BAR(); REFRESH(); CArgs A = args_now(); unsigned char* ws = A->ws;
        const int nun = moe_setup<4, false>(F, A);
        pg8::Gemm g{(const pg8::bf16_t*)(ws + WS_HID), (const pg8::bf16_t*)(ws + WS_WDN)};
        typedef pg8::MoeOrder<4, true, 0u> OrdDn; OrdDn S{(const PG8_LAS int*)(F.lds + UT_OFF), (const PG8_LAS int*)(F.lds + TOK_OFF), nun};
        pg8::EpiDown E{(const int*)(ws + WS_LIST), (const float*)(ws + WS_TOPG), (pg8::bf16_t*)(ws + WS_YS), (float*)(ws + WS_Z), (const float*)(ws + WS_MOD)};
        pg8::gemm_phase<FE_, pg8::EpiDown, OrdDn, PG8_ALIGN, PG8_SP2, false>(F.lds + RING_OFF, g, S, E, F.wave);
        if (BOTH(11)) GRID_BAR();
    }
    if (IN(12)) _Pragma("unroll") for (int rep_ = 0; rep_ < NREP(12); ++rep_) { if (rep_ > 0) GRID_BAR(); REFRESH(); CArgs A = args_now(); unsigned char* ws = A->ws;
        bool poison = __hip_atomic_load(F.ctl + CW_TMO, RLX_AGENT) != 0u;
        poison |= __hip_atomic_load((gu32*)((const unsigned*)(F.ctl + CW_BAR) + XB_TMO), RLX_AGENT) != 0u;
        p12_final(F, A, poison);
    }
#undef IN
#undef BOTH
#undef GRID_BAR
}

#if DBG_CHECK
namespace chk {
__device__ __forceinline__ float bf2f(unsigned short h) { return __uint_as_float((unsigned)h << 16); }
__device__ __forceinline__ float rbf(float f) { unsigned u = __float_as_uint(f); u = (u + 0x7fffu + ((u >> 16) & 1u)) & 0xffff0000u; return __uint_as_float(u); }
__device__ __forceinline__ unsigned hashu(unsigned x) { x ^= x >> 16; x *= 0x7feb352dU; x ^= x >> 15; x *= 0x846ca68bU; x ^= x >> 16; return x; }
__device__ __forceinline__ void errmax(unsigned* ctl, int id, float got, float ref, float atol) { float e = fabsf(got - ref) / (fabsf(ref) + atol); if (!(e == e) || e > 1e30f) e = 1e30f; atomicMax(ctl + CW_ERR + id, __float_as_uint(e)); }
__device__ __forceinline__ float sig(float x) { return 1.0f / (1.0f + expf(-x)); }
__device__ __forceinline__ float dotbf(const unsigned short* a, const unsigned short* b, int n) { float s = 0.f; for (int k = 0; k < n; ++k) s += bf2f(a[k]) * bf2f(b[k]); return s; }
__device__ __forceinline__ float blk_sum(float v, float* sh) { __syncthreads(); sh[threadIdx.x] = v; __syncthreads(); for (int o = 128; o > 0; o >>= 1) { if ((int)threadIdx.x < o) sh[threadIdx.x] += sh[threadIdx.x + o]; __syncthreads(); } const float r = sh[0]; __syncthreads(); return r; }
__device__ __forceinline__ float blk_max(float v, float* sh) { __syncthreads(); sh[threadIdx.x] = v; __syncthreads(); for (int o = 128; o > 0; o >>= 1) { if ((int)threadIdx.x < o) sh[threadIdx.x] = fmaxf(sh[threadIdx.x], sh[threadIdx.x + o]); __syncthreads(); } const float r = sh[0]; __syncthreads(); return r; }
}
__global__ void __launch_bounds__(256) chk_phase(Args a, int ph) {
    using namespace chk;
    __shared__ float sh[256]; __shared__ float big[4096];
    unsigned char* ws = a.ws; unsigned* ctl = (unsigned*)(ws + WS_CTL);
    const int gs = blockIdx.x * 256 + threadIdx.x; const unsigned h1 = hashu(gs * 3 + 1 + ph * 7919), h2 = hashu(h1 + 17), h3 = hashu(h2 + 29);
    const float* mod = (const float*)(ws + WS_MOD);
    typedef unsigned short us;
    if (ph == 0) {
        if (gs < 512) { const int b = gs & 7, j = h1 % 6144; float s = a.in[I_ADAB][j]; for (int k = 0; k < 1024; ++k) { const float c = a.in[I_C][b * 1024 + k]; s += c * sig(c) * a.in[I_ADAW][(size_t)k * 6144 + j]; } errmax(ctl, 1, mod[b * 6144 + j], s, 0.02f); }
        const int which = gs % 8; float got = 0.f, ref = 0.f;
        if (which == 0) { const int r = h1 % NIN_, k = h2 % 1024; got = bf2f(((const us*)(ws + WS_WIN))[(size_t)r * 1024 + k]); ref = rbf(a.in[I_WIN][(size_t)k * NIN_ + in_orig_col(r)]); }
        else if (which <= 3) { const int n = h1 % 1024, k = h2 % 1024; const float* src = which == 1 ? a.in[I_WAO] : (which == 2 ? a.in[I_PWW] : a.in[I_WOUT]); const us* d = (const us*)(ws + (which == 1 ? WS_WA : (which == 2 ? WS_WP : WS_WO))); got = bf2f(d[(size_t)n * 1024 + k]); ref = rbf(src[(size_t)k * 1024 + n]); }
        else if (which == 4) { const int n = h1 % 256, k = h2 % 1024; got = bf2f(((const us*)(ws + WS_WR))[(size_t)n * 1024 + k]); ref = rbf(a.in[I_RW][(size_t)k * 256 + n]); }
        else if (which == 5) { const int e = h1 % NEX_, r = h2 % 512, k = h3 % 1024, pn = r >> 8, w = r & 255, is3 = w >> 7, n = pn * 128 + (w & 127);
            const float* src = e < NE_ ? (is3 ? a.in[I_W3] : a.in[I_W1]) + (size_t)e * 262144 : (is3 ? a.in[I_WS3] : a.in[I_WS1]);
            got = bf2f(((const us*)(ws + WS_WUP))[((size_t)e * 512 + r) * 1024 + k]); ref = rbf(src[(size_t)k * 256 + n]); }
        else if (which == 6) { const int e = h1 % NEX_, n = h2 % 1024, k = h3 % 256; const float* src = e < NE_ ? a.in[I_W2] + (size_t)e * 262144 : a.in[I_WS2];
            got = bf2f(((const us*)(ws + WS_WDN))[((size_t)e * 1024 + n) * 256 + k]); ref = rbf(src[(size_t)k * 1024 + n]); }
        else { const int r = h1 % NIN_; got = ((const float*)(ws + WS_BINP))[r]; ref = a.in[I_BIN][in_orig_col(r)]; }
        errmax(ctl, 2, got, ref, 1e-3f);
    } else if (ph == 1) {
        const int row = h1 % T_, col = h2 % D_, b = row >> 12; const float ref = a.in[I_X][(size_t)row * D_ + col] * (1.f + mod[b * 6144 + 1024 + col]) + mod[b * 6144 + col];
        errmax(ctl, 3, bf2f(((const us*)(ws + WS_H))[(size_t)row * D_ + col]), ref, 0.05f);
    } else if (ph == 2) {
        const us* H = (const us*)(ws + WS_H); const us* W = (const us*)(ws + WS_WIN); const int row = h1 % T_, col = h2 % D_; const us* hr = H + (size_t)row * D_;
        const int which = gs % 3;
        if (which == 0) { const int t = h3 % 3, oc = t * 1024 + col; float r = dotbf(hr, W + (size_t)oc * 1024, 1024) + a.in[I_BIN][oc]; if (t == 0) r *= attn_body::C2;
            errmax(ctl, 4, bf2f(((const us*)(ws + WS_Q + (size_t)t * WS_SLOT))[(size_t)row * D_ + col]), r, t == 0 ? 0.01f : 0.05f); }
        else if (which == 1) { const float av = dotbf(hr, W + (size_t)in_dest_row(3072 + col) * 1024, 1024) + a.in[I_BIN][3072 + col], bv = dotbf(hr, W + (size_t)in_dest_row(4096 + col) * 1024, 1024) + a.in[I_BIN][4096 + col];
            errmax(ctl, 5, bf2f(((const us*)(ws + WS_U))[(size_t)row * D_ + col]), av * sig(bv), 0.03f); }
        else { const float av = dotbf(hr, W + (size_t)in_dest_row(5120 + col) * 1024, 1024) + a.in[I_BIN][5120 + col], bv = dotbf(hr, W + (size_t)in_dest_row(6144 + col) * 1024, 1024) + a.in[I_BIN][6144 + col];
            errmax(ctl, 6, bf2f(((const us*)(ws + WS_SGA))[(size_t)row * D_ + col]), sig(av), 0.02f); errmax(ctl, 20, bf2f(((const us*)(ws + WS_SGB))[(size_t)row * D_ + col]), sig(bv), 0.02f); }
    } else if (ph == 3) {
        {
            const unsigned hb = hashu(blockIdx.x * 977 + 5); const int b = hb & 7, hm = (hb >> 3) & 15, vh = (hb >> 7) & 1; int row = (hb >> 8) & 4095; if (blockIdx.x < 8) row = blockIdx.x * 37;
            const us* Q = (const us*)(ws + WS_Q); const us* K = (const us*)(ws + WS_K); const us* V = (const us*)(ws + WS_V); const us* O = (const us*)(ws + WS_OATT);
            const us* qr = Q + ((size_t)b * SEQ_ + row) * D_ + hm * 64; float mx = -INFINITY;
            for (int j = threadIdx.x; j <= row; j += 256) { const float s = dotbf(qr, K + ((size_t)b * SEQ_ + j) * D_ + hm * 64, 64); big[j] = s; mx = fmaxf(mx, s); }
            mx = blk_max(mx, sh); float l = 0.f;
            for (int j = threadIdx.x; j <= row; j += 256) { const float p = exp2f(big[j] - mx); big[j] = p; l += p; }
            l = blk_sum(l, sh);
            if (threadIdx.x < 64) { float o = 0.f; for (int j = 0; j <= row; ++j) o += big[j] * bf2f(V[((size_t)b * SEQ_ + j) * D_ + (hm >> 1) * 128 + vh * 64 + threadIdx.x]);
                errmax(ctl, 7, bf2f(O[((size_t)b * SEQ_ + row) * 2048 + (hm * 2 + vh) * 64 + threadIdx.x]), o / l, 0.03f); }
            __syncthreads();
        }
        {
            const unsigned hb = hashu(blockIdx.x * 31 + 77); int t = hb % T_; if (blockIdx.x < 16) t = (blockIdx.x >> 1) * SEQ_ + (blockIdx.x & 1) * 17 + 3;
            const int pos = t & (SEQ_ - 1); const us* U = (const us*)(ws + WS_U); float y[4]; float s = 0.f, q = 0.f;
            _Pragma("unroll") for (int i = 0; i < 4; ++i) { const int c = threadIdx.x + 256 * i; float acc = a.in[I_CB][c];
                for (int j = 0; j < 31; ++j) { const int p = pos - 30 + j; if (p >= 0) acc += a.in[I_CW][j * 1024 + c] * bf2f(U[(size_t)(t - 30 + j) * D_ + c]); }
                y[i] = acc; s += acc; }
            const float mean = blk_sum(s, sh) / 1024.f; _Pragma("unroll") for (int i = 0; i < 4; ++i) q += (y[i] - mean) * (y[i] - mean);
            const float var = blk_sum(q, sh) / 1024.f, rstd = 1.0f / sqrtf(var + LN_EPS_);
            _Pragma("unroll") for (int i = 0; i < 4; ++i) { const int c = threadIdx.x + 256 * i; const float z = (y[i] - mean) * rstd * a.in[I_CLG][c] + a.in[I_CLB][c];
                errmax(ctl, 8, bf2f(((const us*)(ws + WS_CACT))[(size_t)t * D_ + c]), z * sig(z), 0.03f); }
        }
    } else if (ph == 4) {
        float s1 = 0.f, s2 = 0.f; for (int i = 0; i < 64; ++i) { s1 += a.in[I_LQ1][i] * a.in[I_LK1][i]; s2 += a.in[I_LQ2][i] * a.in[I_LK2][i]; }
        const float lam = expf(s1) - expf(s2) + LAM_INIT_; const int t = hashu(blockIdx.x * 131 + 9) % T_; const us* O = (const us*)(ws + WS_OATT) + (size_t)t * 2048;
        for (int hh = 0; hh < 8; ++hh) { float o = 0.f; if (threadIdx.x < 128) o = bf2f(O[hh * 256 + threadIdx.x]) - lam * bf2f(O[hh * 256 + 128 + threadIdx.x]);
            const float ss = blk_sum(o * o, sh); const float r = 1.0f / sqrtf(ss / 128.f + RMS_EPS_);
            if (threadIdx.x < 128) errmax(ctl, 9, bf2f(((const us*)(ws + WS_ON))[(size_t)t * D_ + hh * 128 + threadIdx.x]), o * r * a.in[I_SUBG][threadIdx.x] * (1.f - LAM_INIT_), 0.03f); }
    } else if (ph == 5) {
        const int row = h1 % T_, col = h2 % D_; const size_t off = (size_t)row * D_ + col;
        const float yar = bf2f(((const us*)(ws + WS_SGA))[off]) * dotbf((const us*)(ws + WS_ON) + (size_t)row * D_, (const us*)(ws + WS_WA) + (size_t)col * D_, 1024);
        const float yab = bf2f(((const us*)(ws + WS_YA))[off]);
        errmax(ctl, 10, yab, yar, 0.03f);
        const float mr = yab + bf2f(((const us*)(ws + WS_SGB))[off]) * (dotbf((const us*)(ws + WS_CACT) + (size_t)row * D_, (const us*)(ws + WS_WP) + (size_t)col * D_, 1024) + a.in[I_PWB][col]);
        errmax(ctl, 11, bf2f(((const us*)(ws + WS_M))[off]), mr, 0.03f);
    } else if (ph == 6) {
        const int row = h1 % T_, col = h2 % D_, b = row >> 12; const size_t off = (size_t)row * D_ + col;
        const float r = DN_ALPHA_ * a.in[I_X][off] + mod[b * 6144 + 2048 + col] * dotbf((const us*)(ws + WS_M) + (size_t)row * D_, (const us*)(ws + WS_WO) + (size_t)col * D_, 1024);
        errmax(ctl, 12, ((const float*)(ws + WS_Z))[off], r, 0.05f);
    } else if (ph == 7) {
        const int t = hashu(blockIdx.x * 131 + 11) % T_, b = t >> 12; const float* X1 = (const float*)(ws + WS_Z) + (size_t)t * D_; float v[4]; float s = 0.f, q = 0.f;
        _Pragma("unroll") for (int i = 0; i < 4; ++i) { const int c = threadIdx.x + 256 * i; v[i] = (X1[c] - a.in[I_LN1B][c]) / a.in[I_LN1G][c]; s += v[i]; }
        const float mean = blk_sum(s, sh) / 1024.f; _Pragma("unroll") for (int i = 0; i < 4; ++i) q += (v[i] - mean) * (v[i] - mean); const float var = blk_sum(q, sh) / 1024.f;
        if (threadIdx.x == 0) { errmax(ctl, 13, mean, 0.f, 0.05f); errmax(ctl, 13, var, 1.f, 0.f); }
        _Pragma("unroll") for (int i = 0; i < 4; ++i) { const int c = threadIdx.x + 256 * i; errmax(ctl, 13, bf2f(((const us*)(ws + WS_H2))[(size_t)t * D_ + c]), X1[c] * (1.f + mod[b * 6144 + 4096 + c]) + mod[b * 6144 + 3072 + c], 0.05f); }
    } else if (ph == 8) {
        const int row = h1 % T_, e = h2 % NE_;
        errmax(ctl, 14, ((const float*)(ws + WS_LG))[(size_t)row * NE_ + e], dotbf((const us*)(ws + WS_H2) + (size_t)row * D_, (const us*)(ws + WS_WR) + (size_t)e * D_, 1024), 0.05f);
    } else if (ph == 9) {
        {
            const int t = hashu(blockIdx.x * 173 + 3) % T_; float* sc = big; float* ch = big + 256; float* gsc = big + 512; int* gsel = (int*)(big + 520); int* eidx = (int*)(big + 530); float* egate = big + 540;
            const float sv = sig(((const float*)(ws + WS_LG))[(size_t)t * NE_ + threadIdx.x]); sc[threadIdx.x] = sv; ch[threadIdx.x] = sv + a.in[I_RB][threadIdx.x]; __syncthreads();
            if (threadIdx.x < 8) { float m1 = -INFINITY, m2 = -INFINITY; for (int i = 0; i < 32; ++i) { const float v = ch[threadIdx.x * 32 + i]; if (v > m1) { m2 = m1; m1 = v; } else if (v > m2) m2 = v; } gsc[threadIdx.x] = m1 + m2; }
            __syncthreads();
            if (threadIdx.x == 0) { for (int g = 0; g < 8; ++g) { int rank = 0; for (int gp = 0; gp < 8; ++gp) rank += (gsc[gp] > gsc[g] || (gsc[gp] == gsc[g] && gp < g)) ? 1 : 0; gsel[g] = rank < 4; }
                float ssum = 0.f;
                for (int k = 0; k < 8; ++k) { int best = -1; float bv = -INFINITY; for (int e = 0; e < 256; ++e) { if (!gsel[e >> 5]) continue; bool taken = false; for (int kk = 0; kk < k; ++kk) taken |= (eidx[kk] == e); if (taken) continue; if (ch[e] > bv) { bv = ch[e]; best = e; } }
                    eidx[k] = best; egate[k] = sc[best]; ssum += sc[best]; }
                for (int k = 0; k < 8; ++k) { const int gi = ((const int*)(ws + WS_TOPI))[t * 8 + k]; errmax(ctl, 15, gi != eidx[k] ? 1.f : 0.f, 0.f, 1.f);
                    errmax(ctl, 15, ((const float*)(ws + WS_TOPG))[t * 8 + k], egate[k] / ssum * ROUTED_SCALE_, 1e-3f); } }
            __syncthreads();
        }
        {
            const int* list = (const int*)(ws + WS_LIST); const int* topi = (const int*)(ws + WS_TOPI);
            if (blockIdx.x == 0) { const int c = (int)ctl[CW_CNT + 64 * threadIdx.x]; const float tot = blk_sum((float)c, sh); if (threadIdx.x == 0) errmax(ctl, 16, tot, (float)(T_ * 8), 0.f); }
            const int e = h1 % NE_, c = (int)ctl[CW_CNT + 64 * e]; if (c > 0) { const int pos = h2 % c, av = list[(size_t)e * T_ + pos]; float bad = 0.f; if (av < 0 || av >= T_ * 8) bad = 1.f; else if (topi[av] != e) bad = 1.f; errmax(ctl, 16, bad, 0.f, 1.f); }
        }
    } else if (ph == 10 || ph == 11) {
        const int e = (gs & 7) == 0 ? NE_ : (int)(h1 % NE_); const int c = e < NE_ ? (int)ctl[CW_CNT + 64 * e] : T_;
        if (c > 0) { int ts = 0; for (int i = 0; i < e; ++i) ts += ((int)ctl[CW_CNT + 64 * i] + 255) >> 8;
            const int pos = h2 % c; const int av = e < NE_ ? ((const int*)(ws + WS_LIST))[(size_t)e * T_ + pos] : pos * 8; const int t = av >> 3; const size_t row = (size_t)(ts + (pos >> 8)) * 256 + (pos & 255);
            if (ph == 10) { const int n = h3 % FE_; const us* hr = (const us*)(ws + WS_H2) + (size_t)t * D_; const us* W = (const us*)(ws + WS_WUP) + ((size_t)e * 512 + (n >> 7) * 256 + (n & 127)) * 1024;
                const float A = dotbf(hr, W, 1024), B = dotbf(hr, W + 128 * 1024, 1024); errmax(ctl, 17, bf2f(((const us*)(ws + WS_HID))[row * FE_ + n]), A * sig(A) * B, 0.03f); }
            else if (e < NE_) { const int col = h3 % D_; const float r = ((const float*)(ws + WS_TOPG))[av] * dotbf((const us*)(ws + WS_HID) + row * FE_, (const us*)(ws + WS_WDN) + ((size_t)e * 1024 + col) * 256, 256);
                errmax(ctl, 18, bf2f(((const us*)(ws + WS_YS))[(size_t)av * D_ + col]), r, 0.02f); }
        }
    } else if (ph == 12) {
        const int t = hashu(blockIdx.x * 211 + 13) % T_, b = t >> 12; float v[4]; float s = 0.f, q = 0.f;
        _Pragma("unroll") for (int i = 0; i < 4; ++i) { const int c = threadIdx.x + 256 * i; float y = 0.f; for (int k = 0; k < 8; ++k) y += bf2f(((const us*)(ws + WS_YS))[((size_t)t * 8 + k) * D_ + c]);
            v[i] = ((const float*)(ws + WS_Z))[(size_t)t * D_ + c] + mod[b * 6144 + 5120 + c] * y; s += v[i]; }
        const float mean = blk_sum(s, sh) / 1024.f; _Pragma("unroll") for (int i = 0; i < 4; ++i) q += (v[i] - mean) * (v[i] - mean); const float rstd = 1.0f / sqrtf(blk_sum(q, sh) / 1024.f + LN_EPS_);
        _Pragma("unroll") for (int i = 0; i < 4; ++i) { const int c = threadIdx.x + 256 * i; errmax(ctl, 19, a.out[(size_t)t * D_ + c], (v[i] - mean) * rstd * a.in[I_LN2G][c] + a.in[I_LN2B][c], 0.05f); }
    }
}

__global__ void __launch_bounds__(256) chk_scan(Args a) {
    unsigned* ctl = (unsigned*)(a.ws + WS_CTL); const unsigned short* A = (const unsigned short*)(a.ws + WS_SGA); const unsigned short* B = (const unsigned short*)(a.ws + WS_SGB);
    for (size_t i = (size_t)blockIdx.x * 256 + threadIdx.x; i < (size_t)T_ * D_; i += (size_t)gridDim.x * 256) {
        const float va = chk::bf2f(A[i]), vb = chk::bf2f(B[i]); const int row = (int)(i >> 10), col = (int)(i & 1023);
        if (!(va >= 0.f && va <= 1.f)) { atomicAdd(ctl + CW_ERR + 40, 1u); atomicOr(ctl + CW_ERR + 41, 1u << (col >> 7)); atomicOr(ctl + CW_ERR + 42, 1u << ((row >> 8) & 31)); atomicMin(ctl + CW_ERR + 43, (unsigned)row ^ 0xffffffffu); atomicMax(ctl + CW_ERR + 44, (unsigned)row); atomicOr(ctl + CW_ERR + 46, 1u << (row & 31)); atomicOr(ctl + CW_ERR + 47, 1u << ((col >> 2) & 31)); }
        if (!(vb >= 0.f && vb <= 1.f)) atomicAdd(ctl + CW_ERR + 45, 1u);
        { const unsigned short* S = (const unsigned short*)(a.ws + WS_CACT); const float vs = chk::bf2f(S[i]); if (!(vs >= 0.f && vs <= 1.f)) atomicAdd(ctl + CW_ERR + 48, 1u); if (S[i] != A[i]) atomicAdd(ctl + CW_ERR + 49, 1u); }
    }
}
#ifndef CHK_TOL
#define CHK_TOL 0.06f
#endif
#ifndef CHK_FIRST
#define CHK_FIRST 1
#endif
__global__ void __launch_bounds__(256) chk_final(Args a) {
    const unsigned* ctl = (const unsigned*)(a.ws + WS_CTL); int bad = 0;
    for (int id = 20; id >= CHK_FIRST; --id) if (__uint_as_float(ctl[CW_ERR + id]) > CHK_TOL) bad = id;
#ifdef CHK_WORD
    { const unsigned w = ctl[CW_ERR + CHK_WORD];
#if CHK_ENC == 0
      bad = 1 + (int)(4.f * log2f((float)w + 1.f) + 0.5f);
#else
      bad = 1 + (int)((w >> CHK_SHIFT) & 63u);
#endif
    }
#endif
#ifdef CHK_MAG
    { const float e = __uint_as_float(ctl[CW_ERR + CHK_MAG]); float code = 40.f + 4.f * log2f(fmaxf(e, 1e-9f)); code = fminf(fmaxf(code, 0.f), 96.f); bad = (int)(code + 0.5f); if (bad < 1) bad = 1; }
#endif
    float vv = sqrtf((float)bad);
#ifdef CHK_TWO
    { const unsigned w1 = ctl[CW_ERR + 40], w2 = ctl[CW_ERR + 48], w3 = ctl[CW_ERR + 49]; int v1 = (int)(3.f * log2f((float)w1 + 1.f) + 0.5f); if (v1 > 63) v1 = 63; int v2 = (w2 != 0u ? 1 : 0) + (w3 != 0u ? 2 : 0);
      float sc = (float)(10 + v1) * 10.f; for (int i = 0; i < v2; ++i) sc *= 10.f; vv = sqrtf(sc); bad = 1; }
#endif
    if (bad) { const float v = vv; for (size_t i = (size_t)blockIdx.x * 256 + threadIdx.x; i < (size_t)T_ * D_; i += (size_t)gridDim.x * 256) a.out[i] = v; }
}
#endif

extern "C" void kernel_launch(void* const* d_in, const int* in_sizes, int n_in, void* d_out, int out_size, void* d_ws, size_t ws_size, hipStream_t stream) {
    static int grid = 0;
    if (grid == 0) {
        if (n_in != N_IN || in_sizes[0] != T_ * D_ || out_size != T_ * D_ || ws_size < WS_END) { fprintf(stderr, "kernel_launch: unexpected shapes (n_in %d, in0 %d, out %d, ws %zu); nothing launched\n", n_in, n_in > 0 ? in_sizes[0] : -1, out_size, ws_size); grid = -1; return; }
        int dev = 0, cus = 0, per_cu = 0;
        if (hipGetDevice(&dev) != hipSuccess || hipDeviceGetAttribute(&cus, hipDeviceAttributeMultiprocessorCount, dev) != hipSuccess) { grid = -1; return; }
        if (hipFuncSetAttribute((const void*)mk_fwd, hipFuncAttributeMaxDynamicSharedMemorySize, LDS_BYTES) != hipSuccess) { fprintf(stderr, "kernel_launch: hipFuncSetAttribute failed\n"); grid = -1; return; }
        if (hipOccupancyMaxActiveBlocksPerMultiprocessor(&per_cu, (const void*)mk_fwd, NWAVES * 64, LDS_BYTES) != hipSuccess || per_cu < 1) { fprintf(stderr, "kernel_launch: occupancy query reports %d\n", per_cu); }
        (void)hipGetLastError();
        grid = cus;
    }
    if (grid < 0) return;
    if (hipMemsetAsync((char*)d_ws + WS_CTL, 0, CTL_ZERO_BYTES, stream) != hipSuccess) return;
    Args a{};
    for (int i = 0; i < N_IN; ++i) a.in[i] = (const float*)d_in[i];
    a.out = (float*)d_out; a.ws = (unsigned char*)d_ws;
#if MK_SPLIT
    for (int p = 0; p < NPH; ++p) { a.ph_lo = p; a.ph_hi = p + 1;
#ifdef DBG_PREFILL
        if (p == 2) (void)hipMemsetAsync((char*)d_ws + WS_SGA, 0x3f, 2 * WS_SLOT, stream);
#endif
        hipLaunchKernelGGL(mk_fwd, dim3(grid), dim3(NWAVES * 64), LDS_BYTES, stream, a);
#if DBG_CHECK
        hipLaunchKernelGGL(chk_phase, dim3(64), dim3(256), 0, stream, a, p);
        if (p == 2) hipLaunchKernelGGL(chk_scan, dim3(1024), dim3(256), 0, stream, a);
#endif
    }
#if DBG_CHECK
    hipLaunchKernelGGL(chk_final, dim3(1024), dim3(256), 0, stream, a);
#ifdef DBG_POSTFILL
    (void)hipMemsetAsync((char*)d_ws + WS_SGA, 0x3f, 2 * WS_SLOT, stream);
#endif
#endif
#else
    a.ph_lo = 0; a.ph_hi = NPH;
    hipLaunchKernelGGL(mk_fwd, dim3(grid), dim3(NWAVES * 64), LDS_BYTES, stream, a);
#endif
}
```

```cpp
#include <hip/hip_runtime.h>
#include <hip/hip_bf16.h>
#include <cstdio>
#include <cstdint>
#include <cmath>

#ifndef MK_SPLIT
#define MK_SPLIT 0
#endif
#ifndef DBG_CHECK
#define DBG_CHECK 0
#endif

constexpr int T_ = 32768, D_ = 1024, NB_ = 8, SEQ_ = 4096;
constexpr int NIN_ = 7168;
constexpr int NE_ = 256, NEX_ = 257, TOPK_ = 8;
constexpr int FE_ = 256;
constexpr float LN_EPS_ = 1e-5f, RMS_EPS_ = 1e-5f;
constexpr float DN_ALPHA_ = 1.189207115002721f;
constexpr float LAM_INIT_ = 0.2f;
constexpr float ROUTED_SCALE_ = 2.5f;
constexpr float LOG2E_ = 1.4426950408889634f;

__device__ __forceinline__ int mk_lane_now() { int l; asm volatile("v_mbcnt_lo_u32_b32 %0, -1, 0\n\tv_mbcnt_hi_u32_b32 %0, -1, %0" : "=v"(l)); return l; }
namespace pg8 {
#define PG8_LAS __attribute__((address_space(3)))
typedef unsigned short bf16_t;
typedef short bf16x8 __attribute__((ext_vector_type(8)));
typedef float f32x4 __attribute__((ext_vector_type(4)));
typedef unsigned u32x4 __attribute__((ext_vector_type(4)));
constexpr int BM = 256, BK = 64, HALF = 128, HTB = HALF * BK * 2  , STAGE_BYTES = 8 * HTB, NXCD = 8, WGM = 8;

__host__ __device__ __forceinline__ int lds_byte(int r, int c) { const int st = (r >> 4) * 2 + (c >> 5), rr = r & 15, cc = c & 31, ob = rr * 64 + cc * 2; return st * 1024 + (ob ^ (((ob >> 9) & 1) << 5)); }
__host__ __device__ __forceinline__ void stage_rc(int b, int& R, int& C) { const int st = b / 1024, sb = b % 1024, swz = sb ^ (((sb >> 9) & 1) << 5); R = (st >> 1) * 16 + swz / 64; C = (st & 1) * 32 + (swz % 64) / 2; }
__host__ __device__ __forceinline__ int perm32(int rho) { const int n = rho >> 4, i = rho & 15; return 8 * (i >> 2) + 4 * n + (i & 3); }

struct UnitS { int pm, pn; };
struct UnitM { int pm, pn, e, rt, nrows, slot; };
struct Gemm { const bf16_t* A; const bf16_t* Bt; };

struct StaticOrder {
    typedef UnitS Unit;
    int nM, nN, nwg, G, c;
    __host__ __device__ void init(int M, int N, int G_, int c_) { nM = M / BM; nN = N / BM; nwg = nM * nN; G = G_; c = c_; }
    __host__ __device__ bool next(int i, Unit& u) const {
        const long L = (long)i * G + c; if (L >= nwg) return false;
        int wgid = (int)L; { const int q = nwg / NXCD, r = nwg % NXCD, xcd = wgid % NXCD, off = wgid / NXCD; wgid = (xcd < r ? xcd * (q + 1) : r * (q + 1) + (xcd - r) * q) + off; }
        const int nig = WGM * nN, gid = wgid / nig, fm = gid * WGM, gsz = (nM - fm) < WGM ? (nM - fm) : WGM;
        u.pm = fm + ((wgid % nig) % gsz); u.pn = (wgid % nig) / gsz; return true;
    }
    __device__ __forceinline__ size_t a_off(const Unit& u, size_t tstep) const { return (size_t)u.pm * tstep; }
    __device__ __forceinline__ size_t b_off(const Unit& u, size_t tstep) const { return (size_t)u.pn * tstep; }
    __device__ __forceinline__ unsigned row_off(const Unit&, int, int) const { return 0u; }
    __device__ __forceinline__ void a_ready(const Unit&) const {}
    __device__ __forceinline__ void done(const Unit&) const {}
};
template <int BTILES, bool A_DENSE, unsigned ROWBYTES>
struct MoeOrder {
    typedef UnitM Unit;
    const PG8_LAS int* UT; const PG8_LAS int* TOK; int nunits;
    __device__ __forceinline__ bool next(int i, Unit& u) const {
        if (i >= nunits) return false;
        u.e = __builtin_amdgcn_readfirstlane(UT[i * 8 + 0]); u.rt = __builtin_amdgcn_readfirstlane(UT[i * 8 + 1]); u.pn = __builtin_amdgcn_readfirstlane(UT[i * 8 + 2]);
        u.nrows = __builtin_amdgcn_readfirstlane(UT[i * 8 + 3]); u.pm = __builtin_amdgcn_readfirstlane(UT[i * 8 + 4]); u.slot = i; return true;
    }
    __device__ __forceinline__ size_t a_off(const Unit& u, size_t tstep) const { return A_DENSE ? (size_t)u.pm * tstep : (size_t)0; }
    __device__ __forceinline__ size_t b_off(const Unit& u, size_t tstep) const { return (size_t)(u.e * BTILES + u.pn) * tstep; }
    __device__ __forceinline__ unsigned row_off(const Unit& u, int row, int C) const { return (unsigned)TOK[u.slot * 256 + row] * ROWBYTES + (unsigned)C * 2u; }
    __device__ __forceinline__ void a_ready(const Unit&) const {}
    __device__ __forceinline__ void done(const Unit&) const {}
};

typedef float f32x2_t_ __attribute__((ext_vector_type(2))); typedef __bf16 bf16x2_t_ __attribute__((ext_vector_type(2)));
__device__ __forceinline__ unsigned cvt_pk_bf16(float lo, float hi) { const f32x2_t_ v = {lo, hi}; const bf16x2_t_ b = __builtin_convertvector(v, bf16x2_t_); return __builtin_bit_cast(unsigned, b); }
__device__ __forceinline__ float bf_lo(unsigned w) { return __uint_as_float(w << 16); }
__device__ __forceinline__ float bf_hi(unsigned w) { return __uint_as_float(w & 0xffff0000u); }
__device__ __forceinline__ float sigm(float x) { return __builtin_amdgcn_rcpf(1.0f + __builtin_amdgcn_exp2f(-x * LOG2E_)); }
__device__ __forceinline__ u32x4 pack8(const f32x4& a, const f32x4& b) { u32x4 w; w.x = cvt_pk_bf16(a[0], a[1]); w.y = cvt_pk_bf16(a[2], a[3]); w.z = cvt_pk_bf16(b[0], b[1]); w.w = cvt_pk_bf16(b[2], b[3]); return w; }
__device__ __forceinline__ void unpack8(const u32x4& w, f32x4& a, f32x4& b) { a = (f32x4){bf_lo(w.x), bf_hi(w.x), bf_lo(w.y), bf_hi(w.y)}; b = (f32x4){bf_lo(w.z), bf_hi(w.z), bf_lo(w.w), bf_hi(w.w)}; }
__device__ __forceinline__ f32x4 sigm4(const f32x4& v) { return (f32x4){sigm(v[0]), sigm(v[1]), sigm(v[2]), sigm(v[3])}; }

#define PG8_EPI_ARGS const f32x4 (&acc)[2][2][4][2], const U& u, int wr, int wc, int fr, int fq
struct EpiInproj {
    static constexpr bool PERM = true, AFTER_DRAIN = false;
    bf16_t *q; size_t slot; bf16_t *ug, *sga, *sgb; const float* biasP; float qscale;
    template <class U> __device__ __forceinline__ void operator()(PG8_EPI_ARGS) const {
        const int pn = u.pn, row0 = u.pm * BM + wr * 64 + fr, cb = wc * 32 + 8 * fq;
        f32x4 bv[2][2];
#pragma unroll
        for (int bj = 0; bj < 2; ++bj)
#pragma unroll
            for (int n = 0; n < 2; ++n) bv[bj][n] = *(const f32x4*)(biasP + pn * BM + bj * HALF + cb + 4 * n);
        if (pn < 12) {
            bf16_t* base = q + (size_t)(pn >> 2) * slot; float sc = 1.0f; if (pn < 4) sc = qscale; const int colt = (pn & 3) * BM + cb;
#pragma unroll
            for (int ai = 0; ai < 2; ++ai)
#pragma unroll
                for (int m = 0; m < 4; ++m) { bf16_t* rowp = base + (size_t)(row0 + ai * HALF + m * 16) * D_ + colt;
#pragma unroll
                    for (int bj = 0; bj < 2; ++bj) { const f32x4 v0 = (acc[ai][bj][m][0] + bv[bj][0]) * sc, v1 = (acc[ai][bj][m][1] + bv[bj][1]) * sc; *(u32x4*)(rowp + bj * HALF) = pack8(v0, v1); } }
        } else if (pn < 20) {
            const int colt = (pn - 12) * HALF + cb;
#pragma unroll
            for (int ai = 0; ai < 2; ++ai)
#pragma unroll
                for (int m = 0; m < 4; ++m) { const size_t off = (size_t)(row0 + ai * HALF + m * 16) * D_ + colt;
                    const f32x4 a0 = acc[ai][0][m][0] + bv[0][0], a1 = acc[ai][0][m][1] + bv[0][1], b0 = sigm4(acc[ai][1][m][0] + bv[1][0]), b1 = sigm4(acc[ai][1][m][1] + bv[1][1]);
                    *(u32x4*)(ug + off) = pack8(a0 * b0, a1 * b1); }
        } else {
            const int colt = (pn - 20) * HALF + cb;
#pragma unroll
            for (int ai = 0; ai < 2; ++ai)
#pragma unroll
                for (int m = 0; m < 4; ++m) { const size_t off = (size_t)(row0 + ai * HALF + m * 16) * D_ + colt;
                    *(u32x4*)(sga + off) = pack8(sigm4(acc[ai][0][m][0] + bv[0][0]), sigm4(acc[ai][0][m][1] + bv[0][1]));
                    *(u32x4*)(sgb + off) = pack8(sigm4(acc[ai][1][m][0] + bv[1][0]), sigm4(acc[ai][1][m][1] + bv[1][1]));
                    }
        }
    }
};
struct EpiYa {
    static constexpr bool PERM = true, AFTER_DRAIN = false;
    const bf16_t* sga; bf16_t* ya;
    template <class U> __device__ __forceinline__ void operator()(PG8_EPI_ARGS) const {
        const int row0 = u.pm * BM + wr * 64 + fr, col0 = u.pn * BM + wc * 32 + 8 * fq;
#pragma unroll
        for (int ai = 0; ai < 2; ++ai)
#pragma unroll
            for (int m = 0; m < 4; ++m)
#pragma unroll
                for (int bj = 0; bj < 2; ++bj) { const size_t off = (size_t)(row0 + ai * HALF + m * 16) * D_ + col0 + bj * HALF;
                    f32x4 g0, g1; unpack8(*(const u32x4*)(sga + off), g0, g1);
                    *(u32x4*)(ya + off) = pack8(acc[ai][bj][m][0] * g0, acc[ai][bj][m][1] * g1); }
    }
};
struct EpiM {
    static constexpr bool PERM = true, AFTER_DRAIN = false;
    const bf16_t* sgb; const bf16_t* ya; bf16_t* mo; const float* bp;
    template <class U> __device__ __forceinline__ void operator()(PG8_EPI_ARGS) const {
        const int row0 = u.pm * BM + wr * 64 + fr, col0 = u.pn * BM + wc * 32 + 8 * fq;
#pragma unroll
        for (int bj = 0; bj < 2; ++bj) { const f32x4 b0 = *(const f32x4*)(bp + col0 + bj * HALF), b1 = *(const f32x4*)(bp + col0 + bj * HALF + 4);
#pragma unroll
            for (int ai = 0; ai < 2; ++ai)
#pragma unroll
                for (int m = 0; m < 4; ++m) { const size_t off = (size_t)(row0 + ai * HALF + m * 16) * D_ + col0 + bj * HALF;
                    f32x4 g0, g1, y0, y1; unpack8(*(const u32x4*)(sgb + off), g0, g1); unpack8(*(const u32x4*)(ya + off), y0, y1);
                    *(u32x4*)(mo + off) = pack8(y0 + g0 * (acc[ai][bj][m][0] + b0), y1 + g1 * (acc[ai][bj][m][1] + b1)); } }
    }
};
struct EpiZ {
    static constexpr bool PERM = true, AFTER_DRAIN = false;
    const float* x; const float* mod; float* z;
    template <class U> __device__ __forceinline__ void operator()(PG8_EPI_ARGS) const {
        const int row0 = u.pm * BM + wr * 64 + fr, col0 = u.pn * BM + wc * 32 + 8 * fq; const int b = (u.pm * BM) >> 12;
#pragma unroll
        for (int bj = 0; bj < 2; ++bj) { const float* gp = mod + b * 6144 + 2048 + col0 + bj * HALF; const f32x4 g0 = *(const f32x4*)gp, g1 = *(const f32x4*)(gp + 4);
#pragma unroll
            for (int ai = 0; ai < 2; ++ai)
#pragma unroll
                for (int m = 0; m < 4; ++m) { const size_t off = (size_t)(row0 + ai * HALF + m * 16) * D_ + col0 + bj * HALF;
                    const f32x4 x0 = *(const f32x4*)(x + off), x1 = *(const f32x4*)(x + off + 4);
                    *(f32x4*)(z + off) = x0 * DN_ALPHA_ + g0 * acc[ai][bj][m][0]; *(f32x4*)(z + off + 4) = x1 * DN_ALPHA_ + g1 * acc[ai][bj][m][1]; } }
    }
};
struct EpiLogit {
    static constexpr bool PERM = true, AFTER_DRAIN = false;
    float* lg;
    template <class U> __device__ __forceinline__ void operator()(PG8_EPI_ARGS) const {
        const int row0 = u.pm * BM + wr * 64 + fr, col0 = wc * 32 + 8 * fq;
#pragma unroll
        for (int ai = 0; ai < 2; ++ai)
#pragma unroll
            for (int m = 0; m < 4; ++m)
#pragma unroll
                for (int bj = 0; bj < 2; ++bj) { float* p = lg + (size_t)(row0 + ai * HALF + m * 16) * NE_ + col0 + bj * HALF; *(f32x4*)p = acc[ai][bj][m][0]; *(f32x4*)(p + 4) = acc[ai][bj][m][1]; }
    }
};
struct EpiSwiglu {
    static constexpr bool PERM = true, AFTER_DRAIN = false;
    bf16_t* hid;
    template <class U> __device__ __forceinline__ void operator()(PG8_EPI_ARGS) const {
        const int row0 = u.pm * BM + wr * 64 + fr, col0 = u.pn * HALF + wc * 32 + 8 * fq;
#pragma unroll
        for (int ai = 0; ai < 2; ++ai)
#pragma unroll
            for (int m = 0; m < 4; ++m) { const size_t off = (size_t)(row0 + ai * HALF + m * 16) * FE_ + col0;
                const f32x4 a0 = acc[ai][0][m][0], a1 = acc[ai][0][m][1];
                *(u32x4*)(hid + off) = pack8(a0 * sigm4(a0) * acc[ai][1][m][0], a1 * sigm4(a1) * acc[ai][1][m][1]); }
    }
};
constexpr float YS_SCALE = 16.0f;
__device__ __forceinline__ unsigned pack4_fp8(const f32x4& v) { int w = __builtin_amdgcn_cvt_pk_fp8_f32(v[0], v[1], 0, false); w = __builtin_amdgcn_cvt_pk_fp8_f32(v[2], v[3], w, true); return (unsigned)w; }
struct EpiDown {
    static constexpr bool PERM = true, AFTER_DRAIN = false;
    const int* list; const float* gate; unsigned char* yslot; float* xb; const float* mod;
    template <class U> __device__ __forceinline__ void operator()(PG8_EPI_ARGS) const {
        typedef unsigned u32x2 __attribute__((ext_vector_type(2)));
        const int rl0 = wr * 64 + fr, col0 = u.pn * BM + wc * 32 + 8 * fq;
        if (u.e < NE_) {
            const int* lp = list + (size_t)u.e * T_ + u.rt * BM;
#pragma unroll
            for (int ai = 0; ai < 2; ++ai)
#pragma unroll
                for (int m = 0; m < 4; ++m) { const int rl = rl0 + ai * HALF + m * 16;
                    if (rl < u.nrows) { const int a = lp[rl]; const float g = gate[a] * YS_SCALE; unsigned char* rowp = yslot + (size_t)a * D_ + col0;
#pragma unroll
                        for (int bj = 0; bj < 2; ++bj) { u32x2 w; w.x = pack4_fp8(acc[ai][bj][m][0] * g); w.y = pack4_fp8(acc[ai][bj][m][1] * g); *(u32x2*)(rowp + bj * HALF) = w; } } }
        } else {
            const int t0 = u.rt * BM, b = t0 >> 12;
#pragma unroll
            for (int bj = 0; bj < 2; ++bj) { const float* gp = mod + b * 6144 + 5120 + col0 + bj * HALF; const f32x4 g0 = *(const f32x4*)gp, g1 = *(const f32x4*)(gp + 4);
#pragma unroll
                for (int ai = 0; ai < 2; ++ai)
#pragma unroll
                    for (int m = 0; m < 4; ++m) { float* p = xb + (size_t)(t0 + rl0 + ai * HALF + m * 16) * D_ + col0 + bj * HALF;
                        const f32x4 x0 = *(const f32x4*)p, x1 = *(const f32x4*)(p + 4);
                        *(f32x4*)p = x0 * DN_ALPHA_ + g0 * acc[ai][bj][m][0]; *(f32x4*)(p + 4) = x1 * DN_ALPHA_ + g1 * acc[ai][bj][m][1]; } }
        }
    }
};

template <int K, class Epi, class Sched, bool ALIGN_EPI = false, bool SP2 = false, bool GATHER = false>
__device__ __forceinline__ void gemm_phase(PG8_LAS unsigned char* lds, const Gemm g, const Sched& S, const Epi& E, const int wid) {
    const int lane = mk_lane_now(), tid = wid * 64 + lane, wr = wid >> 2, wc = wid & 3, fr = lane & 15, fq = lane >> 4;
    typedef typename Sched::Unit Unit;
    constexpr int nt = K / BK;
    unsigned voffA[2], voffB[2]; int RA[2], CA[2];
#pragma unroll
    for (int i = 0; i < 2; ++i) { int R, C; stage_rc(tid * 16 + i * 8192, R, C); const int Rb = Epi::PERM ? ((R & ~31) + perm32(R & 31)) : R;
        voffA[i] = (unsigned)(R * K + C) * 2u; voffB[i] = (unsigned)(Rb * K + C) * 2u; RA[i] = R; CA[i] = C; }
    constexpr size_t kstep = (size_t)(BK * 2);
    constexpr size_t hstep = (size_t)HALF * K * 2;
    constexpr size_t tstep = 2 * hstep;
    const unsigned ldsw = (unsigned)wid * 1024u;
    const int aoff = lds_byte(wr * 64 + fr, fq * 8), boff = lds_byte(wc * 32 + fr, fq * 8);
#define PG8_SA(b, h) (((b) * 2 + (h)) * HTB)
#define PG8_SB(b, h) ((4 + (b) * 2 + (h)) * HTB)
#define PG8_STAGE(bufoff, gbase, voff) do { _Pragma("unroll") for (int _i = 0; _i < 2; ++_i) \
        __builtin_amdgcn_global_load_lds((const unsigned*)((const char*)(gbase) + (voff)[_i]), (PG8_LAS unsigned*)(lds + (bufoff) + ldsw + _i * 8192), 16, 0, 0); } while (0)
#define PG8_STAGE_A(bufoff, base, h, nx) do { if constexpr (GATHER) { const unsigned _v[2] = {(nx) ? gn[h][0] : gc[h][0], (nx) ? gn[h][1] : gc[h][1]}; PG8_STAGE(bufoff, base, _v); } \
        else { PG8_STAGE(bufoff, (base) + (h) * hstep, voffA); } } while (0)
#define PG8_LDA(dst, b, h) do { _Pragma("unroll") for (int m = 0; m < 4; ++m) _Pragma("unroll") for (int k = 0; k < 2; ++k) dst[m][k] = *(const PG8_LAS bf16x8*)(lds + PG8_SA(b, h) + aoff + m * 2048 + k * 1024); } while (0)
#define PG8_LDB(dst, b, h) do { _Pragma("unroll") for (int n = 0; n < 2; ++n) _Pragma("unroll") for (int k = 0; k < 2; ++k) dst[n][k] = *(const PG8_LAS bf16x8*)(lds + PG8_SB(b, h) + boff + n * 2048 + k * 1024); } while (0)
#define PG8_MMA(ai, bj, At, Bt) do { __builtin_amdgcn_s_setprio(1); _Pragma("unroll") for (int m = 0; m < 4; ++m) _Pragma("unroll") for (int n = 0; n < 2; ++n) _Pragma("unroll") for (int k = 0; k < 2; ++k) \
        acc[ai][bj][m][n] = __builtin_amdgcn_mfma_f32_16x16x32_bf16(Bt[n][k], At[m][k], acc[ai][bj][m][n], 0, 0, 0); __builtin_amdgcn_s_setprio(0); } while (0)
#define PG8_WAIT_V(n) asm volatile("s_waitcnt vmcnt(" #n ")" ::: "memory")
#define PG8_WAIT_L(n) asm volatile("s_waitcnt lgkmcnt(" #n ")" ::: "memory")
#define PG8_BAR __builtin_amdgcn_s_barrier()
#define PG8_SCHED __builtin_amdgcn_sched_barrier(0)
    Unit cur, nxt; int ui = 0;
    if (!S.next(0, cur)) return;
    f32x4 acc[2][2][4][2];
#pragma unroll
    for (int a = 0; a < 2; ++a)
#pragma unroll
        for (int b = 0; b < 2; ++b)
#pragma unroll
            for (int m = 0; m < 4; ++m)
#pragma unroll
                for (int n = 0; n < 2; ++n) acc[a][b][m][n] = (f32x4){0.f, 0.f, 0.f, 0.f};
    bf16x8 At[4][2], B0[2][2], B1[2][2];
    unsigned gc[2][2] = {{0u, 0u}, {0u, 0u}}, gn[2][2] = {{0u, 0u}, {0u, 0u}};
    if constexpr (GATHER) {
#pragma unroll
        for (int h = 0; h < 2; ++h)
#pragma unroll
            for (int i = 0; i < 2; ++i) gc[h][i] = S.row_off(cur, h * HALF + RA[i], CA[i]);
    }
    const char* cA = (const char*)g.A + S.a_off(cur, tstep); const char* cB = (const char*)g.Bt + S.b_off(cur, tstep);
    S.a_ready(cur);
    if constexpr (SP2) {
        PG8_STAGE(PG8_SB(0, 0), cB, voffB); PG8_STAGE(PG8_SB(0, 1), cB + hstep, voffB); PG8_STAGE_A(PG8_SA(0, 0), cA, 0, false); PG8_STAGE_A(PG8_SA(0, 1), cA, 1, false);
        if (wr == 1) PG8_BAR;
        PG8_WAIT_V(2); PG8_BAR;
        PG8_STAGE(PG8_SB(1, 0), cB + kstep, voffB); PG8_STAGE_A(PG8_SA(1, 0), cA + kstep, 0, false); PG8_STAGE(PG8_SB(1, 1), cB + hstep + kstep, voffB);
        PG8_WAIT_V(6); PG8_BAR;
    } else {
        PG8_STAGE(PG8_SB(0, 0), cB, voffB); PG8_STAGE_A(PG8_SA(0, 0), cA, 0, false); PG8_STAGE(PG8_SB(0, 1), cB + hstep, voffB); PG8_STAGE_A(PG8_SA(0, 1), cA, 1, false);
        if (wr == 1) PG8_BAR;
        PG8_WAIT_V(4); PG8_BAR;
        PG8_STAGE(PG8_SB(1, 0), cB + kstep, voffB); PG8_STAGE_A(PG8_SA(1, 0), cA + kstep, 0, false); PG8_STAGE(PG8_SB(1, 1), cB + hstep + kstep, voffB);
        PG8_WAIT_V(6); PG8_BAR;
    }
    for (;;) {
        const bool has_next = S.next(ui + 1, nxt);
        const char* nA = has_next ? (const char*)g.A + S.a_off(nxt, tstep) : cA; const char* nB = has_next ? (const char*)g.Bt + S.b_off(nxt, tstep) : cB;
        if constexpr (GATHER) {
#pragma unroll
            for (int h = 0; h < 2; ++h)
#pragma unroll
                for (int i = 0; i < 2; ++i) gn[h][i] = has_next ? S.row_off(nxt, h * HALF + RA[i], CA[i]) : gc[h][i];
        }
        for (int t = 0; t < nt; t += 2) {
            const bool last = (t == nt - 2);
            const char* a1 = cA + (size_t)(t + 1) * kstep;
            const char* a2 = last ? nA : cA + (size_t)(t + 2) * kstep; const char* b2 = last ? nB : cB + (size_t)(t + 2) * kstep;
            const char* a3 = a2 + kstep; const char* b3 = b2 + kstep;
            if (last && has_next) S.a_ready(nxt);
            if constexpr (SP2) {
            PG8_LDB(B0, 0, 0); PG8_LDB(B1, 0, 1); PG8_SCHED; PG8_LDA(At, 0, 0); PG8_STAGE_A(PG8_SA(1, 1), a1, 1, false);
            PG8_WAIT_V(8); PG8_WAIT_L(0); PG8_BAR; PG8_MMA(0, 0, At, B0); PG8_MMA(0, 1, At, B1); PG8_BAR; PG8_SCHED;
            PG8_LDA(At, 0, 1); PG8_STAGE(PG8_SB(0, 0), b2, voffB); PG8_STAGE(PG8_SB(0, 1), b2 + hstep, voffB); PG8_STAGE_A(PG8_SA(0, 0), a2, 0, last);
            PG8_WAIT_V(8); PG8_WAIT_L(0); PG8_BAR; PG8_MMA(1, 0, At, B0); PG8_MMA(1, 1, At, B1); PG8_BAR; PG8_SCHED;
            PG8_LDB(B0, 1, 0); PG8_LDB(B1, 1, 1); PG8_SCHED; PG8_LDA(At, 1, 0); PG8_STAGE_A(PG8_SA(0, 1), a2, 1, last);
            PG8_WAIT_V(8); PG8_WAIT_L(0); PG8_BAR; PG8_MMA(0, 0, At, B0); PG8_MMA(0, 1, At, B1); PG8_BAR; PG8_SCHED;
            PG8_LDA(At, 1, 1); PG8_STAGE(PG8_SB(1, 0), b3, voffB); PG8_STAGE(PG8_SB(1, 1), b3 + hstep, voffB); PG8_STAGE_A(PG8_SA(1, 0), a3, 0, last);
            PG8_WAIT_V(8); PG8_WAIT_L(0); PG8_BAR; PG8_MMA(1, 0, At, B0); PG8_MMA(1, 1, At, B1); PG8_BAR; PG8_SCHED;
            } else {
            PG8_LDB(B0, 0, 0); PG8_SCHED; PG8_LDA(At, 0, 0); PG8_STAGE_A(PG8_SA(1, 1), a1, 1, false);
            PG8_WAIT_L(8); PG8_BAR; PG8_WAIT_L(0); PG8_MMA(0, 0, At, B0); PG8_BAR; PG8_SCHED;
            PG8_LDB(B1, 0, 1); PG8_STAGE(PG8_SB(0, 0), b2, voffB);
            PG8_BAR; PG8_WAIT_L(0); PG8_MMA(0, 1, At, B1); PG8_BAR;
            PG8_LDA(At, 0, 1); PG8_STAGE_A(PG8_SA(0, 0), a2, 0, last);
            PG8_BAR; PG8_WAIT_L(0); PG8_MMA(1, 0, At, B0); PG8_BAR; PG8_SCHED;
            PG8_STAGE(PG8_SB(0, 1), b2 + hstep, voffB);
            PG8_WAIT_V(6); PG8_BAR; PG8_MMA(1, 1, At, B1); PG8_BAR;
            PG8_LDB(B0, 1, 0); PG8_SCHED; PG8_LDA(At, 1, 0); PG8_STAGE_A(PG8_SA(0, 1), a2, 1, last);
            PG8_WAIT_L(8); PG8_BAR; PG8_WAIT_L(0); PG8_MMA(0, 0, At, B0); PG8_BAR; PG8_SCHED;
            PG8_LDB(B1, 1, 1); PG8_STAGE(PG8_SB(1, 0), b3, voffB);
            PG8_BAR; PG8_WAIT_L(0); PG8_MMA(0, 1, At, B1); PG8_BAR;
            PG8_LDA(At, 1, 1); PG8_STAGE_A(PG8_SA(1, 0), a3, 0, last);
            PG8_BAR; PG8_WAIT_L(0); PG8_MMA(1, 0, At, B0); PG8_BAR; PG8_SCHED;
            PG8_STAGE(PG8_SB(1, 1), b3 + hstep, voffB);
            PG8_WAIT_V(6); PG8_BAR; PG8_MMA(1, 1, At, B1); PG8_BAR;
            }
        }
        if constexpr (ALIGN_EPI) { if (wr == 0) PG8_BAR; }
        if constexpr (!Epi::AFTER_DRAIN) { E(acc, cur, wr, wc, fr, fq); S.done(cur); }
        if (!has_next) break;
#pragma unroll
        for (int a = 0; a < 2; ++a)
#pragma unroll
            for (int b = 0; b < 2; ++b)
#pragma unroll
                for (int m = 0; m < 4; ++m)
#pragma unroll
                    for (int n = 0; n < 2; ++n) acc[a][b][m][n] = (f32x4){0.f, 0.f, 0.f, 0.f};
        cur = nxt; cA = nA; cB = nB; ++ui;
        if constexpr (GATHER) {
#pragma unroll
            for (int h = 0; h < 2; ++h)
#pragma unroll
                for (int i = 0; i < 2; ++i) gc[h][i] = gn[h][i];
        }
        if constexpr (ALIGN_EPI) { if (wr == 1) PG8_BAR; }
    }
    PG8_WAIT_V(0);
    if constexpr (!ALIGN_EPI) { if (wr == 0) PG8_BAR; }
    PG8_BAR;
#undef PG8_SA
#undef PG8_SB
#undef PG8_STAGE
#undef PG8_STAGE_A
#undef PG8_LDA
#undef PG8_LDB
#undef PG8_MMA
#undef PG8_WAIT_V
#undef PG8_WAIT_L
#undef PG8_BAR
#undef PG8_SCHED
}
}
#define PG8_SP2 true
#define PG8_ALIGN true
#include <hip/hip_bf16.h>
#include <cmath>
namespace attn_body {
using bf16=__hip_bfloat16;
using bf16x8=__attribute__((ext_vector_type(8)))short;
using s16x4=__attribute__((ext_vector_type(4)))short;
using f32x16=__attribute__((ext_vector_type(16)))float;
using u32x4=__attribute__((ext_vector_type(4)))unsigned;
constexpr int BATCH=8,NHEAD=16,SEQ=4096,D=64,DM=1024,OP=2048;
constexpr int NW=8,QBLK=32,QB=QBLK*NW,KVBLK=64,NQB=SEQ/QB;
constexpr int ATTN_PITCH=DM, ATTN_UNIT_ROWS=QB;
__device__ __forceinline__ int crow(int r,int hi){return (r&3)+8*(r>>2)+4*hi;}
#define SBAR() __builtin_amdgcn_sched_barrier(0)
__device__ __forceinline__ void cmask(f32x16&p0,f32x16&p1,int jb,int qrel,int hi){
  const float NEG=-INFINITY; int kb=64*jb+4*hi;
  #pragma unroll
  for(int r=0;r<16;++r){int kv=kb+(r&3)+8*(r>>2); if(kv>qrel)p0[r]=NEG; if(kv+32>qrel)p1[r]=NEG;}
}

constexpr int NSLOT=3, SLOTB=8192;
constexpr int LDS_K=0, LDS_V=NSLOT*SLOTB, LDS_WS=2*NSLOT*SLOTB, LDS_OST=LDS_WS+NW*64*4, LDS_BYTES=LDS_OST+NW*4096;
constexpr float C2=0.125f*1.4426950408889634f;
__device__ __forceinline__ void glds16(const void*gsrc,unsigned lds_dst){unsigned keep;
  asm volatile("s_mov_b32 %0, m0\n\ts_mov_b32 m0, %2\n\ts_nop 0\n\tglobal_load_lds_dwordx4 %1, off\n\ts_mov_b32 m0, %0":"=&s"(keep):"v"(gsrc),"s"(lds_dst):"memory");}
__device__ __forceinline__ float max3f(float a,float b,float c){float r;asm("v_max3_f32 %0, %1, %2, %3":"=v"(r):"v"(a),"v"(b),"v"(c));return r;}
__device__ __forceinline__ float max2f(float a,float b){float r;asm("v_max_f32_e32 %0, %1, %2":"=v"(r):"v"(a),"v"(b));return r;}
__device__ __forceinline__ float fadd_s(float a,float b){float r;asm("v_add_f32_e32 %0, %1, %2":"=v"(r):"v"(a),"v"(b));return r;}
__device__ __forceinline__ float fsub_s(float a,float b){float r;asm("v_sub_f32_e32 %0, %1, %2":"=v"(r):"v"(a),"v"(b));return r;}
typedef float f32x2_t __attribute__((ext_vector_type(2))); typedef __bf16 bf16x2_t __attribute__((ext_vector_type(2)));
__device__ __forceinline__ unsigned cvtpk_s(float lo,float hi){f32x2_t v={lo,hi};bf16x2_t b=__builtin_convertvector(v,bf16x2_t);return __builtin_bit_cast(unsigned,b);}
#define WAIT_BAR(N) asm volatile("s_waitcnt vmcnt(" #N ") lgkmcnt(0)\n\ts_barrier":::"memory")

__device__ __forceinline__ void qkt(f32x16&p0,f32x16&p1,const char*Kslot,const bf16x8*qr,const f32x16&negm,int r32,int hi){
  const char*kb=Kslot+hi*1024+r32*16;
  #pragma unroll
  for(int d0=0;d0<4;++d0){
    const bf16x8 b0=*reinterpret_cast<const bf16x8*>(kb+d0*2048);
    const bf16x8 b1=*reinterpret_cast<const bf16x8*>(kb+d0*2048+512);
    if(d0==0){p0=__builtin_amdgcn_mfma_f32_32x32x16_bf16(b0,qr[0],negm,0,0,0);p1=__builtin_amdgcn_mfma_f32_32x32x16_bf16(b1,qr[0],negm,0,0,0);}
    else{p0=__builtin_amdgcn_mfma_f32_32x32x16_bf16(b0,qr[d0],p0,0,0,0);p1=__builtin_amdgcn_mfma_f32_32x32x16_bf16(b1,qr[d0],p1,0,0,0);}}
}
typedef __attribute__((address_space(3))) const char* lds_cptr;
typedef short v4i16_t __attribute__((ext_vector_type(4)));
__device__ __forceinline__ void kload8(bf16x8*kf,lds_cptr kp){
  kf[0]=*(const __attribute__((address_space(3))) bf16x8*)(kp);      kf[1]=*(const __attribute__((address_space(3))) bf16x8*)(kp+512);
  kf[2]=*(const __attribute__((address_space(3))) bf16x8*)(kp+2048); kf[3]=*(const __attribute__((address_space(3))) bf16x8*)(kp+2560);
  kf[4]=*(const __attribute__((address_space(3))) bf16x8*)(kp+4096); kf[5]=*(const __attribute__((address_space(3))) bf16x8*)(kp+4608);
  kf[6]=*(const __attribute__((address_space(3))) bf16x8*)(kp+6144); kf[7]=*(const __attribute__((address_space(3))) bf16x8*)(kp+6656);
}
__device__ __forceinline__ void kload2(bf16x8*kf,lds_cptr kp,int j){ kf[2*j]=*(const __attribute__((address_space(3))) bf16x8*)(kp+j*2048); kf[2*j+1]=*(const __attribute__((address_space(3))) bf16x8*)(kp+j*2048+512); }
__device__ __forceinline__ s16x4 vtr(lds_cptr p){ return __builtin_bit_cast(s16x4,__builtin_amdgcn_ds_read_tr16_b64_v4i16((__attribute__((address_space(3))) v4i16_t*)p)); }
__device__ __forceinline__ float rowmax(const f32x16&p0,const f32x16&p1){
  float a=max3f(p0[0],p0[1],p1[0]),b=max3f(p0[2],p0[3],p1[1]);a=max3f(a,p1[2],p1[3]);
  #pragma unroll
  for(int r=4;r<16;r+=4){a=max3f(a,p0[r],p0[r+1]);b=max3f(b,p0[r+2],p0[r+3]);a=max3f(a,p1[r],p1[r+1]);b=max3f(b,p1[r+2],p1[r+3]);}
  const float m=max2f(a,b);
  auto rr=__builtin_amdgcn_permlane32_swap(__float_as_uint(m),__float_as_uint(m),false,false);
  return max2f(__uint_as_float(rr[0]),__uint_as_float(rr[1]));
}
__device__ __forceinline__ void pv(f32x16*o,int vb,bf16x8 pa0,bf16x8 pa1,bf16x8 pa2,bf16x8 pa3){
  #pragma unroll
  for(int d0=0;d0<2;++d0){s16x4 lo[4],hi[4];
    #pragma unroll
    for(int ks=0;ks<4;++ks){
      asm volatile("ds_read_b64_tr_b16 %0,%1 offset:%c2":"=&v"(lo[ks]):"v"(vb),"i"(d0*4096+ks*1024):"memory");
      asm volatile("ds_read_b64_tr_b16 %0,%1 offset:%c2":"=&v"(hi[ks]):"v"(vb),"i"(d0*4096+ks*1024+512):"memory");}
    asm volatile("s_waitcnt lgkmcnt(0)":::"memory");SBAR();
    #define PK(k) (bf16x8){lo[k][0],lo[k][1],lo[k][2],lo[k][3],hi[k][0],hi[k][1],hi[k][2],hi[k][3]}
    o[d0]=__builtin_amdgcn_mfma_f32_32x32x16_bf16(pa0,PK(0),o[d0],0,0,0);
    o[d0]=__builtin_amdgcn_mfma_f32_32x32x16_bf16(pa1,PK(1),o[d0],0,0,0);
    o[d0]=__builtin_amdgcn_mfma_f32_32x32x16_bf16(pa2,PK(2),o[d0],0,0,0);
    o[d0]=__builtin_amdgcn_mfma_f32_32x32x16_bf16(pa3,PK(3),o[d0],0,0,0);
    #undef PK
  }
}

#ifndef ATTN_STORE16
#define ATTN_STORE16(p,v) (*(u32x4*)(p)=(v))
#endif
template<int THRL> __device__ __forceinline__ void attn_unit(const int wid,int b,int cq,int cv,int co,int qb,const bf16*Q,const bf16*__restrict__ K,const bf16*__restrict__ V,bf16*O,char*shm){
  const int lane=mk_lane_now(),r32=lane&31,hi=lane>>5;
  const long rowbase=(long)b*SEQ; const int q0=qb*QB;
  const bf16*Qw=Q+(rowbase+q0+wid*QBLK)*DM+cq;
  const bf16*Kh=K+rowbase*DM+cq,*Vh=V+rowbase*DM+cv;
  const unsigned lds0=(unsigned)(uintptr_t)shm;
  float*wsf=(float*)(shm+LDS_WS)+wid*64;
  const bf16*ksrc=Kh+(long)lane*DM+wid*8;
  const bf16*vsrc=Vh+(long)(16*(wid&3)+(lane>>2))*DM+(wid>>2)*32+(lane&3)*8;
  const unsigned kdst=lds0+LDS_K+wid*1024, vdst=lds0+LDS_V+wid*1024;
  #define DMA_K(t,slot) glds16(ksrc+(long)(t)*KVBLK*DM,(unsigned)__builtin_amdgcn_readfirstlane(kdst+(slot)))
  #define DMA_V(t,slot) glds16(vsrc+(long)(t)*KVBLK*DM,(unsigned)__builtin_amdgcn_readfirstlane(vdst+(slot)))
  const int vb0=(int)(lds0+LDS_V)+((lane>>4)&1)*32+(lane&3)*8+(4*hi+((lane&15)>>2))*64;
  const char*Kbase=shm+LDS_K; bf16x8 kf[8];
  const lds_cptr shm3=(lds_cptr)shm; const lds_cptr kp0=shm3+LDS_K+hi*1024+r32*16; const lds_cptr vp0=shm3+LDS_V+((lane>>4)&1)*32+(lane&3)*8+(4*hi+((lane&15)>>2))*64;
  const int NT=(q0+QB)/KVBLK;
  DMA_K(0,0);DMA_V(0,0);DMA_K(1,SLOTB);
  bf16x8 qr[4];
  #pragma unroll
  for(int d0=0;d0<4;++d0)qr[d0]=*reinterpret_cast<const bf16x8*>(&Qw[(long)r32*DM+d0*16+hi*8]);
  float zf_=0.f;asm volatile("":"+v"(zf_));f32x16 zv_;
  #pragma unroll
  for(int r=0;r<16;++r)zv_[r]=zf_;
  float mhat=0.f,l_reg=0.f;f32x16 o[2];o[0]=zv_;o[1]=zv_;f32x16 negm=zv_;asm volatile("":"+v"(negm));
  const int qrel=wid*QBLK+r32;
  #define CMASK(P0,P1,t) do{int jb_=(t)-(NT-4); if(jb_>=0)cmask(P0,P1,jb_,qrel,hi);}while(0)
  bool resc=false;
  #define START(P0,P1) do{ const float rm=rowmax(P0,P1); resc=false; \
    { const float dl=rm; mhat=fadd_s(mhat,dl); \
      _Pragma("unroll") for(int r=0;r<16;++r){P0[r]=fsub_s(P0[r],dl);P1[r]=fsub_s(P1[r],dl);} \
      _Pragma("unroll") for(int r=0;r<16;++r)negm[r]=-mhat; asm volatile("":"+v"(negm)); } \
    _Pragma("unroll") for(int r=0;r<16;++r)P0[r]=__builtin_amdgcn_exp2f(P0[r]); }while(0)
  #define RESC() do{ if(resc){ asm volatile("s_waitcnt lgkmcnt(0)":::"memory"); \
      _Pragma("unroll") for(int d_=0;d_<2;++d_) _Pragma("unroll") for(int r=0;r<16;++r)o[d_][r]*=wsf[crow(r,hi)]; } }while(0)
  f32x16 pA0,pA1,pB0,pB1;
  int sl_prev=0,sl_cur=0,sl_next=SLOTB;
  #define ROT() do{sl_prev=sl_cur;sl_cur=sl_next;sl_next=(sl_next==(NSLOT-1)*SLOTB)?0:sl_next+SLOTB;}while(0)
  DMA_K(2,2*SLOTB);
  WAIT_BAR(3);
  qkt(pA0,pA1,Kbase,qr,negm,r32,hi);asm volatile("s_nop 15\n\ts_nop 7":"+v"(pA0),"+v"(pA1));CMASK(pA0,pA1,0);
  START(pA0,pA1);
  _Pragma("unroll") for(int r=0;r<16;++r)pA1[r]=__builtin_amdgcn_exp2f(pA1[r]);
  WAIT_BAR(0);
  DMA_K(3,0);DMA_V(1,SLOTB);
  ROT();
  kload8(kf,kp0+sl_cur);
  WAIT_BAR(2);
  s16x4 vlo[8],vhi[8]; u32x4 pw0,pw1,pw2,pw3;
  #define PKW(P,B) cvtpk_s(P[B],P[B+1])
  #define PAF(k) __builtin_bit_cast(bf16x8,pw##k)
  #define VFR(i) (bf16x8){vlo[i][0],vlo[i][1],vlo[i][2],vlo[i][3],vhi[i][0],vhi[i][1],vhi[i][2],vhi[i][3]}
  #define PIN(x) asm volatile("":"+v"(x))
  #define MX3(a,b,c) __builtin_fmaxf(__builtin_fmaxf((a),(b)),(c))
  #define GAPA(MF,A0,A1,A2,A3,W0,W1,PW) do{ MF; sacc+=A0; sacc+=A1; sacc+=A2; sacc+=A3; PIN(sacc); W0; W1; PIN(PW); SBAR(); }while(0)
  #define EX(v) __builtin_amdgcn_exp2f(v)
  #define GAPB(MF,X,B) do{ MF; X[B]=EX(X[B]); X[B+1]=EX(X[B+1]); X[B+2]=EX(X[B+2]); X[B+3]=EX(X[B+3]); PIN(X); SBAR(); }while(0)
  #define VRD(i) do{ vlo[i]=vtr(vp_+(((i)>>2)*4096+((i)&3)*1024)); vhi[i]=vtr(vp_+(((i)>>2)*4096+((i)&3)*1024+512)); }while(0)
  #define KRD(G,j) do{ if(G){ kload2(kf,kp0+sl_next,j); SBAR(); } }while(0)
  #define STEP(C0,C1,P0,P1,t,GK,GV,GL) do{ SBAR(); \
    const lds_cptr vp_=vp0+sl_prev; \
    VRD(0); SBAR(); float sacc=(P0[0]+P0[1]); \
    GAPA(C0=__builtin_amdgcn_mfma_f32_32x32x16_bf16(kf[0],qr[0],negm,0,0,0), P0[2],P0[3],P0[4],P0[5],     pw0[0]=PKW(P0,0), pw0[1]=PKW(P0,2), pw0); \
    VRD(4); SBAR(); GAPA(C1=__builtin_amdgcn_mfma_f32_32x32x16_bf16(kf[1],qr[0],negm,0,0,0), P0[6],P0[7],P0[8],P0[9],     pw0[2]=PKW(P0,4), pw0[3]=PKW(P0,6), pw0); \
    VRD(1); SBAR(); GAPA(C0=__builtin_amdgcn_mfma_f32_32x32x16_bf16(kf[2],qr[1],C0,0,0,0),   P0[10],P0[11],P0[12],P0[13], pw1[0]=PKW(P0,8), pw1[1]=PKW(P0,10), pw1); \
    VRD(5); SBAR(); GAPA(C1=__builtin_amdgcn_mfma_f32_32x32x16_bf16(kf[3],qr[1],C1,0,0,0),   P0[14],P0[15],P1[0],P1[1],   pw1[2]=PKW(P0,12),pw1[3]=PKW(P0,14), pw1); \
    VRD(2); SBAR(); GAPA(C0=__builtin_amdgcn_mfma_f32_32x32x16_bf16(kf[4],qr[2],C0,0,0,0),   P1[2],P1[3],P1[4],P1[5],     pw2[0]=PKW(P1,0), pw2[1]=PKW(P1,2), pw2); \
    VRD(6); SBAR(); GAPA(C1=__builtin_amdgcn_mfma_f32_32x32x16_bf16(kf[5],qr[2],C1,0,0,0),   P1[6],P1[7],P1[8],P1[9],     pw2[2]=PKW(P1,4), pw2[3]=PKW(P1,6), pw2); \
    VRD(3); SBAR(); GAPA(C0=__builtin_amdgcn_mfma_f32_32x32x16_bf16(kf[6],qr[3],C0,0,0,0),   P1[10],P1[11],P1[12],P1[13], pw3[0]=PKW(P1,8), pw3[1]=PKW(P1,10), pw3); \
    VRD(7); SBAR(); GAPA(C1=__builtin_amdgcn_mfma_f32_32x32x16_bf16(kf[7],qr[3],C1,0,0,0),   P1[14],P1[15],0.f,0.f,       pw3[2]=PKW(P1,12),pw3[3]=PKW(P1,14), pw3); \
    l_reg+=sacc; \
    if(GK){DMA_K((t)+3,sl_cur);} if(GV){DMA_V((t)+1,sl_next);} \
    CMASK(C0,C1,t); \
    { float a=MX3(C0[0],C0[1],C1[0]),b=MX3(C0[2],C0[3],C1[1]); a=MX3(a,C1[2],C1[3]); \
      _Pragma("unroll") for(int r=4;r<16;r+=4){a=MX3(a,C0[r],C0[r+1]);b=MX3(b,C0[r+2],C0[r+3]);a=MX3(a,C1[r],C1[r+1]);b=MX3(b,C1[r+2],C1[r+3]);} \
      float rm=__builtin_fmaxf(a,b); { auto rr=__builtin_amdgcn_permlane32_swap(__float_as_uint(rm),__float_as_uint(rm),false,false); rm=__builtin_fmaxf(__uint_as_float(rr[0]),__uint_as_float(rr[1])); } \
      resc=false; \
      if(__builtin_expect(__any(rm>(float)THRL),0)){ const float dl=__builtin_fmaxf(rm,0.f); mhat+=dl; \
        _Pragma("unroll") for(int r=0;r<16;++r){C0[r]-=dl;C1[r]-=dl;} \
        _Pragma("unroll") for(int r=0;r<16;++r)negm[r]=-mhat; asm volatile("":"+v"(negm)); \
        const float f=__builtin_amdgcn_exp2f(-dl); l_reg*=f; if(hi==0)wsf[r32]=f; resc=true; } } \
    SBAR(); \
    GAPB(o[0]=__builtin_amdgcn_mfma_f32_32x32x16_bf16(PAF(0),VFR(0),o[0],0,0,0), C0,0); \
    GAPB(o[1]=__builtin_amdgcn_mfma_f32_32x32x16_bf16(PAF(0),VFR(4),o[1],0,0,0), C0,4); \
    KRD(GL,0); GAPB(o[0]=__builtin_amdgcn_mfma_f32_32x32x16_bf16(PAF(1),VFR(1),o[0],0,0,0), C0,8); \
    KRD(GL,1); GAPB(o[1]=__builtin_amdgcn_mfma_f32_32x32x16_bf16(PAF(1),VFR(5),o[1],0,0,0), C0,12); \
    KRD(GL,2); GAPB(o[0]=__builtin_amdgcn_mfma_f32_32x32x16_bf16(PAF(2),VFR(2),o[0],0,0,0), C1,0); \
    KRD(GL,3); GAPB(o[1]=__builtin_amdgcn_mfma_f32_32x32x16_bf16(PAF(2),VFR(6),o[1],0,0,0), C1,4); \
    GAPB(o[0]=__builtin_amdgcn_mfma_f32_32x32x16_bf16(PAF(3),VFR(3),o[0],0,0,0), C1,8); \
    GAPB(o[1]=__builtin_amdgcn_mfma_f32_32x32x16_bf16(PAF(3),VFR(7),o[1],0,0,0), C1,12); \
    }while(0)
  int t=1;
  #undef CMASK
  #define CMASK(P0,P1,t) do{}while(0)
  for(;t+5<NT;t+=2){
    STEP(pB0,pB1,pA0,pA1,t,true,true,true);     WAIT_BAR(2); RESC(); ROT();
    STEP(pA0,pA1,pB0,pB1,t+1,true,true,true);   WAIT_BAR(2); RESC(); ROT();
  }
  #undef CMASK
  #define CMASK(P0,P1,t) do{int jb_=(t)-(NT-4); if(jb_>=0)cmask(P0,P1,jb_,qrel,hi);}while(0)
  #define ENDW(tt) do{ if((tt)+3<NT){WAIT_BAR(2);} else if((tt)+2<NT){WAIT_BAR(1);} else {WAIT_BAR(0);} }while(0)
  for(;t+1<NT;t+=2){
    STEP(pB0,pB1,pA0,pA1,t,(t+3<NT),(t+1<NT),(t+1<NT));       ENDW(t);   RESC(); ROT();
    STEP(pA0,pA1,pB0,pB1,t+1,(t+4<NT),(t+2<NT),(t+2<NT));     ENDW(t+1); RESC(); ROT();
  }
  STEP(pB0,pB1,pA0,pA1,NT-1,false,false,false); RESC();
  { float sacc=pB0[0]+pB0[1]; _Pragma("unroll") for(int r=2;r<16;++r)sacc+=pB0[r]; _Pragma("unroll") for(int r=0;r<16;++r)sacc+=pB1[r]; l_reg+=sacc;
    pw0=(u32x4){PKW(pB0,0),PKW(pB0,2),PKW(pB0,4),PKW(pB0,6)};pw1=(u32x4){PKW(pB0,8),PKW(pB0,10),PKW(pB0,12),PKW(pB0,14)};pw2=(u32x4){PKW(pB1,0),PKW(pB1,2),PKW(pB1,4),PKW(pB1,6)};pw3=(u32x4){PKW(pB1,8),PKW(pB1,10),PKW(pB1,12),PKW(pB1,14)};
    SBAR(); pv(o,vb0+sl_cur,PAF(0),PAF(1),PAF(2),PAF(3)); }
  #undef PKW
  #undef PAF
  #undef VFR
  #undef PIN
  #undef MX3
  #undef GAPA
  #undef GAPB
  #undef EX
  #undef VRD
  #undef KRD
  #undef STEP
  #undef ENDW
  {auto rr=__builtin_amdgcn_permlane32_swap(__float_as_uint(l_reg),__float_as_uint(l_reg),false,false);l_reg=__uint_as_float(rr[0])+__uint_as_float(rr[1]);}
  if(hi==0)wsf[32+r32]=l_reg;asm volatile("s_waitcnt lgkmcnt(0)":::"memory");
  float rli[16];
  #pragma unroll
  for(int r=0;r<16;++r)rli[r]=__builtin_amdgcn_rcpf(wsf[32+crow(r,hi)]);
  bf16*Ow=O+(rowbase+q0+wid*QBLK)*OP+co;
  { bf16*stg=(bf16*)(shm+LDS_OST)+wid*2048;
    #pragma unroll
    for(int r=0;r<16;++r){const int orow=crow(r,hi);
      #pragma unroll
      for(int d0=0;d0<2;++d0)stg[orow*64+d0*32+r32]=__float2bfloat16(o[d0][r]*rli[r]);}
    asm volatile("s_waitcnt lgkmcnt(0)":::"memory");
    #pragma unroll
    for(int i=0;i<4;++i){const int row=i*8+(lane>>3),ch=lane&7; const u32x4 v=*(const u32x4*)(stg+row*64+ch*8); ATTN_STORE16(Ow+(long)row*OP+ch*8,v);} }
  asm volatile("s_waitcnt lgkmcnt(0)\n\ts_barrier":::"memory");
  #undef DMA_K
  #undef DMA_V
  #undef CMASK
  #undef START
  #undef RESC
  #undef ROT
}
constexpr int ATTN_LDS_BYTES=LDS_BYTES;
struct AttnTensors { const bf16* Q; const bf16* K; const bf16* V; bf16* O; };
struct AttnUnit { int combo; int qb; };
struct StaticOrder {
  int vcu, G;
  __device__ __forceinline__ explicit StaticOrder(int grid,int v):vcu(v),G(grid){}
  __device__ __forceinline__ bool next(int i,AttnUnit&u)const{ const int c=vcu+(i>>4)*G; if(c>=256)return false; u.combo=c; u.qb=15-(i&15); return true; }
};
template<class Sched,class Hook,int THRL=8> __device__ __forceinline__ void attn_phase(char*lds,const AttnTensors&T,const Sched&S,const int wid,const Hook&H){
  AttnUnit u;
  for(int i=0;S.next(i,u);++i){ H(i); const int vh=u.combo&1,hm=(u.combo>>1)&15,b=u.combo>>5;
    attn_unit<THRL>(wid,b,hm*64,(hm>>1)*128+vh*64,(hm*2+vh)*64,u.qb,T.Q,T.K,T.V,T.O,lds); }
}
#undef SBAR
#undef WAIT_BAR
}
#define GAS __attribute__((address_space(1)))
#define LAS __attribute__((address_space(3)))
typedef unsigned short bf16;
typedef unsigned v4u __attribute__((ext_vector_type(4)));
typedef float f32x4 __attribute__((ext_vector_type(4)));
typedef short bf16x8 __attribute__((ext_vector_type(8)));
typedef GAS unsigned gu32;
typedef GAS unsigned long long gu64;
#define RLX_AGENT __ATOMIC_RELAXED, __HIP_MEMORY_SCOPE_AGENT
#define LDS_WAIT() asm volatile("s_waitcnt lgkmcnt(0)" ::: "memory")
#define VM_WAIT() asm volatile("s_waitcnt vmcnt(0)" ::: "memory")
__device__ __forceinline__ unsigned long long rt() { return __builtin_amdgcn_s_memrealtime(); }
__device__ __forceinline__ unsigned f2bf(float f) { unsigned u = __builtin_bit_cast(unsigned, f); return (u + 0x7fffu + ((u >> 16) & 1u)) >> 16; }
__device__ __forceinline__ unsigned pk2(float lo, float hi) { return f2bf(lo) | (f2bf(hi) << 16); }

#define XB_TMO      128
#define XB_XCNT(j)  (256  + 64 * (j))
#define XB_XSUB(j)  (1280 + 64 * (j))
#define XB_XGEN(j)  (2304 + 64 * (j))
#define XB_TOP      3328
#define XB_TOPGEN   3392
#define XCD_BAR_WORDS 3456
#define XB_SPIN_CAP (1u << 18)

__device__ __forceinline__ unsigned xb_ld(unsigned* p)              { return __hip_atomic_load(p, __ATOMIC_RELAXED, __HIP_MEMORY_SCOPE_AGENT); }
__device__ __forceinline__ unsigned xb_add(unsigned* p, unsigned v) { return __hip_atomic_fetch_add(p, v, __ATOMIC_RELAXED, __HIP_MEMORY_SCOPE_AGENT); }
__device__ __forceinline__ unsigned xb_xcc_id() { return (unsigned)__builtin_amdgcn_s_getreg((3 << 11) | 20) & 0xFu; }
#define XB_SPIN(cond, bar) do { unsigned _sp = 0; while (cond) { __builtin_amdgcn_s_sleep(1); \
    if ((++_sp & 255u) == 0u) { if (xb_ld(&(bar)[XB_TMO])) break; if (_sp > XB_SPIN_CAP) { atomicAdd(&(bar)[XB_TMO], 1u); break; } } } } while (0)

struct XcdBarrier {
    unsigned* bar; unsigned x; int wave;
    volatile LAS unsigned* st;
};

__device__ __forceinline__ XcdBarrier xcd_barrier_post(unsigned* bar, volatile LAS unsigned* st) {
    XcdBarrier b; b.bar = bar; b.x = xb_xcc_id(); b.st = st; b.wave = 0;
    if (threadIdx.x == 0) (void)xb_add(&bar[XB_XCNT(b.x)], 1u);
    return b;
}
__device__ __forceinline__ void xcd_barrier_complete(unsigned* bar, unsigned x, unsigned& nloc, unsigned& nx) {
    const unsigned G = gridDim.x * gridDim.y * gridDim.z;
    unsigned sum, cnt, mine, sp = 0u;
    for (;;) {
        sum = 0u; cnt = 0u; mine = 0u;
#pragma unroll
        for (unsigned j = 0; j < 16; ++j) { const unsigned c = xb_ld(&bar[XB_XCNT(j)]); sum += c; cnt += (c > 0u) ? 1u : 0u; mine = (j == x) ? c : mine; }
        if (sum == G) break;
        __builtin_amdgcn_s_sleep(1);
        if ((++sp & 255u) == 0u) { if (xb_ld(&bar[XB_TMO])) break; if (sp > XB_SPIN_CAP) { atomicAdd(&bar[XB_TMO], 1u); break; } }
    }
    nloc = mine > 0u ? mine : 1u; nx = cnt > 0u ? cnt : 1u;
}

__device__ __forceinline__ void xcd_barrier(const XcdBarrier& b) {
    asm volatile("s_waitcnt vmcnt(0)" ::: "memory");
    __syncthreads();
    if (b.wave == 0 && mk_lane_now() == 0) {
        unsigned* bar = b.bar;
        __builtin_amdgcn_s_waitcnt(0);
        unsigned nloc = b.st[0], nx = b.st[1];
        if (nloc == 0u) { xcd_barrier_complete(bar, b.x, nloc, nx); b.st[0] = nloc; b.st[1] = nx; }
        const unsigned old = xb_add(&bar[XB_XSUB(b.x)], 1u);
        const unsigned gen = old / nloc;
        if (old + 1u == (gen + 1u) * nloc) {
            __builtin_amdgcn_fence(__ATOMIC_RELEASE, "agent");
            asm volatile("s_waitcnt vmcnt(0)" ::: "memory");
            const unsigned og = xb_add(&bar[XB_TOP], 1u);
            const unsigned tg = og / nx;
            if (og + 1u == (tg + 1u) * nx) xb_add(&bar[XB_TOPGEN], 1u);
            else XB_SPIN(xb_ld(&bar[XB_TOPGEN]) == tg, bar);
            __builtin_amdgcn_fence(__ATOMIC_ACQUIRE, "agent");
            xb_add(&bar[XB_XGEN(b.x)], 1u);
            asm volatile("s_waitcnt vmcnt(0)" ::: "memory");
        } else {
            XB_SPIN(xb_ld(&bar[XB_XGEN(b.x)]) == gen, bar);
            __builtin_amdgcn_fence(__ATOMIC_ACQUIRE, "agent");
            asm volatile("s_waitcnt vmcnt(0)" ::: "memory");
        }
    }
    __syncthreads();
}


constexpr int NWAVES = 8;
constexpr size_t MiB = 1u << 20;
constexpr size_t WS_CTL = 0, CTL_ZERO_BYTES = 1 * MiB;
constexpr size_t WS_MOD = 1 * MiB;
constexpr size_t WS_BINP = 1 * MiB + 256 * 1024;
constexpr size_t WS_TOPI = 2 * MiB, WS_TOPG = 3 * MiB;
constexpr size_t WS_LIST = 4 * MiB;
constexpr size_t WS_WIN = 36 * MiB, WS_WA = 50 * MiB, WS_WP = 52 * MiB, WS_WO = 54 * MiB, WS_WR = 56 * MiB;
constexpr size_t WS_WDN = 60 * MiB;
constexpr size_t WS_WUP = 190 * MiB;
constexpr size_t WS_YS = 190 * MiB;
constexpr size_t WS_S0 = 448 * MiB, WS_SLOT = 64 * MiB;
constexpr size_t WS_Q = WS_S0, WS_K = WS_S0 + WS_SLOT, WS_V = WS_S0 + 2 * WS_SLOT, WS_U = WS_S0 + 3 * WS_SLOT, WS_SGA = WS_S0 + 4 * WS_SLOT, WS_SGB = WS_S0 + 5 * WS_SLOT;
constexpr size_t WS_CACT = WS_S0 + 6 * WS_SLOT, WS_H = WS_S0 + 7 * WS_SLOT, WS_OATT = WS_S0 + 7 * WS_SLOT;
constexpr size_t WS_ON = WS_S0, WS_YA = WS_S0 + WS_SLOT, WS_M = WS_S0 + 2 * WS_SLOT, WS_Z = WS_S0 + 7 * WS_SLOT, WS_H2 = WS_S0, WS_LG = WS_S0 + WS_SLOT, WS_HID = WS_S0 + 4 * WS_SLOT;
constexpr size_t WS_END = 1024 * MiB;
static_assert(WS_WDN + (size_t)NEX_ * 1024 * 256 * 2 <= WS_WUP && WS_WUP + (size_t)NEX_ * 512 * 1024 * 2 <= WS_S0 && WS_YS + (size_t)T_ * 8 * 1024 * 2 <= WS_HID, "d_ws map");
static_assert(WS_HID + (size_t)1408 * 256 * 256 * 2 <= WS_Z && WS_Z + (size_t)T_ * D_ * 4 <= WS_END, "d_ws map 2");
constexpr int CW_TMO = 0, CW_CODE = 1;
constexpr int CW_BAR = 4096;
constexpr int CW_CNT = 32768;
constexpr int CW_ERR = 65536;
constexpr int RING_OFF = 0, RING_BYTES = 131072;
constexpr int LDSCTL_OFF = RING_BYTES, MISC_OFF = LDSCTL_OFF + 320;
constexpr int UT_OFF = 132096, TAB_OFF = 133120, TOK_OFF = 137216, MAXU = 32, MAXTOK = 16;
constexpr int LDS_BYTES = TOK_OFF + MAXTOK * 1024;
static_assert(MISC_OFF + 128 <= UT_OFF && UT_OFF + MAXU * 32 <= TAB_OFF && TAB_OFF + 3 * 260 * 4 <= TOK_OFF && LDS_BYTES <= 163840, "LDS map");

enum { I_X = 0, I_C, I_ADAW, I_ADAB, I_WIN, I_BIN, I_LQ1, I_LK1, I_LQ2, I_LK2, I_SUBG, I_WAO, I_CW, I_CB, I_CLG, I_CLB, I_PWW, I_PWB, I_WOUT, I_LN1G, I_LN1B,
       I_RW, I_RB, I_W1, I_W3, I_W2, I_WS1, I_WS3, I_WS2, I_LN2G, I_LN2B, N_IN };
struct Args { const float* in[N_IN]; float* out; unsigned char* ws; int ph_lo, ph_hi; };
static_assert(sizeof(Args) == N_IN * 8 + 24, "Args has no padding");
typedef const __attribute__((address_space(4))) Args* CArgs;
__device__ __forceinline__ CArgs args_now() { auto p = __builtin_amdgcn_kernarg_segment_ptr(); asm volatile("" : "+s"(p)); return (CArgs)p; }
struct Frame {
    LAS unsigned char* lds; volatile LAS unsigned* MISC; gu32* ctl;
    int tid, lane, wave, vcu, G;
};
__device__ __forceinline__ float wave_sum(float v) {
#pragma unroll
    for (int o = 1; o < 64; o <<= 1) v += __shfl_xor(v, o);
    return v;
}
__device__ __forceinline__ float wave_sum63(float v) {
#define DPP_ADD(ctrl, rmask) v += __uint_as_float((unsigned)__builtin_amdgcn_update_dpp(0, (int)__float_as_uint(v), ctrl, rmask, 0xF, false))
    DPP_ADD(0xB1, 0xF);
    DPP_ADD(0x4E, 0xF);
    DPP_ADD(0x141, 0xF);
    DPP_ADD(0x140, 0xF);
    DPP_ADD(0x142, 0xA);
    DPP_ADD(0x143, 0xC);
#undef DPP_ADD
    return v;
}
__device__ __forceinline__ float sigm_f(float x) { return __builtin_amdgcn_rcpf(1.0f + __builtin_amdgcn_exp2f(-x * LOG2E_)); }
__device__ __forceinline__ unsigned pkbf(float lo, float hi) { return pg8::cvt_pk_bf16(lo, hi); }
__device__ __forceinline__ float bflo(unsigned w) { return __uint_as_float(w << 16); }
__device__ __forceinline__ float bfhi(unsigned w) { return __uint_as_float(w & 0xffff0000u); }

__host__ __device__ __forceinline__ int in_dest_row(int col) {
    if (col < 3072) return col;
    if (col < 5120) { const int r = col - 3072, half = r >> 10, rr = r & 1023; return 3072 + (rr >> 7) * 256 + half * 128 + (rr & 127); }
    const int r = col - 5120, half = r >> 10, rr = r & 1023; return 5120 + (rr >> 7) * 256 + half * 128 + (rr & 127);
}
__host__ __device__ __forceinline__ int in_orig_col(int rho) {
    if (rho < 3072) return rho;
    if (rho < 5120) { const int r = rho - 3072, j = r >> 8, w = r & 255; return 3072 + (w >> 7) * 1024 + j * 128 + (w & 127); }
    const int r = rho - 5120, j = r >> 8, w = r & 255; return 5120 + (w >> 7) * 1024 + j * 128 + (w & 127);
}

constexpr int CV_IN = 16 * 112, CV_SQ = 16 * 16, CV_R = 16 * 4, CV_EX = NEX_ * 64, CV_SMALL = CV_IN + 3 * CV_SQ + CV_R, CV_ALL = CV_SMALL + 3 * CV_EX;
struct CvItem { const GAS f32x4* src; GAS v4u* dst; int K, N; };
__device__ __forceinline__ CvItem cv_decode(CArgs A, int it, int lane) {
    unsigned char* ws = A->ws; const int n4 = (lane & 15) * 4, kbl = (lane >> 4) * 8;
    const float* src; bf16* dst; int K, N, k0, n0; int r = it;
    if (r < CV_IN) { const int kb = r / 112, nb = r % 112; K = 1024; N = NIN_; k0 = kb * 64; n0 = nb * 64; src = A->in[I_WIN]; dst = (bf16*)(ws + WS_WIN) + (size_t)in_dest_row(n0) * 1024; }
    else if ((r -= CV_IN) < 3 * CV_SQ) { const int w = r / CV_SQ, q = r % CV_SQ, kb = q / 16, nb = q % 16; K = 1024; N = 1024; k0 = kb * 64; n0 = nb * 64;
        src = w == 0 ? A->in[I_WAO] : (w == 1 ? A->in[I_PWW] : A->in[I_WOUT]); dst = (bf16*)(ws + (w == 0 ? WS_WA : (w == 1 ? WS_WP : WS_WO))) + (size_t)n0 * 1024; }
    else if ((r -= 3 * CV_SQ) < CV_R) { const int kb = r / 4, nb = r % 4; K = 1024; N = 256; k0 = kb * 64; n0 = nb * 64; src = A->in[I_RW]; dst = (bf16*)(ws + WS_WR) + (size_t)n0 * 1024; }
    else if ((r -= CV_R) < 2 * CV_EX) { const int w3 = r >= CV_EX; if (w3) r -= CV_EX; const int e = r / 64, q = r % 64, kb = q / 4, nb = q % 4; K = 1024; N = 256; k0 = kb * 64; n0 = nb * 64;
        src = e < NE_ ? (w3 ? A->in[I_W3] : A->in[I_W1]) + (size_t)e * 262144 : (w3 ? A->in[I_WS3] : A->in[I_WS1]);
        dst = (bf16*)(ws + WS_WUP) + ((size_t)e * 512 + (n0 >> 7) * 256 + w3 * 128 + (n0 & 127)) * 1024; }
    else { r -= 2 * CV_EX; const int e = r / 64, q = r % 64, kb = q / 16, nb = q % 16; K = 256; N = 1024; k0 = kb * 64; n0 = nb * 64;
        src = e < NE_ ? A->in[I_W2] + (size_t)e * 262144 : A->in[I_WS2]; dst = (bf16*)(ws + WS_WDN) + ((size_t)e * 1024 + n0) * 256; }
    CvItem c; c.src = (const GAS f32x4*)(src + (size_t)(k0 + kbl) * N + n0 + n4); c.dst = (GAS v4u*)(dst + (size_t)n4 * K + k0 + kbl); c.K = K; c.N = N; return c;
}
#define CV_LOAD(c, v) do { _Pragma("unroll") for (int p_ = 0; p_ < 2; ++p_) _Pragma("unroll") for (int j_ = 0; j_ < 8; ++j_) v[p_][j_] = (c).src[((size_t)(32 * p_ + j_) * (c).N) >> 2]; } while (0)
#define CV_STORE(c, v) do { _Pragma("unroll") for (int p_ = 0; p_ < 2; ++p_) _Pragma("unroll") for (int c_ = 0; c_ < 4; ++c_) { v4u o_; \
        o_.x = pkbf(v[p_][0][c_], v[p_][1][c_]); o_.y = pkbf(v[p_][2][c_], v[p_][3][c_]); o_.z = pkbf(v[p_][4][c_], v[p_][5][c_]); o_.w = pkbf(v[p_][6][c_], v[p_][7][c_]); \
        (c).dst[((size_t)c_ * (c).K + 32 * p_) >> 3] = o_; } } while (0)
__device__ __forceinline__ void convert_items(CArgs A, int gw, int NGW, int lane, int first, int last) {
    int it = first + gw; if (it >= last) return;
    CvItem cur = cv_decode(A, it, lane); f32x4 v[2][8]; CV_LOAD(cur, v);
    for (;;) {
        const int nx = it + NGW; const bool more = nx < last;
        CvItem nxt = cur; f32x4 w[2][8];
        if (more) { nxt = cv_decode(A, nx, lane); CV_LOAD(nxt, w); }
        CV_STORE(cur, v);
        if (!more) break;
#pragma unroll
        for (int p_ = 0; p_ < 2; ++p_)
#pragma unroll
            for (int j_ = 0; j_ < 8; ++j_) v[p_][j_] = w[p_][j_];
        cur = nxt; it = nx;
    }
}
struct ConvHook { CArgs A; int gw, NGW, pos;
    __device__ __forceinline__ void operator()(int i) const { if (i == pos) { convert_items(A, gw, NGW, mk_lane_now(), CV_SMALL, CV_ALL); asm volatile("s_waitcnt vmcnt(0)" ::: "memory"); } } };
__device__ __forceinline__ void p0_prologue(Frame& F, CArgs A) {
    unsigned char* ws = A->ws;
    if (blockIdx.x < 192) {
        LAS float* sc = (LAS float*)(F.lds); LAS float* part = (LAS float*)(F.lds + 32768);
        const float* c = A->in[I_C];
        for (int i = F.tid; i < 8192; i += 512) { const float v = c[i]; sc[i] = v * sigm_f(v); }
        __syncthreads();
        const int j0 = blockIdx.x * 32, kg = F.tid >> 5, col = F.tid & 31;
        const float* w = A->in[I_ADAW] + (size_t)(kg * 64) * 6144 + j0 + col;
        float acc[8] = {0.f, 0.f, 0.f, 0.f, 0.f, 0.f, 0.f, 0.f};
#pragma unroll 8
        for (int kk = 0; kk < 64; ++kk) { const float wv = w[(size_t)kk * 6144]; const int k = kg * 64 + kk;
#pragma unroll
            for (int b = 0; b < 8; ++b) acc[b] += sc[b * 1024 + k] * wv; }
#pragma unroll
        for (int b = 0; b < 8; ++b) part[(kg * 8 + b) * 32 + col] = acc[b];
        __syncthreads();
        if (F.tid < 256) { const int b = F.tid >> 5, cc = F.tid & 31; float s = A->in[I_ADAB][j0 + cc];
            for (int g = 0; g < 16; ++g) s += part[(g * 8 + b) * 32 + cc];
            ((float*)(ws + WS_MOD))[b * 6144 + j0 + cc] = s; }
        __syncthreads();
    }
    { const int gt = blockIdx.x * 512 + F.tid; if (gt < NIN_) ((float*)(ws + WS_BINP))[gt] = A->in[I_BIN][in_orig_col(gt)]; }
    convert_items(A, F.vcu * NWAVES + F.wave, F.G * NWAVES, F.lane, 0, CV_SMALL);
}
__device__ __forceinline__ void p1_modulate(Frame& F, CArgs A) {
    const int gw = F.vcu * NWAVES + F.wave, NGW = F.G * NWAVES;
    const float* mod = (const float*)(A->ws + WS_MOD); bf16* H = (bf16*)(A->ws + WS_H);
    for (int m = gw; m < T_; m += NGW) { const int b = m >> 12;
        const GAS f32x4* xr = (const GAS f32x4*)(A->in[I_X] + (size_t)m * D_) + F.lane;
        const f32x4* sh = (const f32x4*)(mod + b * 6144) + F.lane; const f32x4* sc = (const f32x4*)(mod + b * 6144 + 1024) + F.lane;
        GAS unsigned long long* o8 = (GAS unsigned long long*)(H + (size_t)m * D_) + F.lane;
#pragma unroll
        for (int j = 0; j < 4; ++j) { const f32x4 v = xr[64 * j], s = sc[64 * j], h = sh[64 * j]; const f32x4 o = v * (s + 1.0f) + h;
            o8[64 * j] = (unsigned long long)pkbf(o.x, o.y) | ((unsigned long long)pkbf(o.z, o.w) << 32); } }
}
__device__ __forceinline__ void p3_conv(Frame& F, CArgs A) {
    typedef float f32x2 __attribute__((ext_vector_type(2)));
    LAS unsigned* U = (LAS unsigned*)(F.lds);
    LAS v4u* U16 = (LAS v4u*)(F.lds);
    LAS float* ST = (LAS float*)(F.lds + 126976);
    LAS float* MS = ST + 256;
    const bf16* ug = (const bf16*)(A->ws + WS_U); unsigned* co = (unsigned*)(A->ws + WS_CACT);
    const int c0 = 2 * F.tid;
    f32x2 w[31];
#pragma unroll
    for (int j = 0; j < 31; ++j) w[j] = *(const f32x2*)(A->in[I_CW] + j * 1024 + c0);
    const f32x2 cb = *(const f32x2*)(A->in[I_CB] + c0), g = *(const f32x2*)(A->in[I_CLG] + c0), be = *(const f32x2*)(A->in[I_CLB] + c0);
    for (int tile = F.vcu; tile < T_ / 32; tile += F.G) {
        const int t0 = tile * 32, tb = t0 & (SEQ_ - 1);
        {
            v4u sv[16];
#pragma unroll
            for (int i = 0; i < 16; ++i) { const int ch = F.tid + 512 * i, r = ch >> 7, cc = ch & 127; const int pos = tb - 30 + r;
                sv[i] = (v4u){0u, 0u, 0u, 0u}; if (ch < 62 * 128 && pos >= 0) sv[i] = *(const GAS v4u*)(ug + (size_t)(t0 - 30 + r) * D_ + cc * 8); }
#pragma unroll
            for (int i = 0; i < 16; ++i) { const int ch = F.tid + 512 * i; if (ch < 62 * 128) U16[ch] = sv[i]; }
        }
        __syncthreads();
#pragma unroll 1
        for (int half = 0; half < 2; ++half) {
            f32x2 y[16];
#pragma unroll
            for (int chunk = 0; chunk < 2; ++chunk) {
                f32x2 v[38];
#pragma unroll
                for (int r = 0; r < 38; ++r) { const unsigned x = U[(half * 16 + chunk * 8 + r) * 512 + F.tid]; v[r] = (f32x2){bflo(x), bfhi(x)}; }
#pragma unroll
                for (int tt = 0; tt < 8; ++tt) { f32x2 a = cb;
#pragma unroll
                    for (int j = 0; j < 31; ++j) a = __builtin_elementwise_fma(w[j], v[tt + j], a);
                    y[chunk * 8 + tt] = a; }
            }
#pragma unroll
            for (int tt = 0; tt < 16; ++tt) { const float s = wave_sum63(y[tt].x + y[tt].y), q = wave_sum63(y[tt].x * y[tt].x + y[tt].y * y[tt].y);
                if (F.lane == 63) { ST[(F.wave * 16 + tt) * 2] = s; ST[(F.wave * 16 + tt) * 2 + 1] = q; } }
            __syncthreads();
            if (F.tid < 16) { float s = 0.f, q = 0.f;
                for (int wv = 0; wv < 8; ++wv) { s += ST[(wv * 16 + F.tid) * 2]; q += ST[(wv * 16 + F.tid) * 2 + 1]; }
                const float mean = s * (1.f / 1024.f), var = q * (1.f / 1024.f) - mean * mean;
                MS[F.tid * 2] = mean; MS[F.tid * 2 + 1] = 1.0f / sqrtf(fmaxf(var, 0.f) + LN_EPS_); }
            __syncthreads();
#pragma unroll
            for (int tt = 0; tt < 16; ++tt) { const float mean = MS[tt * 2], rstd = MS[tt * 2 + 1];
                const f32x2 z = (y[tt] - mean) * rstd * g + be;
                co[((size_t)(t0 + half * 16 + tt) * D_ + c0) >> 1] = pkbf(z.x * sigm_f(z.x), z.y * sigm_f(z.y)); }
        }
        __syncthreads();
    }
}
__device__ __forceinline__ void p4_onorm(Frame& F, CArgs A) {
    const int gw = F.vcu * NWAVES + F.wave, NGW = F.G * NWAVES;
    const float s1 = wave_sum(A->in[I_LQ1][F.lane] * A->in[I_LK1][F.lane]), s2 = wave_sum(A->in[I_LQ2][F.lane] * A->in[I_LK2][F.lane]);
    const float lam = expf(s1) - expf(s2) + LAM_INIT_;
    const int h = F.lane >> 3, dv0 = (F.lane & 7) * 16;
    float g[16];
#pragma unroll
    for (int i = 0; i < 16; ++i) g[i] = A->in[I_SUBG][dv0 + i] * (1.0f - LAM_INIT_);
    const bf16* O = (const bf16*)(A->ws + WS_OATT); bf16* ON = (bf16*)(A->ws + WS_ON);
    for (int m = gw; m < T_; m += NGW) {
        const GAS v4u* p0 = (const GAS v4u*)(O + (size_t)m * 2048 + h * 256 + dv0); const GAS v4u* p1 = (const GAS v4u*)(O + (size_t)m * 2048 + h * 256 + 128 + dv0);
        const v4u a0 = p0[0], a1 = p0[1], b0 = p1[0], b1 = p1[1];
        float o[16];
#define P4_UNP(dst, A_, B_, k) { o[dst] = bflo(A_[k]) - lam * bflo(B_[k]); o[dst + 1] = bfhi(A_[k]) - lam * bfhi(B_[k]); }
        P4_UNP(0, a0, b0, 0) P4_UNP(2, a0, b0, 1) P4_UNP(4, a0, b0, 2) P4_UNP(6, a0, b0, 3) P4_UNP(8, a1, b1, 0) P4_UNP(10, a1, b1, 1) P4_UNP(12, a1, b1, 2) P4_UNP(14, a1, b1, 3)
#undef P4_UNP
        float ss = 0.f;
#pragma unroll
        for (int i = 0; i < 16; ++i) ss += o[i] * o[i];
        ss += __shfl_xor(ss, 1); ss += __shfl_xor(ss, 2); ss += __shfl_xor(ss, 4);
        const float r = 1.0f / sqrtf(ss * (1.f / 128.f) + RMS_EPS_);
        v4u w0, w1;
        w0.x = pkbf(o[0] * r * g[0], o[1] * r * g[1]); w0.y = pkbf(o[2] * r * g[2], o[3] * r * g[3]); w0.z = pkbf(o[4] * r * g[4], o[5] * r * g[5]); w0.w = pkbf(o[6] * r * g[6], o[7] * r * g[7]);
        w1.x = pkbf(o[8] * r * g[8], o[9] * r * g[9]); w1.y = pkbf(o[10] * r * g[10], o[11] * r * g[11]); w1.z = pkbf(o[12] * r * g[12], o[13] * r * g[13]); w1.w = pkbf(o[14] * r * g[14], o[15] * r * g[15]);
        GAS v4u* q = (GAS v4u*)(ON + (size_t)m * D_ + h * 128 + dv0); q[0] = w0; q[1] = w1;
    }
}
__device__ __forceinline__ void p7_ln1(Frame& F, CArgs A) {
    const int gw = F.vcu * NWAVES + F.wave, NGW = F.G * NWAVES;
    const float* mod = (const float*)(A->ws + WS_MOD); float* Z = (float*)(A->ws + WS_Z); bf16* H2 = (bf16*)(A->ws + WS_H2);
    f32x4 lg[4], lb[4];
#pragma unroll
    for (int j = 0; j < 4; ++j) { lg[j] = ((const f32x4*)A->in[I_LN1G])[F.lane + 64 * j]; lb[j] = ((const f32x4*)A->in[I_LN1B])[F.lane + 64 * j]; }
    for (int m = gw; m < T_; m += NGW) { const int b = m >> 12;
        GAS f32x4* zr = (GAS f32x4*)(Z + (size_t)m * D_) + F.lane;
        f32x4 v[4]; float s = 0.f;
#pragma unroll
        for (int j = 0; j < 4; ++j) { v[j] = zr[64 * j]; s += (v[j].x + v[j].y) + (v[j].z + v[j].w); }
        const float mean = wave_sum(s) * (1.f / D_); float s2 = 0.f;
#pragma unroll
        for (int j = 0; j < 4; ++j) { v[j] = v[j] - mean; s2 += (v[j].x * v[j].x + v[j].y * v[j].y) + (v[j].z * v[j].z + v[j].w * v[j].w); }
        const float rstd = 1.f / sqrtf(wave_sum(s2) * (1.f / D_) + LN_EPS_);
        const f32x4* sh = (const f32x4*)(mod + b * 6144 + 3072) + F.lane; const f32x4* sc = (const f32x4*)(mod + b * 6144 + 4096) + F.lane;
        GAS unsigned long long* o8 = (GAS unsigned long long*)(H2 + (size_t)m * D_) + F.lane;
#pragma unroll
        for (int j = 0; j < 4; ++j) { const f32x4 x1 = v[j] * rstd * lg[j] + lb[j]; zr[64 * j] = x1;
            const f32x4 o = x1 * (sc[64 * j] + 1.0f) + sh[64 * j];
            o8[64 * j] = (unsigned long long)pkbf(o.x, o.y) | ((unsigned long long)pkbf(o.z, o.w) << 32); }
    }
}
__device__ __forceinline__ void p9_route(Frame& F, CArgs A) {
    const float* lg = (const float*)(A->ws + WS_LG); int* topi = (int*)(A->ws + WS_TOPI); float* topg = (float*)(A->ws + WS_TOPG); int* list = (int*)(A->ws + WS_LIST);
    gu32* gcnt = F.ctl + CW_CNT;
    LAS int* hist = (LAS int*)(F.lds); LAS int* basel = hist + 256; LAS int* sel = basel + 256;
    float rb[4];
#pragma unroll
    for (int j = 0; j < 4; ++j) rb[j] = A->in[I_RB][F.lane + 64 * j];
    const int hf = F.lane >> 5;
    for (int tb = F.vcu; tb < T_ / 128; tb += F.G) {
        if (F.tid < 256) hist[F.tid] = 0;
        __syncthreads();
        for (int i = 0; i < 16; ++i) { const int t = tb * 128 + F.wave * 16 + i;
            float s[4], c[4], gs[4];
#pragma unroll
            for (int j = 0; j < 4; ++j) { s[j] = sigm_f(lg[(size_t)t * NE_ + F.lane + 64 * j]); c[j] = s[j] + rb[j]; }
#pragma unroll
            for (int j = 0; j < 4; ++j) { float m1 = c[j];
#pragma unroll
                for (int o = 1; o < 32; o <<= 1) m1 = fmaxf(m1, __shfl_xor(m1, o));
                const unsigned long long bal = __ballot(c[j] == m1); const unsigned hb = hf ? (unsigned)(bal >> 32) : (unsigned)bal; const int first = (__ffs((int)hb) - 1) + (F.lane & 32);
                float m2 = (F.lane == first) ? -INFINITY : c[j];
#pragma unroll
                for (int o = 1; o < 32; o <<= 1) m2 = fmaxf(m2, __shfl_xor(m2, o));
                gs[j] = m1 + m2; }
            float G8[8];
#pragma unroll
            for (int j = 0; j < 4; ++j) { G8[2 * j] = __uint_as_float(__builtin_amdgcn_readlane(__float_as_uint(gs[j]), 0)); G8[2 * j + 1] = __uint_as_float(__builtin_amdgcn_readlane(__float_as_uint(gs[j]), 32)); }
#pragma unroll
            for (int j = 0; j < 4; ++j) { const float mine = hf ? G8[2 * j + 1] : G8[2 * j]; const int g = 2 * j + hf; int rank = 0;
#pragma unroll
                for (int gp = 0; gp < 8; ++gp) rank += (G8[gp] > mine || (G8[gp] == mine && gp < g)) ? 1 : 0;
                if (rank >= 4) c[j] = -INFINITY; }
            int ek = 0; float sk = 0.f, ssum = 0.f;
#pragma unroll
            for (int k = 0; k < 8; ++k) { float wm = fmaxf(fmaxf(c[0], c[1]), fmaxf(c[2], c[3]));
#pragma unroll
                for (int o = 1; o < 64; o <<= 1) wm = fmaxf(wm, __shfl_xor(wm, o));
                int e = 0x7fffffff;
#pragma unroll
                for (int j = 3; j >= 0; --j) if (c[j] == wm) e = F.lane + 64 * j;
#pragma unroll
                for (int o = 1; o < 64; o <<= 1) e = min(e, __shfl_xor(e, o));
                float sv = 0.f;
#pragma unroll
                for (int j = 0; j < 4; ++j) if (F.lane + 64 * j == e) { sv = s[j]; c[j] = -INFINITY; }
                sv = __shfl(sv, e & 63);
                ssum += sv; if (F.lane == k) { ek = e; sk = sv; } }
            if (F.lane < 8) { const int a = t * 8 + F.lane; topi[a] = ek; topg[a] = sk / ssum * ROUTED_SCALE_;
                const int lr = __hip_atomic_fetch_add(&hist[ek], 1, __ATOMIC_RELAXED, __HIP_MEMORY_SCOPE_WORKGROUP); sel[(F.wave * 16 + i) * 8 + F.lane] = ek | (lr << 16); }
        }
        __syncthreads();
        if (F.tid < 256) { const int h = hist[F.tid]; int base = 0; if (h > 0) base = (int)__hip_atomic_fetch_add(gcnt + 64 * F.tid, (unsigned)h, __ATOMIC_RELAXED, __HIP_MEMORY_SCOPE_AGENT); basel[F.tid] = base; }
        __syncthreads();
        for (int q = F.lane; q < 128; q += 64) { const int i = q >> 3, k = q & 7, v = sel[(F.wave * 16 + i) * 8 + k], e = v & 0xffff, lr = v >> 16, t = tb * 128 + F.wave * 16 + i;
            list[(size_t)e * T_ + basel[e] + lr] = t * 8 + k; }
        __syncthreads();
    }
}
template <int NP, bool FILL_TOK>
__device__ __forceinline__ int moe_setup(Frame& F, CArgs A) {
    LAS int* UT = (LAS int*)(F.lds + UT_OFF); LAS int* NT = (LAS int*)(F.lds + TAB_OFF); LAS int* TS = NT + 260; LAS int* CN = TS + 260; LAS int* TOK = (LAS int*)(F.lds + TOK_OFF);
    const int* list = (const int*)(A->ws + WS_LIST);
    if (F.tid < NEX_) { int c = T_; if (F.tid < NE_) { c = (int)__hip_atomic_load(F.ctl + CW_CNT + 64 * F.tid, __ATOMIC_RELAXED, __HIP_MEMORY_SCOPE_AGENT); c = c < 0 ? 0 : (c > T_ ? T_ : c); } CN[F.tid] = c; NT[F.tid] = (c + 255) >> 8; }
    __syncthreads();
    if (F.wave == 0) { int loc[5]; int s = 0;
#pragma unroll
        for (int i = 0; i < 5; ++i) { const int idx = 5 * F.lane + i; loc[i] = s; s += (idx < NEX_) ? NT[idx] : 0; }
        int incl = s;
#pragma unroll
        for (int o = 1; o < 64; o <<= 1) { const int n = __shfl_up(incl, o); if (F.lane >= o) incl += n; }
        const int excl = incl - s;
#pragma unroll
        for (int i = 0; i < 5; ++i) { const int idx = 5 * F.lane + i; if (idx < NEX_) TS[idx] = excl + loc[i]; }
        if (F.lane == 63) TS[NEX_] = incl; }
    __syncthreads();
    const int total = TS[NEX_] * NP;
    int nun = (F.vcu < total) ? (total - F.vcu + F.G - 1) / F.G : 0;
    if (nun > (FILL_TOK ? MAXTOK : MAXU)) { nun = FILL_TOK ? MAXTOK : MAXU; if (F.tid == 0) __hip_atomic_store(F.ctl + CW_TMO, 0xBAD0u, RLX_AGENT); }
    if (F.tid < nun) { const int L = F.tid * F.G + F.vcu, rtg = L / NP, pn = L % NP; int lo = 0, hi = NE_;
        while (lo < hi) { const int mid = (lo + hi + 1) >> 1; if (TS[mid] <= rtg) lo = mid; else hi = mid - 1; }
        const int e = lo, rt = rtg - TS[e]; int nr = CN[e] - rt * 256; nr = nr > 256 ? 256 : nr;
        UT[F.tid * 8 + 0] = e; UT[F.tid * 8 + 1] = rt; UT[F.tid * 8 + 2] = pn; UT[F.tid * 8 + 3] = nr; UT[F.tid * 8 + 4] = rtg; }
    __syncthreads();
    if (FILL_TOK) {
        for (int sl = 0; sl < nun; ++sl) if (F.tid < 256) { const int e = UT[sl * 8], rt = UT[sl * 8 + 1], nr = UT[sl * 8 + 3]; int tok = 0;
            if (F.tid < nr) tok = (e < NE_) ? (list[(size_t)e * T_ + rt * 256 + F.tid] >> 3) : (rt * 256 + F.tid);
            TOK[sl * 256 + F.tid] = tok; }
        __syncthreads();
    }
    return nun;
}
__device__ __forceinline__ void p12_final(Frame& F, CArgs A, bool poison) {
    typedef float f32x2 __attribute__((ext_vector_type(2)));
    const int gw = F.vcu * NWAVES + F.wave, NGW = F.G * NWAVES;
    const float* mod = (const float*)(A->ws + WS_MOD); const float* XB = (const float*)(A->ws + WS_Z); const unsigned char* YS = (const unsigned char*)(A->ws + WS_YS);
    const float qnan = __builtin_nanf(""); const int c = 16 * F.lane;
    for (int m0 = gw; m0 < T_; m0 += 2 * NGW) {
        v4u yw[2][8]; f32x4 xb[2][4];
#pragma unroll
        for (int rr = 0; rr < 2; ++rr) { const int m = (m0 + rr * NGW < T_) ? m0 + rr * NGW : m0;
#pragma unroll
            for (int k = 0; k < 8; ++k) yw[rr][k] = *(const GAS v4u*)(YS + ((size_t)m * 8 + k) * D_ + c);
#pragma unroll
            for (int q = 0; q < 4; ++q) xb[rr][q] = *(const GAS f32x4*)(XB + (size_t)m * D_ + c + 4 * q); }
#pragma unroll
        for (int rr = 0; rr < 2; ++rr) { const int m = m0 + rr * NGW; if (m >= T_) break; const int b = m >> 12;
            f32x4 v[4]; float s = 0.f;
#pragma unroll
            for (int q = 0; q < 4; ++q) { f32x4 a = (f32x4){0.f, 0.f, 0.f, 0.f};
#pragma unroll
                for (int k = 0; k < 8; ++k) { const int w = (int)yw[rr][k][q]; const f32x2 lo = __builtin_amdgcn_cvt_pk_f32_fp8(w, false), hi = __builtin_amdgcn_cvt_pk_f32_fp8(w, true); a += (f32x4){lo.x, lo.y, hi.x, hi.y}; }
                const f32x4 g = *(const f32x4*)(mod + b * 6144 + 5120 + c + 4 * q) * (1.0f / pg8::YS_SCALE);
                v[q] = xb[rr][q] + g * a; s += (v[q].x + v[q].y) + (v[q].z + v[q].w); }
            const float mean = wave_sum(s) * (1.f / D_); float s2 = 0.f;
#pragma unroll
            for (int q = 0; q < 4; ++q) { v[q] = v[q] - mean; s2 += (v[q].x * v[q].x + v[q].y * v[q].y) + (v[q].z * v[q].z + v[q].w * v[q].w); }
            const float rstd = 1.f / sqrtf(wave_sum(s2) * (1.f / D_) + LN_EPS_);
#pragma unroll
            for (int q = 0; q < 4; ++q) { f32x4 o = v[q] * rstd * *(const f32x4*)(A->in[I_LN2G] + c + 4 * q) + *(const f32x4*)(A->in[I_LN2B] + c + 4 * q);
                if (poison) o = (f32x4){qnan, qnan, qnan, qnan};
                *(GAS f32x4*)(A->out + (size_t)m * D_ + c + 4 * q) = o; }
        }
    }
}

constexpr int NPH = 13;
#ifndef REP_PH
#define REP_PH (-1)
#endif
#ifndef REP_N
#define REP_N 2
#endif
#define NREP(k) ((k) == REP_PH ? REP_N : 1)
__global__ void __launch_bounds__(NWAVES * 64, 2) mk_fwd(Args args) {
    extern __shared__ __attribute__((aligned(16))) unsigned char lds[];
    Frame F;
    F.lds = (LAS unsigned char*)lds;
    F.MISC = (volatile LAS unsigned*)(F.lds + MISC_OFF);
    #define REFRESH() do { F.lane = mk_lane_now(); F.tid = F.wave * 64 + F.lane; } while (0)
    F.wave = __builtin_amdgcn_readfirstlane((int)threadIdx.x >> 6); REFRESH();
    F.G = gridDim.x; { const int bx = blockIdx.x; F.vcu = (F.G % 8 == 0) ? (bx % 8) * (F.G / 8) + bx / 8 : bx; }
    F.ctl = (gu32*)(args.ws + WS_CTL);
    for (int u = F.tid; u < (LDS_BYTES - LDSCTL_OFF) / 4; u += NWAVES * 64) ((LAS unsigned*)(F.lds + LDSCTL_OFF))[u] = 0u;
    __syncthreads();
    const int lo = args.ph_lo, hi = args.ph_hi;
    XcdBarrier bar; bar.bar = (unsigned*)(F.ctl + CW_BAR); bar.x = 0; bar.st = nullptr; bar.wave = F.wave;
    if (hi - lo > 1) { bar = xcd_barrier_post((unsigned*)(F.ctl + CW_BAR), F.MISC + 8); bar.wave = F.wave; }
#define IN(k) (lo <= (k) && (k) < hi)
#define BOTH(k) (IN(k) && IN((k) + 1))
#define GRID_BAR() xcd_barrier(bar)

    if (IN(0)) _Pragma("unroll") for (int rep_ = 0; rep_ < NREP(0); ++rep_) { if (rep_ > 0) GRID_BAR(); REFRESH(); CArgs A = args_now(); unsigned char* ws = A->ws; p0_prologue(F, A); if (BOTH(0)) GRID_BAR(); }
    if (IN(1)) _Pragma("unroll") for (int rep_ = 0; rep_ < NREP(1); ++rep_) { if (rep_ > 0) GRID_BAR(); REFRESH(); CArgs A = args_now(); unsigned char* ws = A->ws; p1_modulate(F, A); if (BOTH(1)) GRID_BAR(); }
    if (IN(2)) _Pragma("unroll") for (int rep_ = 0; rep_ < NREP(2); ++rep_) { if (rep_ > 0) GRID_BAR(); REFRESH(); CArgs A = args_now(); unsigned char* ws = A->ws;
        pg8::Gemm g{(const pg8::bf16_t*)(ws + WS_H), (const pg8::bf16_t*)(ws + WS_WIN)}; pg8::StaticOrder S; S.init(T_, NIN_, F.G, (int)blockIdx.x);
        pg8::EpiInproj E{(pg8::bf16_t*)(ws + WS_Q), (size_t)(WS_SLOT / 2), (pg8::bf16_t*)(ws + WS_U), (pg8::bf16_t*)(ws + WS_SGA), (pg8::bf16_t*)(ws + WS_SGB),
                         (const float*)(ws + WS_BINP), attn_body::C2};
        pg8::gemm_phase<D_, pg8::EpiInproj, pg8::StaticOrder, PG8_ALIGN, PG8_SP2, false>(F.lds + RING_OFF, g, S, E, F.wave);
        if (BOTH(2)) GRID_BAR();
    }
    if (IN(3)) _Pragma("unroll") for (int rep_ = 0; rep_ < NREP(3); ++rep_) { if (rep_ > 0) GRID_BAR(); REFRESH(); CArgs A = args_now(); unsigned char* ws = A->ws;
#ifndef REP_CONV
#define REP_CONV 1
#endif
        p3_conv(F, A); __syncthreads();
        const attn_body::AttnTensors AT{(const attn_body::bf16*)(ws + WS_Q), (const attn_body::bf16*)(ws + WS_K), (const attn_body::bf16*)(ws + WS_V), (attn_body::bf16*)(ws + WS_OATT)};
        const attn_body::StaticOrder S((int)F.G, F.vcu);
        const int grp_ = F.vcu & 3; const ConvHook HK{A, F.vcu * NWAVES + F.wave, F.G * NWAVES, grp_ == 0 ? 0 : (grp_ == 1 ? 2 : (grp_ == 2 ? 5 : 8))};
        attn_body::attn_phase<attn_body::StaticOrder>((char*)lds + RING_OFF, AT, S, F.wave, HK);
        if (BOTH(3)) GRID_BAR();
    }
    if (IN(4)) _Pragma("unroll") for (int rep_ = 0; rep_ < NREP(4); ++rep_) { if (rep_ > 0) GRID_BAR(); REFRESH(); CArgs A = args_now(); unsigned char* ws = A->ws; if (REP_CONV > 1) { p3_conv(F, A); __syncthreads(); } p4_onorm(F, A); if (BOTH(4)) GRID_BAR(); }
    if (IN(5)) _Pragma("unroll") for (int rep_ = 0; rep_ < NREP(5); ++rep_) { if (rep_ > 0) GRID_BAR(); REFRESH(); CArgs A = args_now(); unsigned char* ws = A->ws;
        { pg8::Gemm g{(const pg8::bf16_t*)(ws + WS_ON), (const pg8::bf16_t*)(ws + WS_WA)}; pg8::StaticOrder S; S.init(T_, D_, F.G, (int)blockIdx.x);
          pg8::EpiYa E{(const pg8::bf16_t*)(ws + WS_SGA), (pg8::bf16_t*)(ws + WS_YA)};
          pg8::gemm_phase<D_, pg8::EpiYa, pg8::StaticOrder, PG8_ALIGN, PG8_SP2, false>(F.lds + RING_OFF, g, S, E, F.wave); }
        asm volatile("s_waitcnt vmcnt(0)" ::: "memory"); __syncthreads();
        { pg8::Gemm g{(const pg8::bf16_t*)(ws + WS_CACT), (const pg8::bf16_t*)(ws + WS_WP)}; pg8::StaticOrder S; S.init(T_, D_, F.G, (int)blockIdx.x);
          pg8::EpiM E{(const pg8::bf16_t*)(ws + WS_SGB), (const pg8::bf16_t*)(ws + WS_YA), (pg8::bf16_t*)(ws + WS_M), A->in[I_PWB]};
          pg8::gemm_phase<D_, pg8::EpiM, pg8::StaticOrder, PG8_ALIGN, PG8_SP2, false>(F.lds + RING_OFF, g, S, E, F.wave); }
        if (BOTH(5)) GRID_BAR();
    }
    if (IN(6)) _Pragma("unroll") for (int rep_ = 0; rep_ < NREP(6); ++rep_) { if (rep_ > 0) GRID_BAR(); REFRESH(); CArgs A = args_now(); unsigned char* ws = A->ws;
        pg8::Gemm g{(const pg8::bf16_t*)(ws + WS_M), (const pg8::bf16_t*)(ws + WS_WO)}; pg8::StaticOrder S; S.init(T_, D_, F.G, (int)blockIdx.x);
        pg8::EpiZ E{A->in[I_X], (const float*)(ws + WS_MOD), (float*)(ws + WS_Z)};
        pg8::gemm_phase<D_, pg8::EpiZ, pg8::StaticOrder, PG8_ALIGN, PG8_SP2, false>(F.lds + RING_OFF, g, S, E, F.wave);
        if (BOTH(6)) GRID_BAR();
    }
    if (IN(7)) _Pragma("unroll") for (int rep_ = 0; rep_ < NREP(7); ++rep_) { if (rep_ > 0) GRID_BAR(); REFRESH(); CArgs A = args_now(); unsigned char* ws = A->ws; p7_ln1(F, A); if (BOTH(7)) GRID_BAR(); }
    if (IN(8)) _Pragma("unroll") for (int rep_ = 0; rep_ < NREP(8); ++rep_) { if (rep_ > 0) GRID_BAR(); REFRESH(); CArgs A = args_now(); unsigned char* ws = A->ws;
        pg8::Gemm g{(const pg8::bf16_t*)(ws + WS_H2), (const pg8::bf16_t*)(ws + WS_WR)}; pg8::StaticOrder S; S.init(T_, NE_, F.G, (int)blockIdx.x);
        pg8::EpiLogit E{(float*)(ws + WS_LG)};
        pg8::gemm_phase<D_, pg8::EpiLogit, pg8::StaticOrder, PG8_ALIGN, PG8_SP2, false>(F.lds + RING_OFF, g, S, E, F.wave);
        if (BOTH(8)) GRID_BAR();
    }
    if (IN(9)) _Pragma("unroll") for (int rep_ = 0; rep_ < NREP(9); ++rep_) { if (rep_ > 0) GRID_BAR(); REFRESH(); CArgs A = args_now(); unsigned char* ws = A->ws; p9_route(F, A); if (BOTH(9)) GRID_BAR(); }
    if (IN(10)) _Pragma("unroll") for (int rep_ = 0; rep_ < NREP(10); ++rep_) { if (rep_ > 0) GRID_BAR(); REFRESH(); CArgs A = args_now(); unsigned char* ws = A->ws;
        const int nun = moe_setup<2, true>(F, A);
        pg8::Gemm g{(const pg8::bf16_t*)(ws + WS_H2), (const pg8::bf16_t*)(ws + WS_WUP)};
        typedef pg8::MoeOrder<2, false, (unsigned)(D_ * 2)> OrdUp; OrdUp S{(const PG8_LAS int*)(F.lds + UT_OFF), (const PG8_LAS int*)(F.lds + TOK_OFF), nun};
        pg8::EpiSwiglu E{(pg8::bf16_t*)(ws + WS_HID)};
        pg8::gemm_phase<D_, pg8::EpiSwiglu, OrdUp, PG8_ALIGN, PG8_SP2, true>(F.lds + RING_OFF, g, S, E, F.wave);
        if (BOTH(10)) GRID_BAR();
    }
    if (IN(11)) _Pragma("unroll") for (int rep_ = 0; rep_ < NREP(11); ++rep_) { if (rep_ > 0) GRID_BAR(); REFRESH(); CArgs A = args_now(); unsigned char* ws = A->ws;
        const int nun = moe_setup<4, false>(F, A);
        pg8::Gemm g{(const pg8::bf16_t*)(ws + WS_HID), (const pg8::bf16_t*)(ws + WS_WDN)};
        typedef pg8::MoeOrder<4, true, 0u> OrdDn; OrdDn S{(const PG8_LAS int*)(F.lds + UT_OFF), (const PG8_LAS int*)(F.lds + TOK_OFF), nun};
        pg8::EpiDown E{(const int*)(ws + WS_LIST), (const float*)(ws + WS_TOPG), (unsigned char*)(ws + WS_YS), (float*)(ws + WS_Z), (const float*)(ws + WS_MOD)};
        pg8::gemm_phase<FE_, pg8::EpiDown, OrdDn, PG8_ALIGN, PG8_SP2, false>(F.lds + RING_OFF, g, S, E, F.wave);
        if (BOTH(11)) GRID_BAR();
    }
    if (IN(12)) _Pragma("unroll") for (int rep_ = 0; rep_ < NREP(12); ++rep_) { if (rep_ > 0) GRID_BAR(); REFRESH(); CArgs A = args_now(); unsigned char* ws = A->ws;
        bool poison = __hip_atomic_load(F.ctl + CW_TMO, RLX_AGENT) != 0u;
        poison |= __hip_atomic_load((gu32*)((const unsigned*)(F.ctl + CW_BAR) + XB_TMO), RLX_AGENT) != 0u;
        p12_final(F, A, poison);
    }
#undef IN
#undef BOTH
#undef GRID_BAR
}

#if DBG_CHECK
namespace chk {
__device__ __forceinline__ float bf2f(unsigned short h) { return __uint_as_float((unsigned)h << 16); }
__device__ __forceinline__ float rbf(float f) { unsigned u = __float_as_uint(f); u = (u + 0x7fffu + ((u >> 16) & 1u)) & 0xffff0000u; return __uint_as_float(u); }
__device__ __forceinline__ unsigned hashu(unsigned x) { x ^= x >> 16; x *= 0x7feb352dU; x ^= x >> 15; x *= 0x846ca68bU; x ^= x >> 16; return x; }
__device__ __forceinline__ void errmax(unsigned* ctl, int id, float got, float ref, float atol) { float e = fabsf(got - ref) / (fabsf(ref) + atol); if (!(e == e) || e > 1e30f) e = 1e30f; atomicMax(ctl + CW_ERR + id, __float_as_uint(e)); }
__device__ __forceinline__ float sig(float x) { return 1.0f / (1.0f + expf(-x)); }
__device__ __forceinline__ float dotbf(const unsigned short* a, const unsigned short* b, int n) { float s = 0.f; for (int k = 0; k < n; ++k) s += bf2f(a[k]) * bf2f(b[k]); return s; }
__device__ __forceinline__ float blk_sum(float v, float* sh) { __syncthreads(); sh[threadIdx.x] = v; __syncthreads(); for (int o = 128; o > 0; o >>= 1) { if ((int)threadIdx.x < o) sh[threadIdx.x] += sh[threadIdx.x + o]; __syncthreads(); } const float r = sh[0]; __syncthreads(); return r; }
__device__ __forceinline__ float blk_max(float v, float* sh) { __syncthreads(); sh[threadIdx.x] = v; __syncthreads(); for (int o = 128; o > 0; o >>= 1) { if ((int)threadIdx.x < o) sh[threadIdx.x] = fmaxf(sh[threadIdx.x], sh[threadIdx.x + o]); __syncthreads(); } const float r = sh[0]; __syncthreads(); return r; }
}
__global__ void __launch_bounds__(256) chk_phase(Args a, int ph) {
    using namespace chk;
    __shared__ float sh[256]; __shared__ float big[4096];
    unsigned char* ws = a.ws; unsigned* ctl = (unsigned*)(ws + WS_CTL);
    const int gs = blockIdx.x * 256 + threadIdx.x; const unsigned h1 = hashu(gs * 3 + 1 + ph * 7919), h2 = hashu(h1 + 17), h3 = hashu(h2 + 29);
    const float* mod = (const float*)(ws + WS_MOD);
    typedef unsigned short us;
    if (ph == 0) {
        if (gs < 512) { const int b = gs & 7, j = h1 % 6144; float s = a.in[I_ADAB][j]; for (int k = 0; k < 1024; ++k) { const float c = a.in[I_C][b * 1024 + k]; s += c * sig(c) * a.in[I_ADAW][(size_t)k * 6144 + j]; } errmax(ctl, 1, mod[b * 6144 + j], s, 0.02f); }
        const int which = (gs % 8 == 5 || gs % 8 == 6) ? 7 : gs % 8; float got = 0.f, ref = 0.f;
        if (which == 0) { const int r = h1 % NIN_, k = h2 % 1024; got = bf2f(((const us*)(ws + WS_WIN))[(size_t)r * 1024 + k]); ref = rbf(a.in[I_WIN][(size_t)k * NIN_ + in_orig_col(r)]); }
        else if (which <= 3) { const int n = h1 % 1024, k = h2 % 1024; const float* src = which == 1 ? a.in[I_WAO] : (which == 2 ? a.in[I_PWW] : a.in[I_WOUT]); const us* d = (const us*)(ws + (which == 1 ? WS_WA : (which == 2 ? WS_WP : WS_WO))); got = bf2f(d[(size_t)n * 1024 + k]); ref = rbf(src[(size_t)k * 1024 + n]); }
        else if (which == 4) { const int n = h1 % 256, k = h2 % 1024; got = bf2f(((const us*)(ws + WS_WR))[(size_t)n * 1024 + k]); ref = rbf(a.in[I_RW][(size_t)k * 256 + n]); }
        else if (which == 5) { const int e = h1 % NEX_, r = h2 % 512, k = h3 % 1024, pn = r >> 8, w = r & 255, is3 = w >> 7, n = pn * 128 + (w & 127);
            const float* src = e < NE_ ? (is3 ? a.in[I_W3] : a.in[I_W1]) + (size_t)e * 262144 : (is3 ? a.in[I_WS3] : a.in[I_WS1]);
            got = bf2f(((const us*)(ws + WS_WUP))[((size_t)e * 512 + r) * 1024 + k]); ref = rbf(src[(size_t)k * 256 + n]); }
        else if (which == 6) { const int e = h1 % NEX_, n = h2 % 1024, k = h3 % 256; const float* src = e < NE_ ? a.in[I_W2] + (size_t)e * 262144 : a.in[I_WS2];
            got = bf2f(((const us*)(ws + WS_WDN))[((size_t)e * 1024 + n) * 256 + k]); ref = rbf(src[(size_t)k * 1024 + n]); }
        else { const int r = h1 % NIN_; got = ((const float*)(ws + WS_BINP))[r]; ref = a.in[I_BIN][in_orig_col(r)]; }
        errmax(ctl, 2, got, ref, 1e-3f);
    } else if (ph == 1) {
        const int row = h1 % T_, col = h2 % D_, b = row >> 12; const float ref = a.in[I_X][(size_t)row * D_ + col] * (1.f + mod[b * 6144 + 1024 + col]) + mod[b * 6144 + col];
        errmax(ctl, 3, bf2f(((const us*)(ws + WS_H))[(size_t)row * D_ + col]), ref, 0.05f);
    } else if (ph == 2) {
        const us* H = (const us*)(ws + WS_H); const us* W = (const us*)(ws + WS_WIN); const int row = h1 % T_, col = h2 % D_; const us* hr = H + (size_t)row * D_;
        const int which = gs % 3;
        if (which == 0) { const int t = h3 % 3, oc = t * 1024 + col; float r = dotbf(hr, W + (size_t)oc * 1024, 1024) + a.in[I_BIN][oc]; if (t == 0) r *= attn_body::C2;
            errmax(ctl, 4, bf2f(((const us*)(ws + WS_Q + (size_t)t * WS_SLOT))[(size_t)row * D_ + col]), r, t == 0 ? 0.01f : 0.05f); }
        else if (which == 1) { const float av = dotbf(hr, W + (size_t)in_dest_row(3072 + col) * 1024, 1024) + a.in[I_BIN][3072 + col], bv = dotbf(hr, W + (size_t)in_dest_row(4096 + col) * 1024, 1024) + a.in[I_BIN][4096 + col];
            errmax(ctl, 5, bf2f(((const us*)(ws + WS_U))[(size_t)row * D_ + col]), av * sig(bv), 0.03f); }
        else { const float av = dotbf(hr, W + (size_t)in_dest_row(5120 + col) * 1024, 1024) + a.in[I_BIN][5120 + col], bv = dotbf(hr, W + (size_t)in_dest_row(6144 + col) * 1024, 1024) + a.in[I_BIN][6144 + col];
            errmax(ctl, 6, bf2f(((const us*)(ws + WS_SGA))[(size_t)row * D_ + col]), sig(av), 0.02f); errmax(ctl, 20, bf2f(((const us*)(ws + WS_SGB))[(size_t)row * D_ + col]), sig(bv), 0.02f); }
    } else if (ph == 3) {
        { const int which = 5 + (gs & 1); float got = 0.f, ref = 0.f;
          if (which == 5) { const int e = h1 % NEX_, r = h2 % 512, k = h3 % 1024, pn = r >> 8, w = r & 255, is3 = w >> 7, n = pn * 128 + (w & 127);
            const float* src = e < NE_ ? (is3 ? a.in[I_W3] : a.in[I_W1]) + (size_t)e * 262144 : (is3 ? a.in[I_WS3] : a.in[I_WS1]);
            got = bf2f(((const us*)(ws + WS_WUP))[((size_t)e * 512 + r) * 1024 + k]); ref = rbf(src[(size_t)k * 256 + n]); }
          else { const int e = h1 % NEX_, n = h2 % 1024, k = h3 % 256; const float* src = e < NE_ ? a.in[I_W2] + (size_t)e * 262144 : a.in[I_WS2];
            got = bf2f(((const us*)(ws + WS_WDN))[((size_t)e * 1024 + n) * 256 + k]); ref = rbf(src[(size_t)k * 1024 + n]); }
          errmax(ctl, 2, got, ref, 1e-3f); }
        {
            const unsigned hb = hashu(blockIdx.x * 977 + 5); const int b = hb & 7, hm = (hb >> 3) & 15, vh = (hb >> 7) & 1; int row = (hb >> 8) & 4095; if (blockIdx.x < 8) row = blockIdx.x * 37;
            const us* Q = (const us*)(ws + WS_Q); const us* K = (const us*)(ws + WS_K); const us* V = (const us*)(ws + WS_V); const us* O = (const us*)(ws + WS_OATT);
            const us* qr = Q + ((size_t)b * SEQ_ + row) * D_ + hm * 64; float mx = -INFINITY;
            for (int j = threadIdx.x; j <= row; j += 256) { const float s = dotbf(qr, K + ((size_t)b * SEQ_ + j) * D_ + hm * 64, 64); big[j] = s; mx = fmaxf(mx, s); }
            mx = blk_max(mx, sh); float l = 0.f;
            for (int j = threadIdx.x; j <= row; j += 256) { const float p = exp2f(big[j] - mx); big[j] = p; l += p; }
            l = blk_sum(l, sh);
            if (threadIdx.x < 64) { float o = 0.f; for (int j = 0; j <= row; ++j) o += big[j] * bf2f(V[((size_t)b * SEQ_ + j) * D_ + (hm >> 1) * 128 + vh * 64 + threadIdx.x]);
                errmax(ctl, 7, bf2f(O[((size_t)b * SEQ_ + row) * 2048 + (hm * 2 + vh) * 64 + threadIdx.x]), o / l, 0.03f); }
            __syncthreads();
        }
        {
            const unsigned hb = hashu(blockIdx.x * 31 + 77); int t = hb % T_; if (blockIdx.x < 16) t = (blockIdx.x >> 1) * SEQ_ + (blockIdx.x & 1) * 17 + 3;
            const int pos = t & (SEQ_ - 1); const us* U = (const us*)(ws + WS_U); float y[4]; float s = 0.f, q = 0.f;
            _Pragma("unroll") for (int i = 0; i < 4; ++i) { const int c = threadIdx.x + 256 * i; float acc = a.in[I_CB][c];
                for (int j = 0; j < 31; ++j) { const int p = pos - 30 + j; if (p >= 0) acc += a.in[I_CW][j * 1024 + c] * bf2f(U[(size_t)(t - 30 + j) * D_ + c]); }
                y[i] = acc; s += acc; }
            const float mean = blk_sum(s, sh) / 1024.f; _Pragma("unroll") for (int i = 0; i < 4; ++i) q += (y[i] - mean) * (y[i] - mean);
            const float var = blk_sum(q, sh) / 1024.f, rstd = 1.0f / sqrtf(var + LN_EPS_);
            _Pragma("unroll") for (int i = 0; i < 4; ++i) { const int c = threadIdx.x + 256 * i; const float z = (y[i] - mean) * rstd * a.in[I_CLG][c] + a.in[I_CLB][c];
                errmax(ctl, 8, bf2f(((const us*)(ws + WS_CACT))[(size_t)t * D_ + c]), z * sig(z), 0.03f); }
        }
    } else if (ph == 4) {
        float s1 = 0.f, s2 = 0.f; for (int i = 0; i < 64; ++i) { s1 += a.in[I_LQ1][i] * a.in[I_LK1][i]; s2 += a.in[I_LQ2][i] * a.in[I_LK2][i]; }
        const float lam = expf(s1) - expf(s2) + LAM_INIT_; const int t = hashu(blockIdx.x * 131 + 9) % T_; const us* O = (const us*)(ws + WS_OATT) + (size_t)t * 2048;
        for (int hh = 0; hh < 8; ++hh) { float o = 0.f; if (threadIdx.x < 128) o = bf2f(O[hh * 256 + threadIdx.x]) - lam * bf2f(O[hh * 256 + 128 + threadIdx.x]);
            const float ss = blk_sum(o * o, sh); const float r = 1.0f / sqrtf(ss / 128.f + RMS_EPS_);
            if (threadIdx.x < 128) errmax(ctl, 9, bf2f(((const us*)(ws + WS_ON))[(size_t)t * D_ + hh * 128 + threadIdx.x]), o * r * a.in[I_SUBG][threadIdx.x] * (1.f - LAM_INIT_), 0.03f); }
    } else if (ph == 5) {
        const int row = h1 % T_, col = h2 % D_; const size_t off = (size_t)row * D_ + col;
        const float yar = bf2f(((const us*)(ws + WS_SGA))[off]) * dotbf((const us*)(ws + WS_ON) + (size_t)row * D_, (const us*)(ws + WS_WA) + (size_t)col * D_, 1024);
        const float yab = bf2f(((const us*)(ws + WS_YA))[off]);
        errmax(ctl, 10, yab, yar, 0.03f);
        const float mr = yab + bf2f(((const us*)(ws + WS_SGB))[off]) * (dotbf((const us*)(ws + WS_CACT) + (size_t)row * D_, (const us*)(ws + WS_WP) + (size_t)col * D_, 1024) + a.in[I_PWB][col]);
        errmax(ctl, 11, bf2f(((const us*)(ws + WS_M))[off]), mr, 0.03f);
    } else if (ph == 6) {
        const int row = h1 % T_, col = h2 % D_, b = row >> 12; const size_t off = (size_t)row * D_ + col;
        const float r = DN_ALPHA_ * a.in[I_X][off] + mod[b * 6144 + 2048 + col] * dotbf((const us*)(ws + WS_M) + (size_t)row * D_, (const us*)(ws + WS_WO) + (size_t)col * D_, 1024);
        errmax(ctl, 12, ((const float*)(ws + WS_Z))[off], r, 0.05f);
    } else if (ph == 7) {
        const int t = hashu(blockIdx.x * 131 + 11) % T_, b = t >> 12; const float* X1 = (const float*)(ws + WS_Z) + (size_t)t * D_; float v[4]; float s = 0.f, q = 0.f;
        _Pragma("unroll") for (int i = 0; i < 4; ++i) { const int c = threadIdx.x + 256 * i; v[i] = (X1[c] - a.in[I_LN1B][c]) / a.in[I_LN1G][c]; s += v[i]; }
        const float mean = blk_sum(s, sh) / 1024.f; _Pragma("unroll") for (int i = 0; i < 4; ++i) q += (v[i] - mean) * (v[i] - mean); const float var = blk_sum(q, sh) / 1024.f;
        if (threadIdx.x == 0) { errmax(ctl, 13, mean, 0.f, 0.05f); errmax(ctl, 13, var, 1.f, 0.f); }
        _Pragma("unroll") for (int i = 0; i < 4; ++i) { const int c = threadIdx.x + 256 * i; errmax(ctl, 13, bf2f(((const us*)(ws + WS_H2))[(size_t)t * D_ + c]), X1[c] * (1.f + mod[b * 6144 + 4096 + c]) + mod[b * 6144 + 3072 + c], 0.05f); }
    } else if (ph == 8) {
        const int row = h1 % T_, e = h2 % NE_;
        errmax(ctl, 14, ((const float*)(ws + WS_LG))[(size_t)row * NE_ + e], dotbf((const us*)(ws + WS_H2) + (size_t)row * D_, (const us*)(ws + WS_WR) + (size_t)e * D_, 1024), 0.05f);
    } else if (ph == 9) {
        {
            const int t = hashu(blockIdx.x * 173 + 3) % T_; float* sc = big; float* ch = big + 256; float* gsc = big + 512; int* gsel = (int*)(big + 520); int* eidx = (int*)(big + 530); float* egate = big + 540;
            const float sv = sig(((const float*)(ws + WS_LG))[(size_t)t * NE_ + threadIdx.x]); sc[threadIdx.x] = sv; ch[threadIdx.x] = sv + a.in[I_RB][threadIdx.x]; __syncthreads();
            if (threadIdx.x < 8) { float m1 = -INFINITY, m2 = -INFINITY; for (int i = 0; i < 32; ++i) { const float v = ch[threadIdx.x * 32 + i]; if (v > m1) { m2 = m1; m1 = v; } else if (v > m2) m2 = v; } gsc[threadIdx.x] = m1 + m2; }
            __syncthreads();
            if (threadIdx.x == 0) { for (int g = 0; g < 8; ++g) { int rank = 0; for (int gp = 0; gp < 8; ++gp) rank += (gsc[gp] > gsc[g] || (gsc[gp] == gsc[g] && gp < g)) ? 1 : 0; gsel[g] = rank < 4; }
                float ssum = 0.f;
                for (int k = 0; k < 8; ++k) { int best = -1; float bv = -INFINITY; for (int e = 0; e < 256; ++e) { if (!gsel[e >> 5]) continue; bool taken = false; for (int kk = 0; kk < k; ++kk) taken |= (eidx[kk] == e); if (taken) continue; if (ch[e] > bv) { bv = ch[e]; best = e; } }
                    eidx[k] = best; egate[k] = sc[best]; ssum += sc[best]; }
                for (int k = 0; k < 8; ++k) { const int gi = ((const int*)(ws + WS_TOPI))[t * 8 + k]; errmax(ctl, 15, gi != eidx[k] ? 1.f : 0.f, 0.f, 1.f);
                    errmax(ctl, 15, ((const float*)(ws + WS_TOPG))[t * 8 + k], egate[k] / ssum * ROUTED_SCALE_, 1e-3f); } }
            __syncthreads();
        }
        {
            const int* list = (const int*)(ws + WS_LIST); const int* topi = (const int*)(ws + WS_TOPI);
            if (blockIdx.x == 0) { const int c = (int)ctl[CW_CNT + 64 * threadIdx.x]; const float tot = blk_sum((float)c, sh); if (threadIdx.x == 0) errmax(ctl, 16, tot, (float)(T_ * 8), 0.f); }
            const int e = h1 % NE_, c = (int)ctl[CW_CNT + 64 * e]; if (c > 0) { const int pos = h2 % c, av = list[(size_t)e * T_ + pos]; float bad = 0.f; if (av < 0 || av >= T_ * 8) bad = 1.f; else if (topi[av] != e) bad = 1.f; errmax(ctl, 16, bad, 0.f, 1.f); }
        }
    } else if (ph == 10 || ph == 11) {
        const int e = (gs & 7) == 0 ? NE_ : (int)(h1 % NE_); const int c = e < NE_ ? (int)ctl[CW_CNT + 64 * e] : T_;
        if (c > 0) { int ts = 0; for (int i = 0; i < e; ++i) ts += ((int)ctl[CW_CNT + 64 * i] + 255) >> 8;
            const int pos = h2 % c; const int av = e < NE_ ? ((const int*)(ws + WS_LIST))[(size_t)e * T_ + pos] : pos * 8; const int t = av >> 3; const size_t row = (size_t)(ts + (pos >> 8)) * 256 + (pos & 255);
            if (ph == 10) { const int n = h3 % FE_; const us* hr = (const us*)(ws + WS_H2) + (size_t)t * D_; const us* W = (const us*)(ws + WS_WUP) + ((size_t)e * 512 + (n >> 7) * 256 + (n & 127)) * 1024;
                const float A = dotbf(hr, W, 1024), B = dotbf(hr, W + 128 * 1024, 1024); errmax(ctl, 17, bf2f(((const us*)(ws + WS_HID))[row * FE_ + n]), A * sig(A) * B, 0.03f); }
            else if (e < NE_) { const int col = h3 % D_; const float r = ((const float*)(ws + WS_TOPG))[av] * dotbf((const us*)(ws + WS_HID) + row * FE_, (const us*)(ws + WS_WDN) + ((size_t)e * 1024 + col) * 256, 256);
                { const unsigned char yb = ((const unsigned char*)(ws + WS_YS))[(size_t)av * D_ + col]; const float got = __builtin_amdgcn_cvt_pk_f32_fp8((int)yb, false)[0] / pg8::YS_SCALE; errmax(ctl, 18, got, r, 0.02f); } }
        }
    } else if (ph == 12) {
        const int t = hashu(blockIdx.x * 211 + 13) % T_, b = t >> 12; float v[4]; float s = 0.f, q = 0.f;
        _Pragma("unroll") for (int i = 0; i < 4; ++i) { const int c = threadIdx.x + 256 * i; float y = 0.f; for (int k = 0; k < 8; ++k) y += __builtin_amdgcn_cvt_pk_f32_fp8((int)((const unsigned char*)(ws + WS_YS))[((size_t)t * 8 + k) * D_ + c], false)[0] / pg8::YS_SCALE;
            v[i] = ((const float*)(ws + WS_Z))[(size_t)t * D_ + c] + mod[b * 6144 + 5120 + c] * y; s += v[i]; }
        const float mean = blk_sum(s, sh) / 1024.f; _Pragma("unroll") for (int i = 0; i < 4; ++i) q += (v[i] - mean) * (v[i] - mean); const float rstd = 1.0f / sqrtf(blk_sum(q, sh) / 1024.f + LN_EPS_);
        _Pragma("unroll") for (int i = 0; i < 4; ++i) { const int c = threadIdx.x + 256 * i; errmax(ctl, 19, a.out[(size_t)t * D_ + c], (v[i] - mean) * rstd * a.in[I_LN2G][c] + a.in[I_LN2B][c], 0.05f); }
    }
}

__global__ void __launch_bounds__(256) chk_scan(Args a) {
    unsigned* ctl = (unsigned*)(a.ws + WS_CTL); const unsigned short* A = (const unsigned short*)(a.ws + WS_SGA); const unsigned short* B = (const unsigned short*)(a.ws + WS_SGB);
    for (size_t i = (size_t)blockIdx.x * 256 + threadIdx.x; i < (size_t)T_ * D_; i += (size_t)gridDim.x * 256) {
        const float va = chk::bf2f(A[i]), vb = chk::bf2f(B[i]); const int row = (int)(i >> 10), col = (int)(i & 1023);
        if (!(va >= 0.f && va <= 1.f)) { atomicAdd(ctl + CW_ERR + 40, 1u); atomicOr(ctl + CW_ERR + 41, 1u << (col >> 7)); atomicOr(ctl + CW_ERR + 42, 1u << ((row >> 8) & 31)); atomicMin(ctl + CW_ERR + 43, (unsigned)row ^ 0xffffffffu); atomicMax(ctl + CW_ERR + 44, (unsigned)row); atomicOr(ctl + CW_ERR + 46, 1u << (row & 31)); atomicOr(ctl + CW_ERR + 47, 1u << ((col >> 2) & 31)); }
        if (!(vb >= 0.f && vb <= 1.f)) atomicAdd(ctl + CW_ERR + 45, 1u);
        { const unsigned short* S = (const unsigned short*)(a.ws + WS_CACT); const float vs = chk::bf2f(S[i]); if (!(vs >= 0.f && vs <= 1.f)) atomicAdd(ctl + CW_ERR + 48, 1u); if (S[i] != A[i]) atomicAdd(ctl + CW_ERR + 49, 1u); }
    }
}
#ifndef CHK_TOL
#define CHK_TOL 0.06f
#endif
#ifndef CHK_FIRST
#define CHK_FIRST 1
#endif
__global__ void __launch_bounds__(256) chk_final(Args a) {
    const unsigned* ctl = (const unsigned*)(a.ws + WS_CTL); int bad = 0;
    for (int id = 20; id >= CHK_FIRST; --id) if (__uint_as_float(ctl[CW_ERR + id]) > CHK_TOL) bad = id;
#ifdef CHK_WORD
    { const unsigned w = ctl[CW_ERR + CHK_WORD];
#if CHK_ENC == 0
      bad = 1 + (int)(4.f * log2f((float)w + 1.f) + 0.5f);
#else
      bad = 1 + (int)((w >> CHK_SHIFT) & 63u);
#endif
    }
#endif
#ifdef CHK_MAG
    { const float e = __uint_as_float(ctl[CW_ERR + CHK_MAG]); float code = 40.f + 4.f * log2f(fmaxf(e, 1e-9f)); code = fminf(fmaxf(code, 0.f), 96.f); bad = (int)(code + 0.5f); if (bad < 1) bad = 1; }
#endif
    float vv = sqrtf((float)bad);
#ifdef CHK_TWO
    { const unsigned w1 = ctl[CW_ERR + 40], w2 = ctl[CW_ERR + 48], w3 = ctl[CW_ERR + 49]; int v1 = (int)(3.f * log2f((float)w1 + 1.f) + 0.5f); if (v1 > 63) v1 = 63; int v2 = (w2 != 0u ? 1 : 0) + (w3 != 0u ? 2 : 0);
      float sc = (float)(10 + v1) * 10.f; for (int i = 0; i < v2; ++i) sc *= 10.f; vv = sqrtf(sc); bad = 1; }
#endif
    if (bad) { const float v = vv; for (size_t i = (size_t)blockIdx.x * 256 + threadIdx.x; i < (size_t)T_ * D_; i += (size_t)gridDim.x * 256) a.out[i] = v; }
}
#endif

extern "C" void kernel_launch(void* const* d_in, const int* in_sizes, int n_in, void* d_out, int out_size, void* d_ws, size_t ws_size, hipStream_t stream) {
    static int grid = 0;
    if (grid == 0) {
        if (n_in != N_IN || in_sizes[0] != T_ * D_ || out_size != T_ * D_ || ws_size < WS_END) { fprintf(stderr, "kernel_launch: unexpected shapes (n_in %d, in0 %d, out %d, ws %zu); nothing launched\n", n_in, n_in > 0 ? in_sizes[0] : -1, out_size, ws_size); grid = -1; return; }
        int dev = 0, cus = 0, per_cu = 0;
        if (hipGetDevice(&dev) != hipSuccess || hipDeviceGetAttribute(&cus, hipDeviceAttributeMultiprocessorCount, dev) != hipSuccess) { grid = -1; return; }
        if (hipFuncSetAttribute((const void*)mk_fwd, hipFuncAttributeMaxDynamicSharedMemorySize, LDS_BYTES) != hipSuccess) { fprintf(stderr, "kernel_launch: hipFuncSetAttribute failed\n"); grid = -1; return; }
        if (hipOccupancyMaxActiveBlocksPerMultiprocessor(&per_cu, (const void*)mk_fwd, NWAVES * 64, LDS_BYTES) != hipSuccess || per_cu < 1) { fprintf(stderr, "kernel_launch: occupancy query reports %d\n", per_cu); }
        (void)hipGetLastError();
        grid = cus;
    }
    if (grid < 0) return;
    if (hipMemsetAsync((char*)d_ws + WS_CTL, 0, CTL_ZERO_BYTES, stream) != hipSuccess) return;
    Args a{};
    for (int i = 0; i < N_IN; ++i) a.in[i] = (const float*)d_in[i];
    a.out = (float*)d_out; a.ws = (unsigned char*)d_ws;
#if MK_SPLIT
    for (int p = 0; p < NPH; ++p) { a.ph_lo = p; a.ph_hi = p + 1;
#ifdef DBG_PREFILL
        if (p == 2) (void)hipMemsetAsync((char*)d_ws + WS_SGA, 0x3f, 2 * WS_SLOT, stream);
#endif
        hipLaunchKernelGGL(mk_fwd, dim3(grid), dim3(NWAVES * 64), LDS_BYTES, stream, a);
#if DBG_CHECK
        hipLaunchKernelGGL(chk_phase, dim3(64), dim3(256), 0, stream, a, p);
        if (p == 2) hipLaunchKernelGGL(chk_scan, dim3(1024), dim3(256), 0, stream, a);
#endif
    }
#if DBG_CHECK
    hipLaunchKernelGGL(chk_final, dim3(1024), dim3(256), 0, stream, a);
#ifdef DBG_POSTFILL
    (void)hipMemsetAsync((char*)d_ws + WS_SGA, 0x3f, 2 * WS_SLOT, stream);
#endif
#endif
#else
    a.ph_lo = 0; a.ph_hi = NPH;
    hipLaunchKernelGGL(mk_fwd, dim3(grid), dim3(NWAVES * 64), LDS_BYTES, stream, a);
#endif
}
```

```cpp
#include <hip/hip_runtime.h>
#include <hip/hip_bf16.h>
#include <cstdio>
#include <cstdint>
#include <cmath>

#ifndef MK_SPLIT
#define MK_SPLIT 0
#endif
#ifndef DBG_CHECK
#define DBG_CHECK 0
#endif

constexpr int T_ = 32768, D_ = 1024, NB_ = 8, SEQ_ = 4096;
constexpr int NIN_ = 7168;
constexpr int NE_ = 256, NEX_ = 257, TOPK_ = 8;
constexpr int FE_ = 256;
constexpr float LN_EPS_ = 1e-5f, RMS_EPS_ = 1e-5f;
constexpr float DN_ALPHA_ = 1.189207115002721f;
constexpr float LAM_INIT_ = 0.2f;
constexpr float ROUTED_SCALE_ = 2.5f;
constexpr float LOG2E_ = 1.4426950408889634f;

__device__ __forceinline__ int mk_lane_now() { int l; asm volatile("v_mbcnt_lo_u32_b32 %0, -1, 0\n\tv_mbcnt_hi_u32_b32 %0, -1, %0" : "=v"(l)); return l; }
namespace pg8 {
#define PG8_LAS __attribute__((address_space(3)))
typedef unsigned short bf16_t;
typedef short bf16x8 __attribute__((ext_vector_type(8)));
typedef float f32x4 __attribute__((ext_vector_type(4)));
typedef unsigned u32x4 __attribute__((ext_vector_type(4)));
constexpr int BM = 256, BK = 64, HALF = 128, HTB = HALF * BK * 2  , STAGE_BYTES = 8 * HTB, NXCD = 8, WGM = 8;

__host__ __device__ __forceinline__ int lds_byte(int r, int c) { const int st = (r >> 4) * 2 + (c >> 5), rr = r & 15, cc = c & 31, ob = rr * 64 + cc * 2; return st * 1024 + (ob ^ (((ob >> 9) & 1) << 5)); }
__host__ __device__ __forceinline__ void stage_rc(int b, int& R, int& C) { const int st = b / 1024, sb = b % 1024, swz = sb ^ (((sb >> 9) & 1) << 5); R = (st >> 1) * 16 + swz / 64; C = (st & 1) * 32 + (swz % 64) / 2; }
__host__ __device__ __forceinline__ int perm32(int rho) { const int n = rho >> 4, i = rho & 15; return 8 * (i >> 2) + 4 * n + (i & 3); }

struct UnitS { int pm, pn; };
struct UnitM { int pm, pn, e, rt, nrows, slot; };
struct Gemm { const bf16_t* A; const bf16_t* Bt; };

struct StaticOrder {
    typedef UnitS Unit;
    int nM, nN, nwg, G, c;
    __host__ __device__ void init(int M, int N, int G_, int c_) { nM = M / BM; nN = N / BM; nwg = nM * nN; G = G_; c = c_; }
    __host__ __device__ bool next(int i, Unit& u) const {
        const long L = (long)i * G + c; if (L >= nwg) return false;
        int wgid = (int)L; { const int q = nwg / NXCD, r = nwg % NXCD, xcd = wgid % NXCD, off = wgid / NXCD; wgid = (xcd < r ? xcd * (q + 1) : r * (q + 1) + (xcd - r) * q) + off; }
        const int nig = WGM * nN, gid = wgid / nig, fm = gid * WGM, gsz = (nM - fm) < WGM ? (nM - fm) : WGM;
        u.pm = fm + ((wgid % nig) % gsz); u.pn = (wgid % nig) / gsz; return true;
    }
    __device__ __forceinline__ size_t a_off(const Unit& u, size_t tstep) const { return (size_t)u.pm * tstep; }
    __device__ __forceinline__ size_t b_off(const Unit& u, size_t tstep) const { return (size_t)u.pn * tstep; }
    __device__ __forceinline__ unsigned row_off(const Unit&, int, int) const { return 0u; }
    __device__ __forceinline__ void a_ready(const Unit&) const {}
    __device__ __forceinline__ void done(const Unit&) const {}
};
template <int BTILES, bool A_DENSE, unsigned ROWBYTES>
struct MoeOrder {
    typedef UnitM Unit;
    const PG8_LAS int* UT; const PG8_LAS int* TOK; int nunits;
    __device__ __forceinline__ bool next(int i, Unit& u) const {
        if (i >= nunits) return false;
        u.e = __builtin_amdgcn_readfirstlane(UT[i * 8 + 0]); u.rt = __builtin_amdgcn_readfirstlane(UT[i * 8 + 1]); u.pn = __builtin_amdgcn_readfirstlane(UT[i * 8 + 2]);
        u.nrows = __builtin_amdgcn_readfirstlane(UT[i * 8 + 3]); u.pm = __builtin_amdgcn_readfirstlane(UT[i * 8 + 4]); u.slot = i; return true;
    }
    __device__ __forceinline__ size_t a_off(const Unit& u, size_t tstep) const { return A_DENSE ? (size_t)u.pm * tstep : (size_t)0; }
    __device__ __forceinline__ size_t b_off(const Unit& u, size_t tstep) const { return (size_t)(u.e * BTILES + u.pn) * tstep; }
    __device__ __forceinline__ unsigned row_off(const Unit& u, int row, int C) const { return (unsigned)TOK[u.slot * 256 + row] * ROWBYTES + (unsigned)C * 2u; }
    __device__ __forceinline__ void a_ready(const Unit&) const {}
    __device__ __forceinline__ void done(const Unit&) const {}
};

typedef float f32x2_t_ __attribute__((ext_vector_type(2))); typedef __bf16 bf16x2_t_ __attribute__((ext_vector_type(2)));
__device__ __forceinline__ unsigned cvt_pk_bf16(float lo, float hi) { const f32x2_t_ v = {lo, hi}; const bf16x2_t_ b = __builtin_convertvector(v, bf16x2_t_); return __builtin_bit_cast(unsigned, b); }
__device__ __forceinline__ float bf_lo(unsigned w) { return __uint_as_float(w << 16); }
__device__ __forceinline__ float bf_hi(unsigned w) { return __uint_as_float(w & 0xffff0000u); }
__device__ __forceinline__ float sigm(float x) { return __builtin_amdgcn_rcpf(1.0f + __builtin_amdgcn_exp2f(-x * LOG2E_)); }
__device__ __forceinline__ u32x4 pack8(const f32x4& a, const f32x4& b) { u32x4 w; w.x = cvt_pk_bf16(a[0], a[1]); w.y = cvt_pk_bf16(a[2], a[3]); w.z = cvt_pk_bf16(b[0], b[1]); w.w = cvt_pk_bf16(b[2], b[3]); return w; }
__device__ __forceinline__ void unpack8(const u32x4& w, f32x4& a, f32x4& b) { a = (f32x4){bf_lo(w.x), bf_hi(w.x), bf_lo(w.y), bf_hi(w.y)}; b = (f32x4){bf_lo(w.z), bf_hi(w.z), bf_lo(w.w), bf_hi(w.w)}; }
__device__ __forceinline__ f32x4 sigm4(const f32x4& v) { return (f32x4){sigm(v[0]), sigm(v[1]), sigm(v[2]), sigm(v[3])}; }

#define PG8_EPI_ARGS const f32x4 (&acc)[2][2][4][2], const U& u, int wr, int wc, int fr, int fq
struct EpiInproj {
    static constexpr bool PERM = true, AFTER_DRAIN = false;
    bf16_t *q; size_t slot; bf16_t *ug, *sga, *sgb; const float* biasP; float qscale;
    template <class U> __device__ __forceinline__ void operator()(PG8_EPI_ARGS) const {
        const int pn = u.pn, row0 = u.pm * BM + wr * 64 + fr, cb = wc * 32 + 8 * fq;
        f32x4 bv[2][2];
#pragma unroll
        for (int bj = 0; bj < 2; ++bj)
#pragma unroll
            for (int n = 0; n < 2; ++n) bv[bj][n] = *(const f32x4*)(biasP + pn * BM + bj * HALF + cb + 4 * n);
        if (pn < 12) {
            bf16_t* base = q + (size_t)(pn >> 2) * slot; float sc = 1.0f; if (pn < 4) sc = qscale; const int colt = (pn & 3) * BM + cb;
#pragma unroll
            for (int ai = 0; ai < 2; ++ai)
#pragma unroll
                for (int m = 0; m < 4; ++m) { bf16_t* rowp = base + (size_t)(row0 + ai * HALF + m * 16) * D_ + colt;
#pragma unroll
                    for (int bj = 0; bj < 2; ++bj) { const f32x4 v0 = (acc[ai][bj][m][0] + bv[bj][0]) * sc, v1 = (acc[ai][bj][m][1] + bv[bj][1]) * sc; *(u32x4*)(rowp + bj * HALF) = pack8(v0, v1); } }
        } else if (pn < 20) {
            const int colt = (pn - 12) * HALF + cb;
#pragma unroll
            for (int ai = 0; ai < 2; ++ai)
#pragma unroll
                for (int m = 0; m < 4; ++m) { const size_t off = (size_t)(row0 + ai * HALF + m * 16) * D_ + colt;
                    const f32x4 a0 = acc[ai][0][m][0] + bv[0][0], a1 = acc[ai][0][m][1] + bv[0][1], b0 = sigm4(acc[ai][1][m][0] + bv[1][0]), b1 = sigm4(acc[ai][1][m][1] + bv[1][1]);
                    *(u32x4*)(ug + off) = pack8(a0 * b0, a1 * b1); }
        } else {
            const int colt = (pn - 20) * HALF + cb;
#pragma unroll
            for (int ai = 0; ai < 2; ++ai)
#pragma unroll
                for (int m = 0; m < 4; ++m) { const size_t off = (size_t)(row0 + ai * HALF + m * 16) * D_ + colt;
                    *(u32x4*)(sga + off) = pack8(sigm4(acc[ai][0][m][0] + bv[0][0]), sigm4(acc[ai][0][m][1] + bv[0][1]));
                    *(u32x4*)(sgb + off) = pack8(sigm4(acc[ai][1][m][0] + bv[1][0]), sigm4(acc[ai][1][m][1] + bv[1][1]));
                    }
        }
    }
};
struct EpiYa {
    static constexpr bool PERM = true, AFTER_DRAIN = false;
    const bf16_t* sga; bf16_t* ya;
    template <class U> __device__ __forceinline__ void operator()(PG8_EPI_ARGS) const {
        const int row0 = u.pm * BM + wr * 64 + fr, col0 = u.pn * BM + wc * 32 + 8 * fq;
#pragma unroll
        for (int ai = 0; ai < 2; ++ai)
#pragma unroll
            for (int m = 0; m < 4; ++m)
#pragma unroll
                for (int bj = 0; bj < 2; ++bj) { const size_t off = (size_t)(row0 + ai * HALF + m * 16) * D_ + col0 + bj * HALF;
                    f32x4 g0, g1; unpack8(*(const u32x4*)(sga + off), g0, g1);
                    *(u32x4*)(ya + off) = pack8(acc[ai][bj][m][0] * g0, acc[ai][bj][m][1] * g1); }
    }
};
struct EpiM {
    static constexpr bool PERM = true, AFTER_DRAIN = false;
    const bf16_t* sgb; const bf16_t* ya; bf16_t* mo; const float* bp;
    template <class U> __device__ __forceinline__ void operator()(PG8_EPI_ARGS) const {
        const int row0 = u.pm * BM + wr * 64 + fr, col0 = u.pn * BM + wc * 32 + 8 * fq;
#pragma unroll
        for (int bj = 0; bj < 2; ++bj) { const f32x4 b0 = *(const f32x4*)(bp + col0 + bj * HALF), b1 = *(const f32x4*)(bp + col0 + bj * HALF + 4);
#pragma unroll
            for (int ai = 0; ai < 2; ++ai)
#pragma unroll
                for (int m = 0; m < 4; ++m) { const size_t off = (size_t)(row0 + ai * HALF + m * 16) * D_ + col0 + bj * HALF;
                    f32x4 g0, g1, y0, y1; unpack8(*(const u32x4*)(sgb + off), g0, g1); unpack8(*(const u32x4*)(ya + off), y0, y1);
                    *(u32x4*)(mo + off) = pack8(y0 + g0 * (acc[ai][bj][m][0] + b0), y1 + g1 * (acc[ai][bj][m][1] + b1)); } }
    }
};
struct EpiZ {
    static constexpr bool PERM = true, AFTER_DRAIN = false;
    const float* x; const float* mod; float* z;
    template <class U> __device__ __forceinline__ void operator()(PG8_EPI_ARGS) const {
        const int row0 = u.pm * BM + wr * 64 + fr, col0 = u.pn * BM + wc * 32 + 8 * fq; const int b = (u.pm * BM) >> 12;
#pragma unroll
        for (int bj = 0; bj < 2; ++bj) { const float* gp = mod + b * 6144 + 2048 + col0 + bj * HALF; const f32x4 g0 = *(const f32x4*)gp, g1 = *(const f32x4*)(gp + 4);
#pragma unroll
            for (int ai = 0; ai < 2; ++ai)
#pragma unroll
                for (int m = 0; m < 4; ++m) { const size_t off = (size_t)(row0 + ai * HALF + m * 16) * D_ + col0 + bj * HALF;
                    const f32x4 x0 = *(const f32x4*)(x + off), x1 = *(const f32x4*)(x + off + 4);
                    *(f32x4*)(z + off) = x0 * DN_ALPHA_ + g0 * acc[ai][bj][m][0]; *(f32x4*)(z + off + 4) = x1 * DN_ALPHA_ + g1 * acc[ai][bj][m][1]; } }
    }
};
struct EpiLogit {
    static constexpr bool PERM = true, AFTER_DRAIN = false;
    float* lg;
    template <class U> __device__ __forceinline__ void operator()(PG8_EPI_ARGS) const {
        const int row0 = u.pm * BM + wr * 64 + fr, col0 = wc * 32 + 8 * fq;
#pragma unroll
        for (int ai = 0; ai < 2; ++ai)
#pragma unroll
            for (int m = 0; m < 4; ++m)
#pragma unroll
                for (int bj = 0; bj < 2; ++bj) { float* p = lg + (size_t)(row0 + ai * HALF + m * 16) * NE_ + col0 + bj * HALF; *(f32x4*)p = acc[ai][bj][m][0]; *(f32x4*)(p + 4) = acc[ai][bj][m][1]; }
    }
};
struct EpiSwiglu {
    static constexpr bool PERM = true, AFTER_DRAIN = false;
    bf16_t* hid;
    template <class U> __device__ __forceinline__ void operator()(PG8_EPI_ARGS) const {
        const int row0 = u.pm * BM + wr * 64 + fr, col0 = u.pn * HALF + wc * 32 + 8 * fq;
#pragma unroll
        for (int ai = 0; ai < 2; ++ai)
#pragma unroll
            for (int m = 0; m < 4; ++m) { const size_t off = (size_t)(row0 + ai * HALF + m * 16) * FE_ + col0;
                const f32x4 a0 = acc[ai][0][m][0], a1 = acc[ai][0][m][1];
                *(u32x4*)(hid + off) = pack8(a0 * sigm4(a0) * acc[ai][1][m][0], a1 * sigm4(a1) * acc[ai][1][m][1]); }
    }
};
constexpr float YS_SCALE = 16.0f;
__device__ __forceinline__ unsigned pack4_fp8(const f32x4& v) { int w = __builtin_amdgcn_cvt_pk_fp8_f32(v[0], v[1], 0, false); w = __builtin_amdgcn_cvt_pk_fp8_f32(v[2], v[3], w, true); return (unsigned)w; }
struct EpiDown {
    static constexpr bool PERM = true, AFTER_DRAIN = false;
    const int* list; const float* gate; unsigned char* yslot; float* xb; const float* mod;
    template <class U> __device__ __forceinline__ void operator()(PG8_EPI_ARGS) const {
        typedef unsigned u32x2 __attribute__((ext_vector_type(2)));
        const int rl0 = wr * 64 + fr, col0 = u.pn * BM + wc * 32 + 8 * fq;
        if (u.e < NE_) {
            const int* lp = list + (size_t)u.e * T_ + u.rt * BM;
#pragma unroll
            for (int ai = 0; ai < 2; ++ai)
#pragma unroll
                for (int m = 0; m < 4; ++m) { const int rl = rl0 + ai * HALF + m * 16;
                    if (rl < u.nrows) { const int a = lp[rl]; const float g = gate[a] * YS_SCALE; unsigned char* rowp = yslot + (size_t)a * D_ + col0;
#pragma unroll
                        for (int bj = 0; bj < 2; ++bj) { u32x2 w; w.x = pack4_fp8(acc[ai][bj][m][0] * g); w.y = pack4_fp8(acc[ai][bj][m][1] * g); *(u32x2*)(rowp + bj * HALF) = w; } } }
        } else {
            const int t0 = u.rt * BM, b = t0 >> 12;
#pragma unroll
            for (int bj = 0; bj < 2; ++bj) { const float* gp = mod + b * 6144 + 5120 + col0 + bj * HALF; const f32x4 g0 = *(const f32x4*)gp, g1 = *(const f32x4*)(gp + 4);
#pragma unroll
                for (int ai = 0; ai < 2; ++ai)
#pragma unroll
                    for (int m = 0; m < 4; ++m) { float* p = xb + (size_t)(t0 + rl0 + ai * HALF + m * 16) * D_ + col0 + bj * HALF;
                        const f32x4 x0 = *(const f32x4*)p, x1 = *(const f32x4*)(p + 4);
                        *(f32x4*)p = x0 * DN_ALPHA_ + g0 * acc[ai][bj][m][0]; *(f32x4*)(p + 4) = x1 * DN_ALPHA_ + g1 * acc[ai][bj][m][1]; } }
        }
    }
};

template <int K, class Epi, class Sched, bool ALIGN_EPI = false, bool SP2 = false, bool GATHER = false>
__device__ __forceinline__ void gemm_phase(PG8_LAS unsigned char* lds, const Gemm g, const Sched& S, const Epi& E, const int wid) {
    const int lane = mk_lane_now(), tid = wid * 64 + lane, wr = wid >> 2, wc = wid & 3, fr = lane & 15, fq = lane >> 4;
    typedef typename Sched::Unit Unit;
    constexpr int nt = K / BK;
    unsigned voffA[2], voffB[2]; int RA[2], CA[2];
#pragma unroll
    for (int i = 0; i < 2; ++i) { int R, C; stage_rc(tid * 16 + i * 8192, R, C); const int Rb = Epi::PERM ? ((R & ~31) + perm32(R & 31)) : R;
        voffA[i] = (unsigned)(R * K + C) * 2u; voffB[i] = (unsigned)(Rb * K + C) * 2u; RA[i] = R; CA[i] = C; }
    constexpr size_t kstep = (size_t)(BK * 2);
    constexpr size_t hstep = (size_t)HALF * K * 2;
    constexpr size_t tstep = 2 * hstep;
    const unsigned ldsw = (unsigned)wid * 1024u;
    const int aoff = lds_byte(wr * 64 + fr, fq * 8), boff = lds_byte(wc * 32 + fr, fq * 8);
#define PG8_SA(b, h) (((b) * 2 + (h)) * HTB)
#define PG8_SB(b, h) ((4 + (b) * 2 + (h)) * HTB)
#define PG8_STAGE(bufoff, gbase, voff) do { _Pragma("unroll") for (int _i = 0; _i < 2; ++_i) \
        __builtin_amdgcn_global_load_lds((const unsigned*)((const char*)(gbase) + (voff)[_i]), (PG8_LAS unsigned*)(lds + (bufoff) + ldsw + _i * 8192), 16, 0, 0); } while (0)
#define PG8_STAGE_A(bufoff, base, h, nx) do { if constexpr (GATHER) { const unsigned _v[2] = {(nx) ? gn[h][0] : gc[h][0], (nx) ? gn[h][1] : gc[h][1]}; PG8_STAGE(bufoff, base, _v); } \
        else { PG8_STAGE(bufoff, (base) + (h) * hstep, voffA); } } while (0)
#define PG8_LDA(dst, b, h) do { _Pragma("unroll") for (int m = 0; m < 4; ++m) _Pragma("unroll") for (int k = 0; k < 2; ++k) dst[m][k] = *(const PG8_LAS bf16x8*)(lds + PG8_SA(b, h) + aoff + m * 2048 + k * 1024); } while (0)
#define PG8_LDB(dst, b, h) do { _Pragma("unroll") for (int n = 0; n < 2; ++n) _Pragma("unroll") for (int k = 0; k < 2; ++k) dst[n][k] = *(const PG8_LAS bf16x8*)(lds + PG8_SB(b, h) + boff + n * 2048 + k * 1024); } while (0)
#define PG8_MMA(ai, bj, At, Bt) do { __builtin_amdgcn_s_setprio(1); _Pragma("unroll") for (int m = 0; m < 4; ++m) _Pragma("unroll") for (int n = 0; n < 2; ++n) _Pragma("unroll") for (int k = 0; k < 2; ++k) \
        acc[ai][bj][m][n] = __builtin_amdgcn_mfma_f32_16x16x32_bf16(Bt[n][k], At[m][k], acc[ai][bj][m][n], 0, 0, 0); __builtin_amdgcn_s_setprio(0); } while (0)
#define PG8_WAIT_V(n) asm volatile("s_waitcnt vmcnt(" #n ")" ::: "memory")
#define PG8_WAIT_L(n) asm volatile("s_waitcnt lgkmcnt(" #n ")" ::: "memory")
#define PG8_BAR __builtin_amdgcn_s_barrier()
#define PG8_SCHED __builtin_amdgcn_sched_barrier(0)
    Unit cur, nxt; int ui = 0;
    if (!S.next(0, cur)) return;
    f32x4 acc[2][2][4][2];
#pragma unroll
    for (int a = 0; a < 2; ++a)
#pragma unroll
        for (int b = 0; b < 2; ++b)
#pragma unroll
            for (int m = 0; m < 4; ++m)
#pragma unroll
                for (int n = 0; n < 2; ++n) acc[a][b][m][n] = (f32x4){0.f, 0.f, 0.f, 0.f};
    bf16x8 At[4][2], B0[2][2], B1[2][2];
    unsigned gc[2][2] = {{0u, 0u}, {0u, 0u}}, gn[2][2] = {{0u, 0u}, {0u, 0u}};
    if constexpr (GATHER) {
#pragma unroll
        for (int h = 0; h < 2; ++h)
#pragma unroll
            for (int i = 0; i < 2; ++i) gc[h][i] = S.row_off(cur, h * HALF + RA[i], CA[i]);
    }
    const char* cA = (const char*)g.A + S.a_off(cur, tstep); const char* cB = (const char*)g.Bt + S.b_off(cur, tstep);
    S.a_ready(cur);
    if constexpr (SP2) {
        PG8_STAGE(PG8_SB(0, 0), cB, voffB); PG8_STAGE(PG8_SB(0, 1), cB + hstep, voffB); PG8_STAGE_A(PG8_SA(0, 0), cA, 0, false); PG8_STAGE_A(PG8_SA(0, 1), cA, 1, false);
        if (wr == 1) PG8_BAR;
        PG8_WAIT_V(2); PG8_BAR;
        PG8_STAGE(PG8_SB(1, 0), cB + kstep, voffB); PG8_STAGE_A(PG8_SA(1, 0), cA + kstep, 0, false); PG8_STAGE(PG8_SB(1, 1), cB + hstep + kstep, voffB);
        PG8_WAIT_V(6); PG8_BAR;
    } else {
        PG8_STAGE(PG8_SB(0, 0), cB, voffB); PG8_STAGE_A(PG8_SA(0, 0), cA, 0, false); PG8_STAGE(PG8_SB(0, 1), cB + hstep, voffB); PG8_STAGE_A(PG8_SA(0, 1), cA, 1, false);
        if (wr == 1) PG8_BAR;
        PG8_WAIT_V(4); PG8_BAR;
        PG8_STAGE(PG8_SB(1, 0), cB + kstep, voffB); PG8_STAGE_A(PG8_SA(1, 0), cA + kstep, 0, false); PG8_STAGE(PG8_SB(1, 1), cB + hstep + kstep, voffB);
        PG8_WAIT_V(6); PG8_BAR;
    }
    for (;;) {
        const bool has_next = S.next(ui + 1, nxt);
        const char* nA = has_next ? (const char*)g.A + S.a_off(nxt, tstep) : cA; const char* nB = has_next ? (const char*)g.Bt + S.b_off(nxt, tstep) : cB;
        if constexpr (GATHER) {
#pragma unroll
            for (int h = 0; h < 2; ++h)
#pragma unroll
                for (int i = 0; i < 2; ++i) gn[h][i] = has_next ? S.row_off(nxt, h * HALF + RA[i], CA[i]) : gc[h][i];
        }
        for (int t = 0; t < nt; t += 2) {
            const bool last = (t == nt - 2);
            const char* a1 = cA + (size_t)(t + 1) * kstep;
            const char* a2 = last ? nA : cA + (size_t)(t + 2) * kstep; const char* b2 = last ? nB : cB + (size_t)(t + 2) * kstep;
            const char* a3 = a2 + kstep; const char* b3 = b2 + kstep;
            if (last && has_next) S.a_ready(nxt);
            if constexpr (SP2) {
            PG8_LDB(B0, 0, 0); PG8_LDB(B1, 0, 1); PG8_SCHED; PG8_LDA(At, 0, 0); PG8_STAGE_A(PG8_SA(1, 1), a1, 1, false);
            PG8_WAIT_V(8); PG8_WAIT_L(0); PG8_BAR; PG8_MMA(0, 0, At, B0); PG8_MMA(0, 1, At, B1); PG8_BAR; PG8_SCHED;
            PG8_LDA(At, 0, 1); PG8_STAGE(PG8_SB(0, 0), b2, voffB); PG8_STAGE(PG8_SB(0, 1), b2 + hstep, voffB); PG8_STAGE_A(PG8_SA(0, 0), a2, 0, last);
            PG8_WAIT_V(8); PG8_WAIT_L(0); PG8_BAR; PG8_MMA(1, 0, At, B0); PG8_MMA(1, 1, At, B1); PG8_BAR; PG8_SCHED;
            PG8_LDB(B0, 1, 0); PG8_LDB(B1, 1, 1); PG8_SCHED; PG8_LDA(At, 1, 0); PG8_STAGE_A(PG8_SA(0, 1), a2, 1, last);
            PG8_WAIT_V(8); PG8_WAIT_L(0); PG8_BAR; PG8_MMA(0, 0, At, B0); PG8_MMA(0, 1, At, B1); PG8_BAR; PG8_SCHED;
            PG8_LDA(At, 1, 1); PG8_STAGE(PG8_SB(1, 0), b3, voffB); PG8_STAGE(PG8_SB(1, 1), b3 + hstep, voffB); PG8_STAGE_A(PG8_SA(1, 0), a3, 0, last);
            PG8_WAIT_V(8); PG8_WAIT_L(0); PG8_BAR; PG8_MMA(1, 0, At, B0); PG8_MMA(1, 1, At, B1); PG8_BAR; PG8_SCHED;
            } else {
            PG8_LDB(B0, 0, 0); PG8_SCHED; PG8_LDA(At, 0, 0); PG8_STAGE_A(PG8_SA(1, 1), a1, 1, false);
            PG8_WAIT_L(8); PG8_BAR; PG8_WAIT_L(0); PG8_MMA(0, 0, At, B0); PG8_BAR; PG8_SCHED;
            PG8_LDB(B1, 0, 1); PG8_STAGE(PG8_SB(0, 0), b2, voffB);
            PG8_BAR; PG8_WAIT_L(0); PG8_MMA(0, 1, At, B1); PG8_BAR;
            PG8_LDA(At, 0, 1); PG8_STAGE_A(PG8_SA(0, 0), a2, 0, last);
            PG8_BAR; PG8_WAIT_L(0); PG8_MMA(1, 0, At, B0); PG8_BAR; PG8_SCHED;
            PG8_STAGE(PG8_SB(0, 1), b2 + hstep, voffB);
            PG8_WAIT_V(6); PG8_BAR; PG8_MMA(1, 1, At, B1); PG8_BAR;
            PG8_LDB(B0, 1, 0); PG8_SCHED; PG8_LDA(At, 1, 0); PG8_STAGE_A(PG8_SA(0, 1), a2, 1, last);
            PG8_WAIT_L(8); PG8_BAR; PG8_WAIT_L(0); PG8_MMA(0, 0, At, B0); PG8_BAR; PG8_SCHED;
            PG8_LDB(B1, 1, 1); PG8_STAGE(PG8_SB(1, 0), b3, voffB);
            PG8_BAR; PG8_WAIT_L(0); PG8_MMA(0, 1, At, B1); PG8_BAR;
            PG8_LDA(At, 1, 1); PG8_STAGE_A(PG8_SA(1, 0), a3, 0, last);
            PG8_BAR; PG8_WAIT_L(0); PG8_MMA(1, 0, At, B0); PG8_BAR; PG8_SCHED;
            PG8_STAGE(PG8_SB(1, 1), b3 + hstep, voffB);
            PG8_WAIT_V(6); PG8_BAR; PG8_MMA(1, 1, At, B1); PG8_BAR;
            }
        }
        if constexpr (ALIGN_EPI) { if (wr == 0) PG8_BAR; }
        if constexpr (!Epi::AFTER_DRAIN) { E(acc, cur, wr, wc, fr, fq); S.done(cur); }
        if (!has_next) break;
#pragma unroll
        for (int a = 0; a < 2; ++a)
#pragma unroll
            for (int b = 0; b < 2; ++b)
#pragma unroll
                for (int m = 0; m < 4; ++m)
#pragma unroll
                    for (int n = 0; n < 2; ++n) acc[a][b][m][n] = (f32x4){0.f, 0.f, 0.f, 0.f};
        cur = nxt; cA = nA; cB = nB; ++ui;
        if constexpr (GATHER) {
#pragma unroll
            for (int h = 0; h < 2; ++h)
#pragma unroll
                for (int i = 0; i < 2; ++i) gc[h][i] = gn[h][i];
        }
        if constexpr (ALIGN_EPI) { if (wr == 1) PG8_BAR; }
    }
    PG8_WAIT_V(0);
    if constexpr (!ALIGN_EPI) { if (wr == 0) PG8_BAR; }
    PG8_BAR;
#undef PG8_SA
#undef PG8_SB
#undef PG8_STAGE
#undef PG8_STAGE_A
#undef PG8_LDA
#undef PG8_LDB
#undef PG8_MMA
#undef PG8_WAIT_V
#undef PG8_WAIT_L
#undef PG8_BAR
#undef PG8_SCHED
}
}
#define PG8_SP2 true
#define PG8_ALIGN true
#include <hip/hip_bf16.h>
#include <cmath>
namespace attn_body {
using bf16=__hip_bfloat16;
using bf16x8=__attribute__((ext_vector_type(8)))short;
using s16x4=__attribute__((ext_vector_type(4)))short;
using f32x16=__attribute__((ext_vector_type(16)))float;
using u32x4=__attribute__((ext_vector_type(4)))unsigned;
constexpr int BATCH=8,NHEAD=16,SEQ=4096,D=64,DM=1024,OP=2048;
constexpr int NW=8,QBLK=32,QB=QBLK*NW,KVBLK=64,NQB=SEQ/QB;
constexpr int ATTN_PITCH=DM, ATTN_UNIT_ROWS=QB;
__device__ __forceinline__ int crow(int r,int hi){return (r&3)+8*(r>>2)+4*hi;}
#define SBAR() __builtin_amdgcn_sched_barrier(0)
__device__ __forceinline__ void cmask(f32x16&p0,f32x16&p1,int jb,int qrel,int hi){
  const float NEG=-INFINITY; int kb=64*jb+4*hi;
  #pragma unroll
  for(int r=0;r<16;++r){int kv=kb+(r&3)+8*(r>>2); if(kv>qrel)p0[r]=NEG; if(kv+32>qrel)p1[r]=NEG;}
}

constexpr int NSLOT=3, SLOTB=8192;
constexpr int LDS_K=0, LDS_V=NSLOT*SLOTB, LDS_WS=2*NSLOT*SLOTB, LDS_OST=LDS_WS+NW*64*4, LDS_BYTES=LDS_OST+NW*4096;
constexpr float C2=0.125f*1.4426950408889634f;
__device__ __forceinline__ void glds16(const void*gsrc,unsigned lds_dst){unsigned keep;
  asm volatile("s_mov_b32 %0, m0\n\ts_mov_b32 m0, %2\n\ts_nop 0\n\tglobal_load_lds_dwordx4 %1, off\n\ts_mov_b32 m0, %0":"=&s"(keep):"v"(gsrc),"s"(lds_dst):"memory");}
__device__ __forceinline__ float max3f(float a,float b,float c){float r;asm("v_max3_f32 %0, %1, %2, %3":"=v"(r):"v"(a),"v"(b),"v"(c));return r;}
__device__ __forceinline__ float max2f(float a,float b){float r;asm("v_max_f32_e32 %0, %1, %2":"=v"(r):"v"(a),"v"(b));return r;}
__device__ __forceinline__ float fadd_s(float a,float b){float r;asm("v_add_f32_e32 %0, %1, %2":"=v"(r):"v"(a),"v"(b));return r;}
__device__ __forceinline__ float fsub_s(float a,float b){float r;asm("v_sub_f32_e32 %0, %1, %2":"=v"(r):"v"(a),"v"(b));return r;}
typedef float f32x2_t __attribute__((ext_vector_type(2))); typedef __bf16 bf16x2_t __attribute__((ext_vector_type(2)));
__device__ __forceinline__ unsigned cvtpk_s(float lo,float hi){f32x2_t v={lo,hi};bf16x2_t b=__builtin_convertvector(v,bf16x2_t);return __builtin_bit_cast(unsigned,b);}
#define WAIT_BAR(N) asm volatile("s_waitcnt vmcnt(" #N ") lgkmcnt(0)\n\ts_barrier":::"memory")

__device__ __forceinline__ void qkt(f32x16&p0,f32x16&p1,const char*Kslot,const bf16x8*qr,const f32x16&negm,int r32,int hi){
  const char*kb=Kslot+hi*1024+r32*16;
  #pragma unroll
  for(int d0=0;d0<4;++d0){
    const bf16x8 b0=*reinterpret_cast<const bf16x8*>(kb+d0*2048);
    const bf16x8 b1=*reinterpret_cast<const bf16x8*>(kb+d0*2048+512);
    if(d0==0){p0=__builtin_amdgcn_mfma_f32_32x32x16_bf16(b0,qr[0],negm,0,0,0);p1=__builtin_amdgcn_mfma_f32_32x32x16_bf16(b1,qr[0],negm,0,0,0);}
    else{p0=__builtin_amdgcn_mfma_f32_32x32x16_bf16(b0,qr[d0],p0,0,0,0);p1=__builtin_amdgcn_mfma_f32_32x32x16_bf16(b1,qr[d0],p1,0,0,0);}}
}
typedef __attribute__((address_space(3))) const char* lds_cptr;
typedef short v4i16_t __attribute__((ext_vector_type(4)));
__device__ __forceinline__ void kload8(bf16x8*kf,lds_cptr kp){
  kf[0]=*(const __attribute__((address_space(3))) bf16x8*)(kp);      kf[1]=*(const __attribute__((address_space(3))) bf16x8*)(kp+512);
  kf[2]=*(const __attribute__((address_space(3))) bf16x8*)(kp+2048); kf[3]=*(const __attribute__((address_space(3))) bf16x8*)(kp+2560);
  kf[4]=*(const __attribute__((address_space(3))) bf16x8*)(kp+4096); kf[5]=*(const __attribute__((address_space(3))) bf16x8*)(kp+4608);
  kf[6]=*(const __attribute__((address_space(3))) bf16x8*)(kp+6144); kf[7]=*(const __attribute__((address_space(3))) bf16x8*)(kp+6656);
}
__device__ __forceinline__ void kload2(bf16x8*kf,lds_cptr kp,int j){ kf[2*j]=*(const __attribute__((address_space(3))) bf16x8*)(kp+j*2048); kf[2*j+1]=*(const __attribute__((address_space(3))) bf16x8*)(kp+j*2048+512); }
__device__ __forceinline__ s16x4 vtr(lds_cptr p){ return __builtin_bit_cast(s16x4,__builtin_amdgcn_ds_read_tr16_b64_v4i16((__attribute__((address_space(3))) v4i16_t*)p)); }
__device__ __forceinline__ float rowmax(const f32x16&p0,const f32x16&p1){
  float a=max3f(p0[0],p0[1],p1[0]),b=max3f(p0[2],p0[3],p1[1]);a=max3f(a,p1[2],p1[3]);
  #pragma unroll
  for(int r=4;r<16;r+=4){a=max3f(a,p0[r],p0[r+1]);b=max3f(b,p0[r+2],p0[r+3]);a=max3f(a,p1[r],p1[r+1]);b=max3f(b,p1[r+2],p1[r+3]);}
  const float m=max2f(a,b);
  auto rr=__builtin_amdgcn_permlane32_swap(__float_as_uint(m),__float_as_uint(m),false,false);
  return max2f(__uint_as_float(rr[0]),__uint_as_float(rr[1]));
}
__device__ __forceinline__ void pv(f32x16*o,int vb,bf16x8 pa0,bf16x8 pa1,bf16x8 pa2,bf16x8 pa3){
  #pragma unroll
  for(int d0=0;d0<2;++d0){s16x4 lo[4],hi[4];
    #pragma unroll
    for(int ks=0;ks<4;++ks){
      asm volatile("ds_read_b64_tr_b16 %0,%1 offset:%c2":"=&v"(lo[ks]):"v"(vb),"i"(d0*4096+ks*1024):"memory");
      asm volatile("ds_read_b64_tr_b16 %0,%1 offset:%c2":"=&v"(hi[ks]):"v"(vb),"i"(d0*4096+ks*1024+512):"memory");}
    asm volatile("s_waitcnt lgkmcnt(0)":::"memory");SBAR();
    #define PK(k) (bf16x8){lo[k][0],lo[k][1],lo[k][2],lo[k][3],hi[k][0],hi[k][1],hi[k][2],hi[k][3]}
    o[d0]=__builtin_amdgcn_mfma_f32_32x32x16_bf16(pa0,PK(0),o[d0],0,0,0);
    o[d0]=__builtin_amdgcn_mfma_f32_32x32x16_bf16(pa1,PK(1),o[d0],0,0,0);
    o[d0]=__builtin_amdgcn_mfma_f32_32x32x16_bf16(pa2,PK(2),o[d0],0,0,0);
    o[d0]=__builtin_amdgcn_mfma_f32_32x32x16_bf16(pa3,PK(3),o[d0],0,0,0);
    #undef PK
  }
}

#ifndef ATTN_STORE16
#define ATTN_STORE16(p,v) (*(u32x4*)(p)=(v))
#endif
template<int THRL> __device__ __forceinline__ void attn_unit(const int wid,int b,int cq,int cv,int co,int qb,const bf16*Q,const bf16*__restrict__ K,const bf16*__restrict__ V,bf16*O,char*shm){
  const int lane=mk_lane_now(),r32=lane&31,hi=lane>>5;
  const long rowbase=(long)b*SEQ; const int q0=qb*QB;
  const bf16*Qw=Q+(rowbase+q0+wid*QBLK)*DM+cq;
  const bf16*Kh=K+rowbase*DM+cq,*Vh=V+rowbase*DM+cv;
  const unsigned lds0=(unsigned)(uintptr_t)shm;
  float*wsf=(float*)(shm+LDS_WS)+wid*64;
  const bf16*ksrc=Kh+(long)lane*DM+wid*8;
  const bf16*vsrc=Vh+(long)(16*(wid&3)+(lane>>2))*DM+(wid>>2)*32+(lane&3)*8;
  const unsigned kdst=lds0+LDS_K+wid*1024, vdst=lds0+LDS_V+wid*1024;
  #define DMA_K(t,slot) glds16(ksrc+(long)(t)*KVBLK*DM,(unsigned)__builtin_amdgcn_readfirstlane(kdst+(slot)))
  #define DMA_V(t,slot) glds16(vsrc+(long)(t)*KVBLK*DM,(unsigned)__builtin_amdgcn_readfirstlane(vdst+(slot)))
  const int vb0=(int)(lds0+LDS_V)+((lane>>4)&1)*32+(lane&3)*8+(4*hi+((lane&15)>>2))*64;
  const char*Kbase=shm+LDS_K; bf16x8 kf[8];
  const lds_cptr shm3=(lds_cptr)shm; const lds_cptr kp0=shm3+LDS_K+hi*1024+r32*16; const lds_cptr vp0=shm3+LDS_V+((lane>>4)&1)*32+(lane&3)*8+(4*hi+((lane&15)>>2))*64;
  const int NT=(q0+QB)/KVBLK;
  DMA_K(0,0);DMA_V(0,0);DMA_K(1,SLOTB);
  bf16x8 qr[4];
  #pragma unroll
  for(int d0=0;d0<4;++d0)qr[d0]=*reinterpret_cast<const bf16x8*>(&Qw[(long)r32*DM+d0*16+hi*8]);
  float zf_=0.f;asm volatile("":"+v"(zf_));f32x16 zv_;
  #pragma unroll
  for(int r=0;r<16;++r)zv_[r]=zf_;
  float mhat=0.f,l_reg=0.f;f32x16 o[2];o[0]=zv_;o[1]=zv_;f32x16 negm=zv_;asm volatile("":"+v"(negm));
  const int qrel=wid*QBLK+r32;
  #define CMASK(P0,P1,t) do{int jb_=(t)-(NT-4); if(jb_>=0)cmask(P0,P1,jb_,qrel,hi);}while(0)
  bool resc=false;
  #define START(P0,P1) do{ const float rm=rowmax(P0,P1); resc=false; \
    { const float dl=rm; mhat=fadd_s(mhat,dl); \
      _Pragma("unroll") for(int r=0;r<16;++r){P0[r]=fsub_s(P0[r],dl);P1[r]=fsub_s(P1[r],dl);} \
      _Pragma("unroll") for(int r=0;r<16;++r)negm[r]=-mhat; asm volatile("":"+v"(negm)); } \
    _Pragma("unroll") for(int r=0;r<16;++r)P0[r]=__builtin_amdgcn_exp2f(P0[r]); }while(0)
  #define RESC() do{ if(resc){ asm volatile("s_waitcnt lgkmcnt(0)":::"memory"); \
      _Pragma("unroll") for(int d_=0;d_<2;++d_) _Pragma("unroll") for(int r=0;r<16;++r)o[d_][r]*=wsf[crow(r,hi)]; } }while(0)
  f32x16 pA0,pA1,pB0,pB1;
  int sl_prev=0,sl_cur=0,sl_next=SLOTB;
  #define ROT() do{sl_prev=sl_cur;sl_cur=sl_next;sl_next=(sl_next==(NSLOT-1)*SLOTB)?0:sl_next+SLOTB;}while(0)
  DMA_K(2,2*SLOTB);
  WAIT_BAR(3);
  qkt(pA0,pA1,Kbase,qr,negm,r32,hi);asm volatile("s_nop 15\n\ts_nop 7":"+v"(pA0),"+v"(pA1));CMASK(pA0,pA1,0);
  START(pA0,pA1);
  _Pragma("unroll") for(int r=0;r<16;++r)pA1[r]=__builtin_amdgcn_exp2f(pA1[r]);
  WAIT_BAR(0);
  DMA_K(3,0);DMA_V(1,SLOTB);
  ROT();
  kload8(kf,kp0+sl_cur);
  WAIT_BAR(2);
  s16x4 vlo[8],vhi[8]; u32x4 pw0,pw1,pw2,pw3;
  #define PKW(P,B) cvtpk_s(P[B],P[B+1])
  #define PAF(k) __builtin_bit_cast(bf16x8,pw##k)
  #define VFR(i) (bf16x8){vlo[i][0],vlo[i][1],vlo[i][2],vlo[i][3],vhi[i][0],vhi[i][1],vhi[i][2],vhi[i][3]}
  #define PIN(x) asm volatile("":"+v"(x))
  #define MX3(a,b,c) __builtin_fmaxf(__builtin_fmaxf((a),(b)),(c))
  #define GAPA(MF,A0,A1,A2,A3,W0,W1,PW) do{ MF; sacc+=A0; sacc+=A1; sacc+=A2; sacc+=A3; PIN(sacc); W0; W1; PIN(PW); SBAR(); }while(0)
  #define EX(v) __builtin_amdgcn_exp2f(v)
  #define GAPB(MF,X,B) do{ MF; X[B]=EX(X[B]); X[B+1]=EX(X[B+1]); X[B+2]=EX(X[B+2]); X[B+3]=EX(X[B+3]); PIN(X); SBAR(); }while(0)
  #define VRD(i) do{ vlo[i]=vtr(vp_+(((i)>>2)*4096+((i)&3)*1024)); vhi[i]=vtr(vp_+(((i)>>2)*4096+((i)&3)*1024+512)); }while(0)
  #define KRD(G,j) do{ if(G){ kload2(kf,kp0+sl_next,j); SBAR(); } }while(0)
  #define STEP(C0,C1,P0,P1,t,GK,GV,GL) do{ SBAR(); \
    const lds_cptr vp_=vp0+sl_prev; \
    VRD(0); SBAR(); float sacc=(P0[0]+P0[1]); \
    GAPA(C0=__builtin_amdgcn_mfma_f32_32x32x16_bf16(kf[0],qr[0],negm,0,0,0), P0[2],P0[3],P0[4],P0[5],     pw0[0]=PKW(P0,0), pw0[1]=PKW(P0,2), pw0); \
    VRD(4); SBAR(); GAPA(C1=__builtin_amdgcn_mfma_f32_32x32x16_bf16(kf[1],qr[0],negm,0,0,0), P0[6],P0[7],P0[8],P0[9],     pw0[2]=PKW(P0,4), pw0[3]=PKW(P0,6), pw0); \
    VRD(1); SBAR(); GAPA(C0=__builtin_amdgcn_mfma_f32_32x32x16_bf16(kf[2],qr[1],C0,0,0,0),   P0[10],P0[11],P0[12],P0[13], pw1[0]=PKW(P0,8), pw1[1]=PKW(P0,10), pw1); \
    VRD(5); SBAR(); GAPA(C1=__builtin_amdgcn_mfma_f32_32x32x16_bf16(kf[3],qr[1],C1,0,0,0),   P0[14],P0[15],P1[0],P1[1],   pw1[2]=PKW(P0,12),pw1[3]=PKW(P0,14), pw1); \
    VRD(2); SBAR(); GAPA(C0=__builtin_amdgcn_mfma_f32_32x32x16_bf16(kf[4],qr[2],C0,0,0,0),   P1[2],P1[3],P1[4],P1[5],     pw2[0]=PKW(P1,0), pw2[1]=PKW(P1,2), pw2); \
    VRD(6); SBAR(); GAPA(C1=__builtin_amdgcn_mfma_f32_32x32x16_bf16(kf[5],qr[2],C1,0,0,0),   P1[6],P1[7],P1[8],P1[9],     pw2[2]=PKW(P1,4), pw2[3]=PKW(P1,6), pw2); \
    VRD(3); SBAR(); GAPA(C0=__builtin_amdgcn_mfma_f32_32x32x16_bf16(kf[6],qr[3],C0,0,0,0),   P1[10],P1[11],P1[12],P1[13], pw3[0]=PKW(P1,8), pw3[1]=PKW(P1,10), pw3); \
    VRD(7); SBAR(); GAPA(C1=__builtin_amdgcn_mfma_f32_32x32x16_bf16(kf[7],qr[3],C1,0,0,0),   P1[14],P1[15],0.f,0.f,       pw3[2]=PKW(P1,12),pw3[3]=PKW(P1,14), pw3); \
    l_reg+=sacc; \
    if(GK){DMA_K((t)+3,sl_cur);} if(GV){DMA_V((t)+1,sl_next);} \
    CMASK(C0,C1,t); \
    { float a=MX3(C0[0],C0[1],C1[0]),b=MX3(C0[2],C0[3],C1[1]); a=MX3(a,C1[2],C1[3]); \
      _Pragma("unroll") for(int r=4;r<16;r+=4){a=MX3(a,C0[r],C0[r+1]);b=MX3(b,C0[r+2],C0[r+3]);a=MX3(a,C1[r],C1[r+1]);b=MX3(b,C1[r+2],C1[r+3]);} \
      float rm=__builtin_fmaxf(a,b); { auto rr=__builtin_amdgcn_permlane32_swap(__float_as_uint(rm),__float_as_uint(rm),false,false); rm=__builtin_fmaxf(__uint_as_float(rr[0]),__uint_as_float(rr[1])); } \
      resc=false; \
      if(__builtin_expect(__any(rm>(float)THRL),0)){ const float dl=__builtin_fmaxf(rm,0.f); mhat+=dl; \
        _Pragma("unroll") for(int r=0;r<16;++r){C0[r]-=dl;C1[r]-=dl;} \
        _Pragma("unroll") for(int r=0;r<16;++r)negm[r]=-mhat; asm volatile("":"+v"(negm)); \
        const float f=__builtin_amdgcn_exp2f(-dl); l_reg*=f; if(hi==0)wsf[r32]=f; resc=true; } } \
    SBAR(); \
    GAPB(o[0]=__builtin_amdgcn_mfma_f32_32x32x16_bf16(PAF(0),VFR(0),o[0],0,0,0), C0,0); \
    GAPB(o[1]=__builtin_amdgcn_mfma_f32_32x32x16_bf16(PAF(0),VFR(4),o[1],0,0,0), C0,4); \
    KRD(GL,0); GAPB(o[0]=__builtin_amdgcn_mfma_f32_32x32x16_bf16(PAF(1),VFR(1),o[0],0,0,0), C0,8); \
    KRD(GL,1); GAPB(o[1]=__builtin_amdgcn_mfma_f32_32x32x16_bf16(PAF(1),VFR(5),o[1],0,0,0), C0,12); \
    KRD(GL,2); GAPB(o[0]=__builtin_amdgcn_mfma_f32_32x32x16_bf16(PAF(2),VFR(2),o[0],0,0,0), C1,0); \
    KRD(GL,3); GAPB(o[1]=__builtin_amdgcn_mfma_f32_32x32x16_bf16(PAF(2),VFR(6),o[1],0,0,0), C1,4); \
    GAPB(o[0]=__builtin_amdgcn_mfma_f32_32x32x16_bf16(PAF(3),VFR(3),o[0],0,0,0), C1,8); \
    GAPB(o[1]=__builtin_amdgcn_mfma_f32_32x32x16_bf16(PAF(3),VFR(7),o[1],0,0,0), C1,12); \
    }while(0)
  int t=1;
  #undef CMASK
  #define CMASK(P0,P1,t) do{}while(0)
  for(;t+5<NT;t+=2){
    STEP(pB0,pB1,pA0,pA1,t,true,true,true);     WAIT_BAR(2); RESC(); ROT();
    STEP(pA0,pA1,pB0,pB1,t+1,true,true,true);   WAIT_BAR(2); RESC(); ROT();
  }
  #undef CMASK
  #define CMASK(P0,P1,t) do{int jb_=(t)-(NT-4); if(jb_>=0)cmask(P0,P1,jb_,qrel,hi);}while(0)
  #define ENDW(tt) do{ if((tt)+3<NT){WAIT_BAR(2);} else if((tt)+2<NT){WAIT_BAR(1);} else {WAIT_BAR(0);} }while(0)
  for(;t+1<NT;t+=2){
    STEP(pB0,pB1,pA0,pA1,t,(t+3<NT),(t+1<NT),(t+1<NT));       ENDW(t);   RESC(); ROT();
    STEP(pA0,pA1,pB0,pB1,t+1,(t+4<NT),(t+2<NT),(t+2<NT));     ENDW(t+1); RESC(); ROT();
  }
  STEP(pB0,pB1,pA0,pA1,NT-1,false,false,false); RESC();
  { float sacc=pB0[0]+pB0[1]; _Pragma("unroll") for(int r=2;r<16;++r)sacc+=pB0[r]; _Pragma("unroll") for(int r=0;r<16;++r)sacc+=pB1[r]; l_reg+=sacc;
    pw0=(u32x4){PKW(pB0,0),PKW(pB0,2),PKW(pB0,4),PKW(pB0,6)};pw1=(u32x4){PKW(pB0,8),PKW(pB0,10),PKW(pB0,12),PKW(pB0,14)};pw2=(u32x4){PKW(pB1,0),PKW(pB1,2),PKW(pB1,4),PKW(pB1,6)};pw3=(u32x4){PKW(pB1,8),PKW(pB1,10),PKW(pB1,12),PKW(pB1,14)};
    SBAR(); pv(o,vb0+sl_cur,PAF(0),PAF(1),PAF(2),PAF(3)); }
  #undef PKW
  #undef PAF
  #undef VFR
  #undef PIN
  #undef MX3
  #undef GAPA
  #undef GAPB
  #undef EX
  #undef VRD
  #undef KRD
  #undef STEP
  #undef ENDW
  {auto rr=__builtin_amdgcn_permlane32_swap(__float_as_uint(l_reg),__float_as_uint(l_reg),false,false);l_reg=__uint_as_float(rr[0])+__uint_as_float(rr[1]);}
  if(hi==0)wsf[32+r32]=l_reg;asm volatile("s_waitcnt lgkmcnt(0)":::"memory");
  float rli[16];
  #pragma unroll
  for(int r=0;r<16;++r)rli[r]=__builtin_amdgcn_rcpf(wsf[32+crow(r,hi)]);
  bf16*Ow=O+(rowbase+q0+wid*QBLK)*OP+co;
  { bf16*stg=(bf16*)(shm+LDS_OST)+wid*2048;
    #pragma unroll
    for(int r=0;r<16;++r){const int orow=crow(r,hi);
      #pragma unroll
      for(int d0=0;d0<2;++d0)stg[orow*64+d0*32+r32]=__float2bfloat16(o[d0][r]*rli[r]);}
    asm volatile("s_waitcnt lgkmcnt(0)":::"memory");
    #pragma unroll
    for(int i=0;i<4;++i){const int row=i*8+(lane>>3),ch=lane&7; const u32x4 v=*(const u32x4*)(stg+row*64+ch*8); ATTN_STORE16(Ow+(long)row*OP+ch*8,v);} }
  asm volatile("s_waitcnt lgkmcnt(0)\n\ts_barrier":::"memory");
  #undef DMA_K
  #undef DMA_V
  #undef CMASK
  #undef START
  #undef RESC
  #undef ROT
}
struct AttnTensors { const bf16* Q; const bf16* K; const bf16* V; bf16* O; };
struct AttnUnit { int combo; int qb; };
constexpr int SLOTV=16384;
constexpr int L2_K=0, L2_V=NSLOT*SLOTB, L2_WS=L2_V+NSLOT*SLOTV, L2_Q=L2_WS+NW*64*4, L2_BYTES=L2_Q+NW*4096;
__device__ __forceinline__ void pv128(f32x16*o,int vb,bf16x8 pa0,bf16x8 pa1,bf16x8 pa2,bf16x8 pa3){
  #pragma unroll
  for(int d0=0;d0<4;++d0){s16x4 lo[4],hi[4];
    #pragma unroll
    for(int ks=0;ks<4;++ks){
      asm volatile("ds_read_b64_tr_b16 %0,%1 offset:%c2":"=&v"(lo[ks]):"v"(vb),"i"(d0*4096+ks*1024):"memory");
      asm volatile("ds_read_b64_tr_b16 %0,%1 offset:%c2":"=&v"(hi[ks]):"v"(vb),"i"(d0*4096+ks*1024+512):"memory");}
    asm volatile("s_waitcnt lgkmcnt(0)":::"memory");SBAR();
    #define PK(k) (bf16x8){lo[k][0],lo[k][1],lo[k][2],lo[k][3],hi[k][0],hi[k][1],hi[k][2],hi[k][3]}
    o[d0]=__builtin_amdgcn_mfma_f32_32x32x16_bf16(pa0,PK(0),o[d0],0,0,0);
    o[d0]=__builtin_amdgcn_mfma_f32_32x32x16_bf16(pa1,PK(1),o[d0],0,0,0);
    o[d0]=__builtin_amdgcn_mfma_f32_32x32x16_bf16(pa2,PK(2),o[d0],0,0,0);
    o[d0]=__builtin_amdgcn_mfma_f32_32x32x16_bf16(pa3,PK(3),o[d0],0,0,0);
    #undef PK
  }
}
template<int THRL> __device__ __forceinline__ void attn_unit128(const int wid,int b,int cq,int cv,int co,int qb,const bf16*Q,const bf16*__restrict__ K,const bf16*__restrict__ V,bf16*O,char*shm){
  const int lane=mk_lane_now(),r32=lane&31,hi=lane>>5;
  const long rowbase=(long)b*SEQ; const int q0=qb*QB;
  const bf16*Qw=Q+(rowbase+q0+wid*QBLK)*DM+cq;
  const bf16*Kh=K+rowbase*DM+cq,*Vh=V+rowbase*DM+cv;
  const unsigned lds0=(unsigned)(uintptr_t)shm;
  float*wsf=(float*)(shm+L2_WS)+wid*64;
  const bf16*ksrc=Kh+(long)lane*DM+wid*8;
  const bf16*vsrc=Vh+(long)(16*(wid&3)+(lane>>2))*DM+(wid>>2)*32+(lane&3)*8;
  const bf16*qsrc=Qw+(long)r32*DM+hi*8;
  const unsigned kdst=lds0+L2_K+wid*1024, vdst=lds0+L2_V+wid*1024, qdst=lds0+L2_Q+wid*4096;
  #define DMA_K2(t,slot) glds16(ksrc+(long)(t)*KVBLK*DM,(unsigned)__builtin_amdgcn_readfirstlane(kdst+(slot)))
  #define DMA_V2(t,slot) do{ glds16(vsrc+(long)(t)*KVBLK*DM,(unsigned)__builtin_amdgcn_readfirstlane(vdst+2*(slot))); glds16(vsrc+(long)(t)*KVBLK*DM+64,(unsigned)__builtin_amdgcn_readfirstlane(vdst+2*(slot)+8192)); }while(0)
  const int vb0=(int)(lds0+L2_V)+((lane>>4)&1)*32+(lane&3)*8+(4*hi+((lane&15)>>2))*64;
  const char*Kbase=shm+L2_K; bf16x8 kf[8];
  const lds_cptr shm3=(lds_cptr)shm; const lds_cptr kp0=shm3+L2_K+hi*1024+r32*16; const lds_cptr vp0=shm3+L2_V+((lane>>4)&1)*32+(lane&3)*8+(4*hi+((lane&15)>>2))*64;
  const lds_cptr qp0=shm3+L2_Q+wid*4096+lane*16;
  const int NT=(q0+QB)/KVBLK;
  #pragma unroll
  for(int d0=0;d0<4;++d0) glds16(qsrc+16*d0,(unsigned)__builtin_amdgcn_readfirstlane(qdst+d0*1024));
  DMA_K2(0,0);DMA_V2(0,0);DMA_K2(1,SLOTB);DMA_K2(2,2*SLOTB);
  float zf_=0.f;asm volatile("":"+v"(zf_));f32x16 zv_;
  #pragma unroll
  for(int r=0;r<16;++r)zv_[r]=zf_;
  float mhat=0.f,l_reg=0.f;f32x16 o[4];o[0]=zv_;o[1]=zv_;o[2]=zv_;o[3]=zv_;
  const int qrel=wid*QBLK+r32;
  #define CMASK2(P0,P1,t) do{int jb_=(t)-(NT-4); if(jb_>=0)cmask(P0,P1,jb_,qrel,hi);}while(0)
  bool resc=false;
  #define RESC2() do{ if(resc){ asm volatile("s_waitcnt lgkmcnt(0)":::"memory"); \
      _Pragma("unroll") for(int d_=0;d_<4;++d_) _Pragma("unroll") for(int r=0;r<16;++r)o[d_][r]*=wsf[crow(r,hi)]; } }while(0)
  f32x16 pA0,pA1,pB0,pB1;
  int sl_prev=0,sl_cur=0,sl_next=SLOTB;
  #define ROT2() do{sl_prev=sl_cur;sl_cur=sl_next;sl_next=(sl_next==(NSLOT-1)*SLOTB)?0:sl_next+SLOTB;}while(0)
  WAIT_BAR(4);
  { bf16x8 qr[4];
    #pragma unroll
    for(int d0=0;d0<4;++d0)qr[d0]=*(const __attribute__((address_space(3))) bf16x8*)(qp0+d0*1024);
    qkt(pA0,pA1,Kbase,qr,zv_,r32,hi); }
  asm volatile("s_nop 15\n\ts_nop 7":"+v"(pA0),"+v"(pA1));CMASK2(pA0,pA1,0);
  { const float rm=rowmax(pA0,pA1); mhat=rm;
    _Pragma("unroll") for(int r=0;r<16;++r){pA0[r]=__builtin_amdgcn_exp2f(pA0[r]-mhat);pA1[r]=__builtin_amdgcn_exp2f(pA1[r]-mhat);} }
  WAIT_BAR(0);
  DMA_K2(3,0);DMA_V2(1,SLOTB);
  ROT2();
  kload8(kf,kp0+sl_cur);
  WAIT_BAR(3);
  s16x4 vlo[8],vhi[8]; u32x4 pw0,pw1,pw2,pw3;
  #define PKW(P,B) cvtpk_s(P[B],P[B+1])
  #define PAF(k) __builtin_bit_cast(bf16x8,pw##k)
  #define VFR(i) (bf16x8){vlo[i][0],vlo[i][1],vlo[i][2],vlo[i][3],vhi[i][0],vhi[i][1],vhi[i][2],vhi[i][3]}
  #define PIN(x) asm volatile("":"+v"(x))
  #define MX3(a,b,c) __builtin_fmaxf(__builtin_fmaxf((a),(b)),(c))
  #define GAPA(MF,A0,A1,A2,A3,W0,W1,PW) do{ MF; sacc+=A0; sacc+=A1; sacc+=A2; sacc+=A3; PIN(sacc); W0; W1; PIN(PW); SBAR(); }while(0)
  #define EX(v) __builtin_amdgcn_exp2f(v)
  #define GAPB2(MF,X,B) do{ MF; X[B]=EX(X[B]-mhat); X[B+1]=EX(X[B+1]-mhat); PIN(X); SBAR(); }while(0)
  #define VRDS(s,f) do{ vlo[s]=vtr(vp_+(((f)>>2)*4096+((f)&3)*1024)); vhi[s]=vtr(vp_+(((f)>>2)*4096+((f)&3)*1024+512)); }while(0)
  #define KRD(G,j) do{ if(G){ kload2(kf,kp0+sl_next,j); SBAR(); } }while(0)
  #define MF32(a,b,c) __builtin_amdgcn_mfma_f32_32x32x16_bf16(a,b,c,0,0,0)
  #define QFR(d0) (*(const __attribute__((address_space(3))) bf16x8*)(qp_+(d0)*1024))
  #define STEP2(C0,C1,P0,P1,t,GK,GV,GL) do{ SBAR(); \
    const lds_cptr vp_=vp0+2*sl_prev; int qo_=0; asm volatile("":"+v"(qo_)); const lds_cptr qp_=qp0+qo_; \
    const bf16x8 q0_=QFR(0),q1_=QFR(1),q2_=QFR(2),q3_=QFR(3); const f32x16 z16_={}; \
    VRDS(0,0); SBAR(); float sacc=(P0[0]+P0[1]); \
    GAPA(C0=MF32(kf[0],q0_,z16_), P0[2],P0[3],P0[4],P0[5],     pw0[0]=PKW(P0,0), pw0[1]=PKW(P0,2), pw0); \
    VRDS(1,4); SBAR(); GAPA(C1=MF32(kf[1],q0_,z16_), P0[6],P0[7],P0[8],P0[9],     pw0[2]=PKW(P0,4), pw0[3]=PKW(P0,6), pw0); \
    VRDS(2,8); SBAR(); GAPA(C0=MF32(kf[2],q1_,C0),   P0[10],P0[11],P0[12],P0[13], pw1[0]=PKW(P0,8), pw1[1]=PKW(P0,10), pw1); \
    VRDS(3,12);SBAR(); GAPA(C1=MF32(kf[3],q1_,C1),   P0[14],P0[15],P1[0],P1[1],   pw1[2]=PKW(P0,12),pw1[3]=PKW(P0,14), pw1); \
    VRDS(4,1); SBAR(); GAPA(C0=MF32(kf[4],q2_,C0),   P1[2],P1[3],P1[4],P1[5],     pw2[0]=PKW(P1,0), pw2[1]=PKW(P1,2), pw2); \
    VRDS(5,5); SBAR(); GAPA(C1=MF32(kf[5],q2_,C1),   P1[6],P1[7],P1[8],P1[9],     pw2[2]=PKW(P1,4), pw2[3]=PKW(P1,6), pw2); \
    VRDS(6,9); SBAR(); GAPA(C0=MF32(kf[6],q3_,C0),   P1[10],P1[11],P1[12],P1[13], pw3[0]=PKW(P1,8), pw3[1]=PKW(P1,10), pw3); \
    VRDS(7,13);SBAR(); GAPA(C1=MF32(kf[7],q3_,C1),   P1[14],P1[15],0.f,0.f,       pw3[2]=PKW(P1,12),pw3[3]=PKW(P1,14), pw3); \
    l_reg+=sacc; \
    if(GK){DMA_K2((t)+3,sl_cur);} if(GV){DMA_V2((t)+1,sl_next);} \
    CMASK2(C0,C1,t); \
    { float a=MX3(C0[0],C0[1],C1[0]),b_=MX3(C0[2],C0[3],C1[1]); a=MX3(a,C1[2],C1[3]); \
      _Pragma("unroll") for(int r=4;r<16;r+=4){a=MX3(a,C0[r],C0[r+1]);b_=MX3(b_,C0[r+2],C0[r+3]);a=MX3(a,C1[r],C1[r+1]);b_=MX3(b_,C1[r+2],C1[r+3]);} \
      float rm=__builtin_fmaxf(a,b_); { auto rr=__builtin_amdgcn_permlane32_swap(__float_as_uint(rm),__float_as_uint(rm),false,false); rm=__builtin_fmaxf(__uint_as_float(rr[0]),__uint_as_float(rr[1])); } \
      rm-=mhat; resc=false; \
      if(__builtin_expect(__any(rm>(float)THRL),0)){ const float dl=__builtin_fmaxf(rm,0.f); mhat+=dl; \
        const float f=__builtin_amdgcn_exp2f(-dl); l_reg*=f; if(hi==0)wsf[r32]=f; resc=true; } } \
    SBAR(); \
    GAPB2(o[0]=MF32(PAF(0),VFR(0),o[0]), C0,0);  VRDS(0,2);  \
    GAPB2(o[1]=MF32(PAF(0),VFR(1),o[1]), C0,2);  VRDS(1,6);  \
    GAPB2(o[2]=MF32(PAF(0),VFR(2),o[2]), C0,4);  VRDS(2,10); \
    GAPB2(o[3]=MF32(PAF(0),VFR(3),o[3]), C0,6);  VRDS(3,14); \
    KRD(GL,0); GAPB2(o[0]=MF32(PAF(1),VFR(4),o[0]), C0,8);  VRDS(4,3);  \
    GAPB2(o[1]=MF32(PAF(1),VFR(5),o[1]), C0,10); VRDS(5,7);  \
    KRD(GL,1); GAPB2(o[2]=MF32(PAF(1),VFR(6),o[2]), C0,12); VRDS(6,11); \
    GAPB2(o[3]=MF32(PAF(1),VFR(7),o[3]), C0,14); VRDS(7,15); \
    KRD(GL,2); GAPB2(o[0]=MF32(PAF(2),VFR(0),o[0]), C1,0);  \
    GAPB2(o[1]=MF32(PAF(2),VFR(1),o[1]), C1,2);  \
    KRD(GL,3); GAPB2(o[2]=MF32(PAF(2),VFR(2),o[2]), C1,4);  \
    GAPB2(o[3]=MF32(PAF(2),VFR(3),o[3]), C1,6);  \
    GAPB2(o[0]=MF32(PAF(3),VFR(4),o[0]), C1,8);  \
    GAPB2(o[1]=MF32(PAF(3),VFR(5),o[1]), C1,10); \
    GAPB2(o[2]=MF32(PAF(3),VFR(6),o[2]), C1,12); \
    GAPB2(o[3]=MF32(PAF(3),VFR(7),o[3]), C1,14); \
    }while(0)
  int t=1;
  #undef CMASK2
  #define CMASK2(P0,P1,t) do{}while(0)
  for(;t+5<NT;t+=2){
    STEP2(pB0,pB1,pA0,pA1,t,true,true,true);     WAIT_BAR(3); RESC2(); ROT2();
    STEP2(pA0,pA1,pB0,pB1,t+1,true,true,true);   WAIT_BAR(3); RESC2(); ROT2();
  }
  #undef CMASK2
  #define CMASK2(P0,P1,t) do{int jb_=(t)-(NT-4); if(jb_>=0)cmask(P0,P1,jb_,qrel,hi);}while(0)
  #define ENDW2(tt) do{ if((tt)+3<NT){WAIT_BAR(3);} else if((tt)+2<NT){WAIT_BAR(2);} else {WAIT_BAR(0);} }while(0)
  for(;t+1<NT;t+=2){
    STEP2(pB0,pB1,pA0,pA1,t,(t+3<NT),(t+1<NT),(t+1<NT));       ENDW2(t);   RESC2(); ROT2();
    STEP2(pA0,pA1,pB0,pB1,t+1,(t+4<NT),(t+2<NT),(t+2<NT));     ENDW2(t+1); RESC2(); ROT2();
  }
  STEP2(pB0,pB1,pA0,pA1,NT-1,false,false,false); RESC2();
  { float sacc=pB0[0]+pB0[1]; _Pragma("unroll") for(int r=2;r<16;++r)sacc+=pB0[r]; _Pragma("unroll") for(int r=0;r<16;++r)sacc+=pB1[r]; l_reg+=sacc;
    pw0=(u32x4){PKW(pB0,0),PKW(pB0,2),PKW(pB0,4),PKW(pB0,6)};pw1=(u32x4){PKW(pB0,8),PKW(pB0,10),PKW(pB0,12),PKW(pB0,14)};pw2=(u32x4){PKW(pB1,0),PKW(pB1,2),PKW(pB1,4),PKW(pB1,6)};pw3=(u32x4){PKW(pB1,8),PKW(pB1,10),PKW(pB1,12),PKW(pB1,14)};
    SBAR(); pv128(o,vb0+2*sl_cur,PAF(0),PAF(1),PAF(2),PAF(3)); }
  #undef PKW
  #undef PAF
  #undef VFR
  #undef PIN
  #undef MX3
  #undef GAPA
  #undef GAPB2
  #undef EX
  #undef VRDS
  #undef KRD
  #undef MF32
  #undef QFR
  #undef STEP2
  #undef ENDW2
  {auto rr=__builtin_amdgcn_permlane32_swap(__float_as_uint(l_reg),__float_as_uint(l_reg),false,false);l_reg=__uint_as_float(rr[0])+__uint_as_float(rr[1]);}
  if(hi==0)wsf[32+r32]=l_reg;asm volatile("s_waitcnt lgkmcnt(0)":::"memory");
  float rli[16];
  #pragma unroll
  for(int r=0;r<16;++r)rli[r]=__builtin_amdgcn_rcpf(wsf[32+crow(r,hi)]);
  bf16*Ow=O+(rowbase+q0+wid*QBLK)*OP+co;
  { bf16*stg=(bf16*)(shm+L2_Q)+wid*2048;
    #pragma unroll
    for(int ps=0;ps<2;++ps){
      #pragma unroll
      for(int r=0;r<16;++r){const int orow=crow(r,hi);
        #pragma unroll
        for(int d0=0;d0<2;++d0)stg[orow*64+d0*32+r32]=__float2bfloat16(o[2*ps+d0][r]*rli[r]);}
      asm volatile("s_waitcnt lgkmcnt(0)":::"memory");
      #pragma unroll
      for(int i=0;i<4;++i){const int row=i*8+(lane>>3),ch=lane&7; const u32x4 v=*(const u32x4*)(stg+row*64+ch*8); ATTN_STORE16(Ow+(long)row*OP+64*ps+ch*8,v);}
      asm volatile("s_waitcnt lgkmcnt(0)":::"memory"); } }
  asm volatile("s_waitcnt lgkmcnt(0)\n\ts_barrier":::"memory");
  #undef DMA_K2
  #undef DMA_V2
  #undef CMASK2
  #undef RESC2
  #undef ROT2
}
constexpr int ATTN128_LDS_BYTES=L2_BYTES;
struct Order128 {
  int vcu, G;
  __device__ __forceinline__ explicit Order128(int grid,int v):vcu(v),G(grid){}
  __device__ __forceinline__ bool next(int i,AttnUnit&u)const{ const int c=(vcu>>1)+(i>>3)*(G>>1); if(c>=128)return false; u.combo=c; const int s=i&7,pr=s>>1,j=s&1,hf=vcu&1; u.qb=15-4*pr-(hf?(1+j):3*j); return true; }
};
template<class Sched,class Hook,int THRL=8> __device__ __forceinline__ void attn_phase128(char*lds,const AttnTensors&T,const Sched&S,const int wid,const Hook&H){
  AttnUnit u;
  for(int i=0;S.next(i,u);++i){ H(i); const int hm=u.combo&15,b=u.combo>>4;
    attn_unit128<THRL>(wid,b,hm*64,(hm>>1)*128,hm*128,u.qb,T.Q,T.K,T.V,T.O,lds); }
}
constexpr int ATTN_LDS_BYTES=LDS_BYTES;
struct StaticOrder {
  int vcu, G;
  __device__ __forceinline__ explicit StaticOrder(int grid,int v):vcu(v),G(grid){}
  __device__ __forceinline__ bool next(int i,AttnUnit&u)const{ const int c=vcu+(i>>4)*G; if(c>=256)return false; u.combo=c; u.qb=15-(i&15); return true; }
};
template<class Sched,class Hook,int THRL=8> __device__ __forceinline__ void attn_phase(char*lds,const AttnTensors&T,const Sched&S,const int wid,const Hook&H){
  AttnUnit u;
  for(int i=0;S.next(i,u);++i){ H(i); const int vh=u.combo&1,hm=(u.combo>>1)&15,b=u.combo>>5;
    attn_unit<THRL>(wid,b,hm*64,(hm>>1)*128+vh*64,(hm*2+vh)*64,u.qb,T.Q,T.K,T.V,T.O,lds); }
}
#undef SBAR
#undef WAIT_BAR
}
#define GAS __attribute__((address_space(1)))
#define LAS __attribute__((address_space(3)))
typedef unsigned short bf16;
typedef unsigned v4u __attribute__((ext_vector_type(4)));
typedef float f32x4 __attribute__((ext_vector_type(4)));
typedef short bf16x8 __attribute__((ext_vector_type(8)));
typedef GAS unsigned gu32;
typedef GAS unsigned long long gu64;
#define RLX_AGENT __ATOMIC_RELAXED, __HIP_MEMORY_SCOPE_AGENT
#define LDS_WAIT() asm volatile("s_waitcnt lgkmcnt(0)" ::: "memory")
#define VM_WAIT() asm volatile("s_waitcnt vmcnt(0)" ::: "memory")
__device__ __forceinline__ unsigned long long rt() { return __builtin_amdgcn_s_memrealtime(); }
__device__ __forceinline__ unsigned f2bf(float f) { unsigned u = __builtin_bit_cast(unsigned, f); return (u + 0x7fffu + ((u >> 16) & 1u)) >> 16; }
__device__ __forceinline__ unsigned pk2(float lo, float hi) { return f2bf(lo) | (f2bf(hi) << 16); }

#define XB_TMO      128
#define XB_XCNT(j)  (256  + 64 * (j))
#define XB_XSUB(j)  (1280 + 64 * (j))
#define XB_XGEN(j)  (2304 + 64 * (j))
#define XB_TOP      3328
#define XB_TOPGEN   3392
#define XCD_BAR_WORDS 3456
#define XB_SPIN_CAP (1u << 18)

__device__ __forceinline__ unsigned xb_ld(unsigned* p)              { return __hip_atomic_load(p, __ATOMIC_RELAXED, __HIP_MEMORY_SCOPE_AGENT); }
__device__ __forceinline__ unsigned xb_add(unsigned* p, unsigned v) { return __hip_atomic_fetch_add(p, v, __ATOMIC_RELAXED, __HIP_MEMORY_SCOPE_AGENT); }
__device__ __forceinline__ unsigned xb_xcc_id() { return (unsigned)__builtin_amdgcn_s_getreg((3 << 11) | 20) & 0xFu; }
#define XB_SPIN(cond, bar) do { unsigned _sp = 0; while (cond) { __builtin_amdgcn_s_sleep(1); \
    if ((++_sp & 255u) == 0u) { if (xb_ld(&(bar)[XB_TMO])) break; if (_sp > XB_SPIN_CAP) { atomicAdd(&(bar)[XB_TMO], 1u); break; } } } } while (0)

struct XcdBarrier {
    unsigned* bar; unsigned x; int wave;
    volatile LAS unsigned* st;
};

__device__ __forceinline__ XcdBarrier xcd_barrier_post(unsigned* bar, volatile LAS unsigned* st) {
    XcdBarrier b; b.bar = bar; b.x = xb_xcc_id(); b.st = st; b.wave = 0;
    if (threadIdx.x == 0) (void)xb_add(&bar[XB_XCNT(b.x)], 1u);
    return b;
}
__device__ __forceinline__ void xcd_barrier_complete(unsigned* bar, unsigned x, unsigned& nloc, unsigned& nx) {
    const unsigned G = gridDim.x * gridDim.y * gridDim.z;
    unsigned sum, cnt, mine, sp = 0u;
    for (;;) {
        sum = 0u; cnt = 0u; mine = 0u;
#pragma unroll
        for (unsigned j = 0; j < 16; ++j) { const unsigned c = xb_ld(&bar[XB_XCNT(j)]); sum += c; cnt += (c > 0u) ? 1u : 0u; mine = (j == x) ? c : mine; }
        if (sum == G) break;
        __builtin_amdgcn_s_sleep(1);
        if ((++sp & 255u) == 0u) { if (xb_ld(&bar[XB_TMO])) break; if (sp > XB_SPIN_CAP) { atomicAdd(&bar[XB_TMO], 1u); break; } }
    }
    nloc = mine > 0u ? mine : 1u; nx = cnt > 0u ? cnt : 1u;
}

__device__ __forceinline__ void xcd_barrier(const XcdBarrier& b) {
    asm volatile("s_waitcnt vmcnt(0)" ::: "memory");
    __syncthreads();
    if (b.wave == 0 && mk_lane_now() == 0) {
        unsigned* bar = b.bar;
        __builtin_amdgcn_s_waitcnt(0);
        unsigned nloc = b.st[0], nx = b.st[1];
        if (nloc == 0u) { xcd_barrier_complete(bar, b.x, nloc, nx); b.st[0] = nloc; b.st[1] = nx; }
        const unsigned old = xb_add(&bar[XB_XSUB(b.x)], 1u);
        const unsigned gen = old / nloc;
        if (old + 1u == (gen + 1u) * nloc) {
            __builtin_amdgcn_fence(__ATOMIC_RELEASE, "agent");
            asm volatile("s_waitcnt vmcnt(0)" ::: "memory");
            const unsigned og = xb_add(&bar[XB_TOP], 1u);
            const unsigned tg = og / nx;
            if (og + 1u == (tg + 1u) * nx) xb_add(&bar[XB_TOPGEN], 1u);
            else XB_SPIN(xb_ld(&bar[XB_TOPGEN]) == tg, bar);
            __builtin_amdgcn_fence(__ATOMIC_ACQUIRE, "agent");
            xb_add(&bar[XB_XGEN(b.x)], 1u);
            asm volatile("s_waitcnt vmcnt(0)" ::: "memory");
        } else {
            XB_SPIN(xb_ld(&bar[XB_XGEN(b.x)]) == gen, bar);
            __builtin_amdgcn_fence(__ATOMIC_ACQUIRE, "agent");
            asm volatile("s_waitcnt vmcnt(0)" ::: "memory");
        }
    }
    __syncthreads();
}


constexpr int NWAVES = 8;
constexpr size_t MiB = 1u << 20;
constexpr size_t WS_CTL = 0, CTL_ZERO_BYTES = 1 * MiB;
constexpr size_t WS_MOD = 1 * MiB;
constexpr size_t WS_BINP = 1 * MiB + 256 * 1024;
constexpr size_t WS_TOPI = 2 * MiB, WS_TOPG = 3 * MiB;
constexpr size_t WS_LIST = 4 * MiB;
constexpr size_t WS_WIN = 36 * MiB, WS_WA = 50 * MiB, WS_WP = 52 * MiB, WS_WO = 54 * MiB, WS_WR = 56 * MiB;
constexpr size_t WS_WDN = 60 * MiB;
constexpr size_t WS_WUP = 190 * MiB;
constexpr size_t WS_YS = 190 * MiB;
constexpr size_t WS_S0 = 448 * MiB, WS_SLOT = 64 * MiB;
constexpr size_t WS_Q = WS_S0, WS_K = WS_S0 + WS_SLOT, WS_V = WS_S0 + 2 * WS_SLOT, WS_U = WS_S0 + 3 * WS_SLOT, WS_SGA = WS_S0 + 4 * WS_SLOT, WS_SGB = WS_S0 + 5 * WS_SLOT;
constexpr size_t WS_CACT = WS_S0 + 6 * WS_SLOT, WS_H = WS_S0 + 7 * WS_SLOT, WS_OATT = WS_S0 + 7 * WS_SLOT;
constexpr size_t WS_ON = WS_S0, WS_YA = WS_S0 + WS_SLOT, WS_M = WS_S0 + 2 * WS_SLOT, WS_Z = WS_S0 + 7 * WS_SLOT, WS_H2 = WS_S0, WS_LG = WS_S0 + WS_SLOT, WS_HID = WS_S0 + 4 * WS_SLOT;
constexpr size_t WS_END = 1024 * MiB;
static_assert(WS_WDN + (size_t)NEX_ * 1024 * 256 * 2 <= WS_WUP && WS_WUP + (size_t)NEX_ * 512 * 1024 * 2 <= WS_S0 && WS_YS + (size_t)T_ * 8 * 1024 * 2 <= WS_HID, "d_ws map");
static_assert(WS_HID + (size_t)1408 * 256 * 256 * 2 <= WS_Z && WS_Z + (size_t)T_ * D_ * 4 <= WS_END, "d_ws map 2");
constexpr int CW_TMO = 0, CW_CODE = 1;
constexpr int CW_BAR = 4096;
constexpr int CW_CNT = 32768;
constexpr int CW_ERR = 65536;
constexpr int RING_OFF = 0, RING_BYTES = 131072;
constexpr int LDSCTL_OFF = RING_BYTES, MISC_OFF = LDSCTL_OFF + 320;
constexpr int UT_OFF = 132096, TAB_OFF = 133120, TOK_OFF = 137216, MAXU = 32, MAXTOK = 16;
constexpr int LDS_BYTES = TOK_OFF + MAXTOK * 1024;
static_assert(MISC_OFF + 128 <= UT_OFF && UT_OFF + MAXU * 32 <= TAB_OFF && TAB_OFF + 3 * 260 * 4 <= TOK_OFF && LDS_BYTES <= 163840, "LDS map");

enum { I_X = 0, I_C, I_ADAW, I_ADAB, I_WIN, I_BIN, I_LQ1, I_LK1, I_LQ2, I_LK2, I_SUBG, I_WAO, I_CW, I_CB, I_CLG, I_CLB, I_PWW, I_PWB, I_WOUT, I_LN1G, I_LN1B,
       I_RW, I_RB, I_W1, I_W3, I_W2, I_WS1, I_WS3, I_WS2, I_LN2G, I_LN2B, N_IN };
struct Args { const float* in[N_IN]; float* out; unsigned char* ws; int ph_lo, ph_hi; };
static_assert(sizeof(Args) == N_IN * 8 + 24, "Args has no padding");
typedef const __attribute__((address_space(4))) Args* CArgs;
__device__ __forceinline__ CArgs args_now() { auto p = __builtin_amdgcn_kernarg_segment_ptr(); asm volatile("" : "+s"(p)); return (CArgs)p; }
struct Frame {
    LAS unsigned char* lds; volatile LAS unsigned* MISC; gu32* ctl;
    int tid, lane, wave, vcu, G;
};
__device__ __forceinline__ float wave_sum(float v) {
#pragma unroll
    for (int o = 1; o < 64; o <<= 1) v += __shfl_xor(v, o);
    return v;
}
__device__ __forceinline__ float wave_sum63(float v) {
#define DPP_ADD(ctrl, rmask) v += __uint_as_float((unsigned)__builtin_amdgcn_update_dpp(0, (int)__float_as_uint(v), ctrl, rmask, 0xF, false))
    DPP_ADD(0xB1, 0xF);
    DPP_ADD(0x4E, 0xF);
    DPP_ADD(0x141, 0xF);
    DPP_ADD(0x140, 0xF);
    DPP_ADD(0x142, 0xA);
    DPP_ADD(0x143, 0xC);
#undef DPP_ADD
    return v;
}
__device__ __forceinline__ float sigm_f(float x) { return __builtin_amdgcn_rcpf(1.0f + __builtin_amdgcn_exp2f(-x * LOG2E_)); }
__device__ __forceinline__ unsigned pkbf(float lo, float hi) { return pg8::cvt_pk_bf16(lo, hi); }
__device__ __forceinline__ float bflo(unsigned w) { return __uint_as_float(w << 16); }
__device__ __forceinline__ float bfhi(unsigned w) { return __uint_as_float(w & 0xffff0000u); }

__host__ __device__ __forceinline__ int in_dest_row(int col) {
    if (col < 3072) return col;
    if (col < 5120) { const int r = col - 3072, half = r >> 10, rr = r & 1023; return 3072 + (rr >> 7) * 256 + half * 128 + (rr & 127); }
    const int r = col - 5120, half = r >> 10, rr = r & 1023; return 5120 + (rr >> 7) * 256 + half * 128 + (rr & 127);
}
__host__ __device__ __forceinline__ int in_orig_col(int rho) {
    if (rho < 3072) return rho;
    if (rho < 5120) { const int r = rho - 3072, j = r >> 8, w = r & 255; return 3072 + (w >> 7) * 1024 + j * 128 + (w & 127); }
    const int r = rho - 5120, j = r >> 8, w = r & 255; return 5120 + (w >> 7) * 1024 + j * 128 + (w & 127);
}

constexpr int CV_IN = 16 * 112, CV_SQ = 16 * 16, CV_R = 16 * 4, CV_EX = NEX_ * 64, CV_SMALL = CV_IN + 3 * CV_SQ + CV_R, CV_ALL = CV_SMALL + 3 * CV_EX;
struct CvItem { const GAS f32x4* src; GAS v4u* dst; int K, N; };
__device__ __forceinline__ CvItem cv_decode(CArgs A, int it, int lane) {
    unsigned char* ws = A->ws; const int n4 = (lane & 15) * 4, kbl = (lane >> 4) * 8;
    const float* src; bf16* dst; int K, N, k0, n0; int r = it;
    if (r < CV_IN) { const int kb = r / 112, nb = r % 112; K = 1024; N = NIN_; k0 = kb * 64; n0 = nb * 64; src = A->in[I_WIN]; dst = (bf16*)(ws + WS_WIN) + (size_t)in_dest_row(n0) * 1024; }
    else if ((r -= CV_IN) < 3 * CV_SQ) { const int w = r / CV_SQ, q = r % CV_SQ, kb = q / 16, nb = q % 16; K = 1024; N = 1024; k0 = kb * 64; n0 = nb * 64;
        src = w == 0 ? A->in[I_WAO] : (w == 1 ? A->in[I_PWW] : A->in[I_WOUT]); dst = (bf16*)(ws + (w == 0 ? WS_WA : (w == 1 ? WS_WP : WS_WO))) + (size_t)n0 * 1024; }
    else if ((r -= 3 * CV_SQ) < CV_R) { const int kb = r / 4, nb = r % 4; K = 1024; N = 256; k0 = kb * 64; n0 = nb * 64; src = A->in[I_RW]; dst = (bf16*)(ws + WS_WR) + (size_t)n0 * 1024; }
    else if ((r -= CV_R) < 2 * CV_EX) { const int w3 = r >= CV_EX; if (w3) r -= CV_EX; const int e = r / 64, q = r % 64, kb = q / 4, nb = q % 4; K = 1024; N = 256; k0 = kb * 64; n0 = nb * 64;
        src = e < NE_ ? (w3 ? A->in[I_W3] : A->in[I_W1]) + (size_t)e * 262144 : (w3 ? A->in[I_WS3] : A->in[I_WS1]);
        dst = (bf16*)(ws + WS_WUP) + ((size_t)e * 512 + (n0 >> 7) * 256 + w3 * 128 + (n0 & 127)) * 1024; }
    else { r -= 2 * CV_EX; const int e = r / 64, q = r % 64, kb = q / 16, nb = q % 16; K = 256; N = 1024; k0 = kb * 64; n0 = nb * 64;
        src = e < NE_ ? A->in[I_W2] + (size_t)e * 262144 : A->in[I_WS2]; dst = (bf16*)(ws + WS_WDN) + ((size_t)e * 1024 + n0) * 256; }
    CvItem c; c.src = (const GAS f32x4*)(src + (size_t)(k0 + kbl) * N + n0 + n4); c.dst = (GAS v4u*)(dst + (size_t)n4 * K + k0 + kbl); c.K = K; c.N = N; return c;
}
#define CV_LOAD(c, v) do { _Pragma("unroll") for (int p_ = 0; p_ < 2; ++p_) _Pragma("unroll") for (int j_ = 0; j_ < 8; ++j_) v[p_][j_] = (c).src[((size_t)(32 * p_ + j_) * (c).N) >> 2]; } while (0)
#define CV_STORE(c, v) do { _Pragma("unroll") for (int p_ = 0; p_ < 2; ++p_) _Pragma("unroll") for (int c_ = 0; c_ < 4; ++c_) { v4u o_; \
        o_.x = pkbf(v[p_][0][c_], v[p_][1][c_]); o_.y = pkbf(v[p_][2][c_], v[p_][3][c_]); o_.z = pkbf(v[p_][4][c_], v[p_][5][c_]); o_.w = pkbf(v[p_][6][c_], v[p_][7][c_]); \
        (c).dst[((size_t)c_ * (c).K + 32 * p_) >> 3] = o_; } } while (0)
__device__ __forceinline__ void convert_items(CArgs A, int gw, int NGW, int lane, int first, int last) {
    int it = first + gw; if (it >= last) return;
    CvItem cur = cv_decode(A, it, lane); f32x4 v[2][8]; CV_LOAD(cur, v);
    for (;;) {
        const int nx = it + NGW; const bool more = nx < last;
        CvItem nxt = cur; f32x4 w[2][8];
        if (more) { nxt = cv_decode(A, nx, lane); CV_LOAD(nxt, w); }
        CV_STORE(cur, v);
        if (!more) break;
#pragma unroll
        for (int p_ = 0; p_ < 2; ++p_)
#pragma unroll
            for (int j_ = 0; j_ < 8; ++j_) v[p_][j_] = w[p_][j_];
        cur = nxt; it = nx;
    }
}
struct ConvHook { CArgs A; int gw, NGW, pos;
    __device__ __forceinline__ void operator()(int i) const { if (i == pos) { convert_items(A, gw, NGW, mk_lane_now(), CV_SMALL, CV_ALL); asm volatile("s_waitcnt vmcnt(0)" ::: "memory"); } } };
__device__ __forceinline__ void p0_prologue(Frame& F, CArgs A) {
    unsigned char* ws = A->ws;
    if (blockIdx.x < 192) {
        LAS float* sc = (LAS float*)(F.lds); LAS float* part = (LAS float*)(F.lds + 32768);
        const float* c = A->in[I_C];
        for (int i = F.tid; i < 8192; i += 512) { const float v = c[i]; sc[i] = v * sigm_f(v); }
        __syncthreads();
        const int j0 = blockIdx.x * 32, kg = F.tid >> 5, col = F.tid & 31;
        const float* w = A->in[I_ADAW] + (size_t)(kg * 64) * 6144 + j0 + col;
        float acc[8] = {0.f, 0.f, 0.f, 0.f, 0.f, 0.f, 0.f, 0.f};
#pragma unroll 8
        for (int kk = 0; kk < 64; ++kk) { const float wv = w[(size_t)kk * 6144]; const int k = kg * 64 + kk;
#pragma unroll
            for (int b = 0; b < 8; ++b) acc[b] += sc[b * 1024 + k] * wv; }
#pragma unroll
        for (int b = 0; b < 8; ++b) part[(kg * 8 + b) * 32 + col] = acc[b];
        __syncthreads();
        if (F.tid < 256) { const int b = F.tid >> 5, cc = F.tid & 31; float s = A->in[I_ADAB][j0 + cc];
            for (int g = 0; g < 16; ++g) s += part[(g * 8 + b) * 32 + cc];
            ((float*)(ws + WS_MOD))[b * 6144 + j0 + cc] = s; }
        __syncthreads();
    }
    { const int gt = blockIdx.x * 512 + F.tid; if (gt < NIN_) ((float*)(ws + WS_BINP))[gt] = A->in[I_BIN][in_orig_col(gt)]; }
    convert_items(A, F.vcu * NWAVES + F.wave, F.G * NWAVES, F.lane, 0, CV_SMALL);
}
__device__ __forceinline__ void p1_modulate(Frame& F, CArgs A) {
    const int gw = F.vcu * NWAVES + F.wave, NGW = F.G * NWAVES;
    const float* mod = (const float*)(A->ws + WS_MOD); bf16* H = (bf16*)(A->ws + WS_H);
    for (int m = gw; m < T_; m += NGW) { const int b = m >> 12;
        const GAS f32x4* xr = (const GAS f32x4*)(A->in[I_X] + (size_t)m * D_) + F.lane;
        const f32x4* sh = (const f32x4*)(mod + b * 6144) + F.lane; const f32x4* sc = (const f32x4*)(mod + b * 6144 + 1024) + F.lane;
        GAS unsigned long long* o8 = (GAS unsigned long long*)(H + (size_t)m * D_) + F.lane;
#pragma unroll
        for (int j = 0; j < 4; ++j) { const f32x4 v = xr[64 * j], s = sc[64 * j], h = sh[64 * j]; const f32x4 o = v * (s + 1.0f) + h;
            o8[64 * j] = (unsigned long long)pkbf(o.x, o.y) | ((unsigned long long)pkbf(o.z, o.w) << 32); } }
}
__device__ __forceinline__ void p3_conv(Frame& F, CArgs A) {
    typedef float f32x2 __attribute__((ext_vector_type(2)));
    LAS unsigned* U = (LAS unsigned*)(F.lds);
    LAS v4u* U16 = (LAS v4u*)(F.lds);
    LAS float* ST = (LAS float*)(F.lds + 126976);
    LAS float* MS = ST + 256;
    const bf16* ug = (const bf16*)(A->ws + WS_U); unsigned* co = (unsigned*)(A->ws + WS_CACT);
    const int c0 = 2 * F.tid;
    f32x2 w[31];
#pragma unroll
    for (int j = 0; j < 31; ++j) w[j] = *(const f32x2*)(A->in[I_CW] + j * 1024 + c0);
    const f32x2 cb = *(const f32x2*)(A->in[I_CB] + c0), g = *(const f32x2*)(A->in[I_CLG] + c0), be = *(const f32x2*)(A->in[I_CLB] + c0);
    for (int tile = F.vcu; tile < T_ / 32; tile += F.G) {
        const int t0 = tile * 32, tb = t0 & (SEQ_ - 1);
        {
            v4u sv[16];
#pragma unroll
            for (int i = 0; i < 16; ++i) { const int ch = F.tid + 512 * i, r = ch >> 7, cc = ch & 127; const int pos = tb - 30 + r;
                sv[i] = (v4u){0u, 0u, 0u, 0u}; if (ch < 62 * 128 && pos >= 0) sv[i] = *(const GAS v4u*)(ug + (size_t)(t0 - 30 + r) * D_ + cc * 8); }
#pragma unroll
            for (int i = 0; i < 16; ++i) { const int ch = F.tid + 512 * i; if (ch < 62 * 128) U16[ch] = sv[i]; }
        }
        __syncthreads();
#pragma unroll 1
        for (int half = 0; half < 2; ++half) {
            f32x2 y[16];
#pragma unroll
            for (int chunk = 0; chunk < 2; ++chunk) {
                f32x2 v[38];
#pragma unroll
                for (int r = 0; r < 38; ++r) { const unsigned x = U[(half * 16 + chunk * 8 + r) * 512 + F.tid]; v[r] = (f32x2){bflo(x), bfhi(x)}; }
#pragma unroll
                for (int tt = 0; tt < 8; ++tt) { f32x2 a = cb;
#pragma unroll
                    for (int j = 0; j < 31; ++j) a = __builtin_elementwise_fma(w[j], v[tt + j], a);
                    y[chunk * 8 + tt] = a; }
            }
#pragma unroll
            for (int tt = 0; tt < 16; ++tt) { const float s = wave_sum63(y[tt].x + y[tt].y), q = wave_sum63(y[tt].x * y[tt].x + y[tt].y * y[tt].y);
                if (F.lane == 63) { ST[(F.wave * 16 + tt) * 2] = s; ST[(F.wave * 16 + tt) * 2 + 1] = q; } }
            __syncthreads();
            if (F.tid < 16) { float s = 0.f, q = 0.f;
                for (int wv = 0; wv < 8; ++wv) { s += ST[(wv * 16 + F.tid) * 2]; q += ST[(wv * 16 + F.tid) * 2 + 1]; }
                const float mean = s * (1.f / 1024.f), var = q * (1.f / 1024.f) - mean * mean;
                MS[F.tid * 2] = mean; MS[F.tid * 2 + 1] = 1.0f / sqrtf(fmaxf(var, 0.f) + LN_EPS_); }
            __syncthreads();
#pragma unroll
            for (int tt = 0; tt < 16; ++tt) { const float mean = MS[tt * 2], rstd = MS[tt * 2 + 1];
                const f32x2 z = (y[tt] - mean) * rstd * g + be;
                co[((size_t)(t0 + half * 16 + tt) * D_ + c0) >> 1] = pkbf(z.x * sigm_f(z.x), z.y * sigm_f(z.y)); }
        }
        __syncthreads();
    }
}
__device__ __forceinline__ void p4_onorm(Frame& F, CArgs A) {
    const int gw = F.vcu * NWAVES + F.wave, NGW = F.G * NWAVES;
    const float s1 = wave_sum(A->in[I_LQ1][F.lane] * A->in[I_LK1][F.lane]), s2 = wave_sum(A->in[I_LQ2][F.lane] * A->in[I_LK2][F.lane]);
    const float lam = expf(s1) - expf(s2) + LAM_INIT_;
    const int h = F.lane >> 3, dv0 = (F.lane & 7) * 16;
    float g[16];
#pragma unroll
    for (int i = 0; i < 16; ++i) g[i] = A->in[I_SUBG][dv0 + i] * (1.0f - LAM_INIT_);
    const bf16* O = (const bf16*)(A->ws + WS_OATT); bf16* ON = (bf16*)(A->ws + WS_ON);
    for (int m = gw; m < T_; m += NGW) {
        const GAS v4u* p0 = (const GAS v4u*)(O + (size_t)m * 2048 + h * 256 + dv0); const GAS v4u* p1 = (const GAS v4u*)(O + (size_t)m * 2048 + h * 256 + 128 + dv0);
        const v4u a0 = p0[0], a1 = p0[1], b0 = p1[0], b1 = p1[1];
        float o[16];
#define P4_UNP(dst, A_, B_, k) { o[dst] = bflo(A_[k]) - lam * bflo(B_[k]); o[dst + 1] = bfhi(A_[k]) - lam * bfhi(B_[k]); }
        P4_UNP(0, a0, b0, 0) P4_UNP(2, a0, b0, 1) P4_UNP(4, a0, b0, 2) P4_UNP(6, a0, b0, 3) P4_UNP(8, a1, b1, 0) P4_UNP(10, a1, b1, 1) P4_UNP(12, a1, b1, 2) P4_UNP(14, a1, b1, 3)
#undef P4_UNP
        float ss = 0.f;
#pragma unroll
        for (int i = 0; i < 16; ++i) ss += o[i] * o[i];
        ss += __shfl_xor(ss, 1); ss += __shfl_xor(ss, 2); ss += __shfl_xor(ss, 4);
        const float r = 1.0f / sqrtf(ss * (1.f / 128.f) + RMS_EPS_);
        v4u w0, w1;
        w0.x = pkbf(o[0] * r * g[0], o[1] * r * g[1]); w0.y = pkbf(o[2] * r * g[2], o[3] * r * g[3]); w0.z = pkbf(o[4] * r * g[4], o[5] * r * g[5]); w0.w = pkbf(o[6] * r * g[6], o[7] * r * g[7]);
        w1.x = pkbf(o[8] * r * g[8], o[9] * r * g[9]); w1.y = pkbf(o[10] * r * g[10], o[11] * r * g[11]); w1.z = pkbf(o[12] * r * g[12], o[13] * r * g[13]); w1.w = pkbf(o[14] * r * g[14], o[15] * r * g[15]);
        GAS v4u* q = (GAS v4u*)(ON + (size_t)m * D_ + h * 128 + dv0); q[0] = w0; q[1] = w1;
    }
}
__device__ __forceinline__ void p7_ln1(Frame& F, CArgs A) {
    const int gw = F.vcu * NWAVES + F.wave, NGW = F.G * NWAVES;
    const float* mod = (const float*)(A->ws + WS_MOD); float* Z = (float*)(A->ws + WS_Z); bf16* H2 = (bf16*)(A->ws + WS_H2);
    f32x4 lg[4], lb[4];
#pragma unroll
    for (int j = 0; j < 4; ++j) { lg[j] = ((const f32x4*)A->in[I_LN1G])[F.lane + 64 * j]; lb[j] = ((const f32x4*)A->in[I_LN1B])[F.lane + 64 * j]; }
    for (int m = gw; m < T_; m += NGW) { const int b = m >> 12;
        GAS f32x4* zr = (GAS f32x4*)(Z + (size_t)m * D_) + F.lane;
        f32x4 v[4]; float s = 0.f;
#pragma unroll
        for (int j = 0; j < 4; ++j) { v[j] = zr[64 * j]; s += (v[j].x + v[j].y) + (v[j].z + v[j].w); }
        const float mean = wave_sum(s) * (1.f / D_); float s2 = 0.f;
#pragma unroll
        for (int j = 0; j < 4; ++j) { v[j] = v[j] - mean; s2 += (v[j].x * v[j].x + v[j].y * v[j].y) + (v[j].z * v[j].z + v[j].w * v[j].w); }
        const float rstd = 1.f / sqrtf(wave_sum(s2) * (1.f / D_) + LN_EPS_);
        const f32x4* sh = (const f32x4*)(mod + b * 6144 + 3072) + F.lane; const f32x4* sc = (const f32x4*)(mod + b * 6144 + 4096) + F.lane;
        GAS unsigned long long* o8 = (GAS unsigned long long*)(H2 + (size_t)m * D_) + F.lane;
#pragma unroll
        for (int j = 0; j < 4; ++j) { const f32x4 x1 = v[j] * rstd * lg[j] + lb[j]; zr[64 * j] = x1;
            const f32x4 o = x1 * (sc[64 * j] + 1.0f) + sh[64 * j];
            o8[64 * j] = (unsigned long long)pkbf(o.x, o.y) | ((unsigned long long)pkbf(o.z, o.w) << 32); }
    }
}
__device__ __forceinline__ void p9_route(Frame& F, CArgs A) {
    const float* lg = (const float*)(A->ws + WS_LG); int* topi = (int*)(A->ws + WS_TOPI); float* topg = (float*)(A->ws + WS_TOPG); int* list = (int*)(A->ws + WS_LIST);
    gu32* gcnt = F.ctl + CW_CNT;
    LAS int* hist = (LAS int*)(F.lds); LAS int* basel = hist + 256; LAS int* sel = basel + 256;
    float rb[4];
#pragma unroll
    for (int j = 0; j < 4; ++j) rb[j] = A->in[I_RB][F.lane + 64 * j];
    const int hf = F.lane >> 5;
    for (int tb = F.vcu; tb < T_ / 128; tb += F.G) {
        if (F.tid < 256) hist[F.tid] = 0;
        __syncthreads();
        for (int i = 0; i < 16; ++i) { const int t = tb * 128 + F.wave * 16 + i;
            float s[4], c[4], gs[4];
#pragma unroll
            for (int j = 0; j < 4; ++j) { s[j] = sigm_f(lg[(size_t)t * NE_ + F.lane + 64 * j]); c[j] = s[j] + rb[j]; }
#pragma unroll
            for (int j = 0; j < 4; ++j) { float m1 = c[j];
#pragma unroll
                for (int o = 1; o < 32; o <<= 1) m1 = fmaxf(m1, __shfl_xor(m1, o));
                const unsigned long long bal = __ballot(c[j] == m1); const unsigned hb = hf ? (unsigned)(bal >> 32) : (unsigned)bal; const int first = (__ffs((int)hb) - 1) + (F.lane & 32);
                float m2 = (F.lane == first) ? -INFINITY : c[j];
#pragma unroll
                for (int o = 1; o < 32; o <<= 1) m2 = fmaxf(m2, __shfl_xor(m2, o));
                gs[j] = m1 + m2; }
            float G8[8];
#pragma unroll
            for (int j = 0; j < 4; ++j) { G8[2 * j] = __uint_as_float(__builtin_amdgcn_readlane(__float_as_uint(gs[j]), 0)); G8[2 * j + 1] = __uint_as_float(__builtin_amdgcn_readlane(__float_as_uint(gs[j]), 32)); }
#pragma unroll
            for (int j = 0; j < 4; ++j) { const float mine = hf ? G8[2 * j + 1] : G8[2 * j]; const int g = 2 * j + hf; int rank = 0;
#pragma unroll
                for (int gp = 0; gp < 8; ++gp) rank += (G8[gp] > mine || (G8[gp] == mine && gp < g)) ? 1 : 0;
                if (rank >= 4) c[j] = -INFINITY; }
            int ek = 0; float sk = 0.f, ssum = 0.f;
#pragma unroll
            for (int k = 0; k < 8; ++k) { float wm = fmaxf(fmaxf(c[0], c[1]), fmaxf(c[2], c[3]));
#pragma unroll
                for (int o = 1; o < 64; o <<= 1) wm = fmaxf(wm, __shfl_xor(wm, o));
                int e = 0x7fffffff;
#pragma unroll
                for (int j = 3; j >= 0; --j) if (c[j] == wm) e = F.lane + 64 * j;
#pragma unroll
                for (int o = 1; o < 64; o <<= 1) e = min(e, __shfl_xor(e, o));
                float sv = 0.f;
#pragma unroll
                for (int j = 0; j < 4; ++j) if (F.lane + 64 * j == e) { sv = s[j]; c[j] = -INFINITY; }
                sv = __shfl(sv, e & 63);
                ssum += sv; if (F.lane == k) { ek = e; sk = sv; } }
            if (F.lane < 8) { const int a = t * 8 + F.lane; topi[a] = ek; topg[a] = sk / ssum * ROUTED_SCALE_;
                const int lr = __hip_atomic_fetch_add(&hist[ek], 1, __ATOMIC_RELAXED, __HIP_MEMORY_SCOPE_WORKGROUP); sel[(F.wave * 16 + i) * 8 + F.lane] = ek | (lr << 16); }
        }
        __syncthreads();
        if (F.tid < 256) { const int h = hist[F.tid]; int base = 0; if (h > 0) base = (int)__hip_atomic_fetch_add(gcnt + 64 * F.tid, (unsigned)h, __ATOMIC_RELAXED, __HIP_MEMORY_SCOPE_AGENT); basel[F.tid] = base; }
        __syncthreads();
        for (int q = F.lane; q < 128; q += 64) { const int i = q >> 3, k = q & 7, v = sel[(F.wave * 16 + i) * 8 + k], e = v & 0xffff, lr = v >> 16, t = tb * 128 + F.wave * 16 + i;
            list[(size_t)e * T_ + basel[e] + lr] = t * 8 + k; }
        __syncthreads();
    }
}
template <int NP, bool FILL_TOK>
__device__ __forceinline__ int moe_setup(Frame& F, CArgs A) {
    LAS int* UT = (LAS int*)(F.lds + UT_OFF); LAS int* NT = (LAS int*)(F.lds + TAB_OFF); LAS int* TS = NT + 260; LAS int* CN = TS + 260; LAS int* TOK = (LAS int*)(F.lds + TOK_OFF);
    const int* list = (const int*)(A->ws + WS_LIST);
    if (F.tid < NEX_) { int c = T_; if (F.tid < NE_) { c = (int)__hip_atomic_load(F.ctl + CW_CNT + 64 * F.tid, __ATOMIC_RELAXED, __HIP_MEMORY_SCOPE_AGENT); c = c < 0 ? 0 : (c > T_ ? T_ : c); } CN[F.tid] = c; NT[F.tid] = (c + 255) >> 8; }
    __syncthreads();
    if (F.wave == 0) { int loc[5]; int s = 0;
#pragma unroll
        for (int i = 0; i < 5; ++i) { const int idx = 5 * F.lane + i; loc[i] = s; s += (idx < NEX_) ? NT[idx] : 0; }
        int incl = s;
#pragma unroll
        for (int o = 1; o < 64; o <<= 1) { const int n = __shfl_up(incl, o); if (F.lane >= o) incl += n; }
        const int excl = incl - s;
#pragma unroll
        for (int i = 0; i < 5; ++i) { const int idx = 5 * F.lane + i; if (idx < NEX_) TS[idx] = excl + loc[i]; }
        if (F.lane == 63) TS[NEX_] = incl; }
    __syncthreads();
    const int total = TS[NEX_] * NP;
    int nun = (F.vcu < total) ? (total - F.vcu + F.G - 1) / F.G : 0;
    if (nun > (FILL_TOK ? MAXTOK : MAXU)) { nun = FILL_TOK ? MAXTOK : MAXU; if (F.tid == 0) __hip_atomic_store(F.ctl + CW_TMO, 0xBAD0u, RLX_AGENT); }
    if (F.tid < nun) { const int L = F.tid * F.G + F.vcu, rtg = L / NP, pn = L % NP; int lo = 0, hi = NE_;
        while (lo < hi) { const int mid = (lo + hi + 1) >> 1; if (TS[mid] <= rtg) lo = mid; else hi = mid - 1; }
        const int e = lo, rt = rtg - TS[e]; int nr = CN[e] - rt * 256; nr = nr > 256 ? 256 : nr;
        UT[F.tid * 8 + 0] = e; UT[F.tid * 8 + 1] = rt; UT[F.tid * 8 + 2] = pn; UT[F.tid * 8 + 3] = nr; UT[F.tid * 8 + 4] = rtg; }
    __syncthreads();
    if (FILL_TOK) {
        for (int sl = 0; sl < nun; ++sl) if (F.tid < 256) { const int e = UT[sl * 8], rt = UT[sl * 8 + 1], nr = UT[sl * 8 + 3]; int tok = 0;
            if (F.tid < nr) tok = (e < NE_) ? (list[(size_t)e * T_ + rt * 256 + F.tid] >> 3) : (rt * 256 + F.tid);
            TOK[sl * 256 + F.tid] = tok; }
        __syncthreads();
    }
    return nun;
}
__device__ __forceinline__ void p12_final(Frame& F, CArgs A, bool poison) {
    typedef float f32x2 __attribute__((ext_vector_type(2)));
    const int gw = F.vcu * NWAVES + F.wave, NGW = F.G * NWAVES;
    const float* mod = (const float*)(A->ws + WS_MOD); const float* XB = (const float*)(A->ws + WS_Z); const unsigned char* YS = (const unsigned char*)(A->ws + WS_YS);
    const float qnan = __builtin_nanf(""); const int c = 16 * F.lane;
    for (int m0 = gw; m0 < T_; m0 += 2 * NGW) {
        v4u yw[2][8]; f32x4 xb[2][4];
#pragma unroll
        for (int rr = 0; rr < 2; ++rr) { const int m = (m0 + rr * NGW < T_) ? m0 + rr * NGW : m0;
#pragma unroll
            for (int k = 0; k < 8; ++k) yw[rr][k] = *(const GAS v4u*)(YS + ((size_t)m * 8 + k) * D_ + c);
#pragma unroll
            for (int q = 0; q < 4; ++q) xb[rr][q] = *(const GAS f32x4*)(XB + (size_t)m * D_ + c + 4 * q); }
#pragma unroll
        for (int rr = 0; rr < 2; ++rr) { const int m = m0 + rr * NGW; if (m >= T_) break; const int b = m >> 12;
            f32x4 v[4]; float s = 0.f;
#pragma unroll
            for (int q = 0; q < 4; ++q) { f32x4 a = (f32x4){0.f, 0.f, 0.f, 0.f};
#pragma unroll
                for (int k = 0; k < 8; ++k) { const int w = (int)yw[rr][k][q]; const f32x2 lo = __builtin_amdgcn_cvt_pk_f32_fp8(w, false), hi = __builtin_amdgcn_cvt_pk_f32_fp8(w, true); a += (f32x4){lo.x, lo.y, hi.x, hi.y}; }
                const f32x4 g = *(const f32x4*)(mod + b * 6144 + 5120 + c + 4 * q) * (1.0f / pg8::YS_SCALE);
                v[q] = xb[rr][q] + g * a; s += (v[q].x + v[q].y) + (v[q].z + v[q].w); }
            const float mean = wave_sum(s) * (1.f / D_); float s2 = 0.f;
#pragma unroll
            for (int q = 0; q < 4; ++q) { v[q] = v[q] - mean; s2 += (v[q].x * v[q].x + v[q].y * v[q].y) + (v[q].z * v[q].z + v[q].w * v[q].w); }
            const float rstd = 1.f / sqrtf(wave_sum(s2) * (1.f / D_) + LN_EPS_);
#pragma unroll
            for (int q = 0; q < 4; ++q) { f32x4 o = v[q] * rstd * *(const f32x4*)(A->in[I_LN2G] + c + 4 * q) + *(const f32x4*)(A->in[I_LN2B] + c + 4 * q);
                if (poison) o = (f32x4){qnan, qnan, qnan, qnan};
                *(GAS f32x4*)(A->out + (size_t)m * D_ + c + 4 * q) = o; }
        }
    }
}

constexpr int NPH = 13;
#ifndef REP_PH
#define REP_PH (-1)
#endif
#ifndef REP_N
#define REP_N 2
#endif
#define NREP(k) ((k) == REP_PH ? REP_N : 1)
__global__ void __launch_bounds__(NWAVES * 64, 2) mk_fwd(Args args) {
    extern __shared__ __attribute__((aligned(16))) unsigned char lds[];
    Frame F;
    F.lds = (LAS unsigned char*)lds;
    F.MISC = (volatile LAS unsigned*)(F.lds + MISC_OFF);
    #define REFRESH() do { F.lane = mk_lane_now(); F.tid = F.wave * 64 + F.lane; } while (0)
    F.wave = __builtin_amdgcn_readfirstlane((int)threadIdx.x >> 6); REFRESH();
    F.G = gridDim.x; { const int bx = blockIdx.x; F.vcu = (F.G % 8 == 0) ? (bx % 8) * (F.G / 8) + bx / 8 : bx; }
    F.ctl = (gu32*)(args.ws + WS_CTL);
    for (int u = F.tid; u < (LDS_BYTES - LDSCTL_OFF) / 4; u += NWAVES * 64) ((LAS unsigned*)(F.lds + LDSCTL_OFF))[u] = 0u;
    __syncthreads();
    const int lo = args.ph_lo, hi = args.ph_hi;
    XcdBarrier bar; bar.bar = (unsigned*)(F.ctl + CW_BAR); bar.x = 0; bar.st = nullptr; bar.wave = F.wave;
    if (hi - lo > 1) { bar = xcd_barrier_post((unsigned*)(F.ctl + CW_BAR), F.MISC + 8); bar.wave = F.wave; }
#define IN(k) (lo <= (k) && (k) < hi)
#define BOTH(k) (IN(k) && IN((k) + 1))
#define GRID_BAR() xcd_barrier(bar)

    if (IN(0)) _Pragma("unroll") for (int rep_ = 0; rep_ < NREP(0); ++rep_) { if (rep_ > 0) GRID_BAR(); REFRESH(); CArgs A = args_now(); unsigned char* ws = A->ws; p0_prologue(F, A); if (BOTH(0)) GRID_BAR(); }
    if (IN(1)) _Pragma("unroll") for (int rep_ = 0; rep_ < NREP(1); ++rep_) { if (rep_ > 0) GRID_BAR(); REFRESH(); CArgs A = args_now(); unsigned char* ws = A->ws; p1_modulate(F, A); if (BOTH(1)) GRID_BAR(); }
    if (IN(2)) _Pragma("unroll") for (int rep_ = 0; rep_ < NREP(2); ++rep_) { if (rep_ > 0) GRID_BAR(); REFRESH(); CArgs A = args_now(); unsigned char* ws = A->ws;
        pg8::Gemm g{(const pg8::bf16_t*)(ws + WS_H), (const pg8::bf16_t*)(ws + WS_WIN)}; pg8::StaticOrder S; S.init(T_, NIN_, F.G, (int)blockIdx.x);
        pg8::EpiInproj E{(pg8::bf16_t*)(ws + WS_Q), (size_t)(WS_SLOT / 2), (pg8::bf16_t*)(ws + WS_U), (pg8::bf16_t*)(ws + WS_SGA), (pg8::bf16_t*)(ws + WS_SGB),
                         (const float*)(ws + WS_BINP), attn_body::C2};
        pg8::gemm_phase<D_, pg8::EpiInproj, pg8::StaticOrder, PG8_ALIGN, PG8_SP2, false>(F.lds + RING_OFF, g, S, E, F.wave);
        if (BOTH(2)) GRID_BAR();
    }
    if (IN(3)) _Pragma("unroll") for (int rep_ = 0; rep_ < NREP(3); ++rep_) { if (rep_ > 0) GRID_BAR(); REFRESH(); CArgs A = args_now(); unsigned char* ws = A->ws;
#ifndef REP_CONV
#define REP_CONV 1
#endif
        p3_conv(F, A); __syncthreads();
        const attn_body::AttnTensors AT{(const attn_body::bf16*)(ws + WS_Q), (const attn_body::bf16*)(ws + WS_K), (const attn_body::bf16*)(ws + WS_V), (attn_body::bf16*)(ws + WS_OATT)};
        const attn_body::Order128 S((int)F.G, F.vcu);
        static_assert(attn_body::ATTN128_LDS_BYTES <= RING_BYTES, "attention LDS");
        const int grp_ = F.vcu & 3; const ConvHook HK{A, F.vcu * NWAVES + F.wave, F.G * NWAVES, grp_ == 0 ? 0 : (grp_ == 1 ? 1 : (grp_ == 2 ? 2 : 4))};
        attn_body::attn_phase128<attn_body::Order128>((char*)lds + RING_OFF, AT, S, F.wave, HK);
        if (BOTH(3)) GRID_BAR();
    }
    if (IN(4)) _Pragma("unroll") for (int rep_ = 0; rep_ < NREP(4); ++rep_) { if (rep_ > 0) GRID_BAR(); REFRESH(); CArgs A = args_now(); unsigned char* ws = A->ws; if (REP_CONV > 1) { p3_conv(F, A); __syncthreads(); } p4_onorm(F, A); if (BOTH(4)) GRID_BAR(); }
    if (IN(5)) _Pragma("unroll") for (int rep_ = 0; rep_ < NREP(5); ++rep_) { if (rep_ > 0) GRID_BAR(); REFRESH(); CArgs A = args_now(); unsigned char* ws = A->ws;
        { pg8::Gemm g{(const pg8::bf16_t*)(ws + WS_ON), (const pg8::bf16_t*)(ws + WS_WA)}; pg8::StaticOrder S; S.init(T_, D_, F.G, (int)blockIdx.x);
          pg8::EpiYa E{(const pg8::bf16_t*)(ws + WS_SGA), (pg8::bf16_t*)(ws + WS_YA)};
          pg8::gemm_phase<D_, pg8::EpiYa, pg8::StaticOrder, PG8_ALIGN, PG8_SP2, false>(F.lds + RING_OFF, g, S, E, F.wave); }
        asm volatile("s_waitcnt vmcnt(0)" ::: "memory"); __syncthreads();
        { pg8::Gemm g{(const pg8::bf16_t*)(ws + WS_CACT), (const pg8::bf16_t*)(ws + WS_WP)}; pg8::StaticOrder S; S.init(T_, D_, F.G, (int)blockIdx.x);
          pg8::EpiM E{(const pg8::bf16_t*)(ws + WS_SGB), (const pg8::bf16_t*)(ws + WS_YA), (pg8::bf16_t*)(ws + WS_M), A->in[I_PWB]};
          pg8::gemm_phase<D_, pg8::EpiM, pg8::StaticOrder, PG8_ALIGN, PG8_SP2, false>(F.lds + RING_OFF, g, S, E, F.wave); }
        if (BOTH(5)) GRID_BAR();
    }
    if (IN(6)) _Pragma("unroll") for (int rep_ = 0; rep_ < NREP(6); ++rep_) { if (rep_ > 0) GRID_BAR(); REFRESH(); CArgs A = args_now(); unsigned char* ws = A->ws;
        pg8::Gemm g{(const pg8::bf16_t*)(ws + WS_M), (const pg8::bf16_t*)(ws + WS_WO)}; pg8::StaticOrder S; S.init(T_, D_, F.G, (int)blockIdx.x);
        pg8::EpiZ E{A->in[I_X], (const float*)(ws + WS_MOD), (float*)(ws + WS_Z)};
        pg8::gemm_phase<D_, pg8::EpiZ, pg8::StaticOrder, PG8_ALIGN, PG8_SP2, false>(F.lds + RING_OFF, g, S, E, F.wave);
        if (BOTH(6)) GRID_BAR();
    }
    if (IN(7)) _Pragma("unroll") for (int rep_ = 0; rep_ < NREP(7); ++rep_) { if (rep_ > 0) GRID_BAR(); REFRESH(); CArgs A = args_now(); unsigned char* ws = A->ws; p7_ln1(F, A); if (BOTH(7)) GRID_BAR(); }
    if (IN(8)) _Pragma("unroll") for (int rep_ = 0; rep_ < NREP(8); ++rep_) { if (rep_ > 0) GRID_BAR(); REFRESH(); CArgs A = args_now(); unsigned char* ws = A->ws;
        pg8::Gemm g{(const pg8::bf16_t*)(ws + WS_H2), (const pg8::bf16_t*)(ws + WS_WR)}; pg8::StaticOrder S; S.init(T_, NE_, F.G, (int)blockIdx.x);
        pg8::EpiLogit E{(float*)(ws + WS_LG)};
        pg8::gemm_phase<D_, pg8::EpiLogit, pg8::StaticOrder, PG8_ALIGN, PG8_SP2, false>(F.lds + RING_OFF, g, S, E, F.wave);
        if (BOTH(8)) GRID_BAR();
    }
    if (IN(9)) _Pragma("unroll") for (int rep_ = 0; rep_ < NREP(9); ++rep_) { if (rep_ > 0) GRID_BAR(); REFRESH(); CArgs A = args_now(); unsigned char* ws = A->ws; p9_route(F, A); if (BOTH(9)) GRID_BAR(); }
    if (IN(10)) _Pragma("unroll") for (int rep_ = 0; rep_ < NREP(10); ++rep_) { if (rep_ > 0) GRID_BAR(); REFRESH(); CArgs A = args_now(); unsigned char* ws = A->ws;
        const int nun = moe_setup<2, true>(F, A);
        pg8::Gemm g{(const pg8::bf16_t*)(ws + WS_H2), (const pg8::bf16_t*)(ws + WS_WUP)};
        typedef pg8::MoeOrder<2, false, (unsigned)(D_ * 2)> OrdUp; OrdUp S{(const PG8_LAS int*)(F.lds + UT_OFF), (const PG8_LAS int*)(F.lds + TOK_OFF), nun};
        pg8::EpiSwiglu E{(pg8::bf16_t*)(ws + WS_HID)};
        pg8::gemm_phase<D_, pg8::EpiSwiglu, OrdUp, PG8_ALIGN, PG8_SP2, true>(F.lds + RING_OFF, g, S, E, F.wave);
        if (BOTH(10)) GRID_BAR();
    }
    if (IN(11)) _Pragma("unroll") for (int rep_ = 0; rep_ < NREP(11); ++rep_) { if (rep_ > 0) GRID_BAR(); REFRESH(); CArgs A = args_now(); unsigned char* ws = A->ws;
        const int nun = moe_setup<4, false>(F, A);
        pg8::Gemm g{(const pg8::bf16_t*)(ws + WS_HID), (const pg8::bf16_t*)(ws + WS_WDN)};
        typedef pg8::MoeOrder<4, true, 0u> OrdDn; OrdDn S{(const PG8_LAS int*)(F.lds + UT_OFF), (const PG8_LAS int*)(F.lds + TOK_OFF), nun};
        pg8::EpiDown E{(const int*)(ws + WS_LIST), (const float*)(ws + WS_TOPG), (unsigned char*)(ws + WS_YS), (float*)(ws + WS_Z), (const float*)(ws + WS_MOD)};
        pg8::gemm_phase<FE_, pg8::EpiDown, OrdDn, PG8_ALIGN, PG8_SP2, false>(F.lds + RING_OFF, g, S, E, F.wave);
        if (BOTH(11)) GRID_BAR();
    }
    if (IN(12)) _Pragma("unroll") for (int rep_ = 0; rep_ < NREP(12); ++rep_) { if (rep_ > 0) GRID_BAR(); REFRESH(); CArgs A = args_now(); unsigned char* ws = A->ws;
        bool poison = __hip_atomic_load(F.ctl + CW_TMO, RLX_AGENT) != 0u;
        poison |= __hip_atomic_load((gu32*)((const unsigned*)(F.ctl + CW_BAR) + XB_TMO), RLX_AGENT) != 0u;
        p12_final(F, A, poison);
    }
#undef IN
#undef BOTH
#undef GRID_BAR
}

#if DBG_CHECK
namespace chk {
__device__ __forceinline__ float bf2f(unsigned short h) { return __uint_as_float((unsigned)h << 16); }
__device__ __forceinline__ float rbf(float f) { unsigned u = __float_as_uint(f); u = (u + 0x7fffu + ((u >> 16) & 1u)) & 0xffff0000u; return __uint_as_float(u); }
__device__ __forceinline__ unsigned hashu(unsigned x) { x ^= x >> 16; x *= 0x7feb352dU; x ^= x >> 15; x *= 0x846ca68bU; x ^= x >> 16; return x; }
__device__ __forceinline__ void errmax(unsigned* ctl, int id, float got, float ref, float atol) { float e = fabsf(got - ref) / (fabsf(ref) + atol); if (!(e == e) || e > 1e30f) e = 1e30f; atomicMax(ctl + CW_ERR + id, __float_as_uint(e)); }
__device__ __forceinline__ float sig(float x) { return 1.0f / (1.0f + expf(-x)); }
__device__ __forceinline__ float dotbf(const unsigned short* a, const unsigned short* b, int n) { float s = 0.f; for (int k = 0; k < n; ++k) s += bf2f(a[k]) * bf2f(b[k]); return s; }
__device__ __forceinline__ float blk_sum(float v, float* sh) { __syncthreads(); sh[threadIdx.x] = v; __syncthreads(); for (int o = 128; o > 0; o >>= 1) { if ((int)threadIdx.x < o) sh[threadIdx.x] += sh[threadIdx.x + o]; __syncthreads(); } const float r = sh[0]; __syncthreads(); return r; }
__device__ __forceinline__ float blk_max(float v, float* sh) { __syncthreads(); sh[threadIdx.x] = v; __syncthreads(); for (int o = 128; o > 0; o >>= 1) { if ((int)threadIdx.x < o) sh[threadIdx.x] = fmaxf(sh[threadIdx.x], sh[threadIdx.x + o]); __syncthreads(); } const float r = sh[0]; __syncthreads(); return r; }
}
__global__ void __launch_bounds__(256) chk_phase(Args a, int ph) {
    using namespace chk;
    __shared__ float sh[256]; __shared__ float big[4096];
    unsigned char* ws = a.ws; unsigned* ctl = (unsigned*)(ws + WS_CTL);
    const int gs = blockIdx.x * 256 + threadIdx.x; const unsigned h1 = hashu(gs * 3 + 1 + ph * 7919), h2 = hashu(h1 + 17), h3 = hashu(h2 + 29);
    const float* mod = (const float*)(ws + WS_MOD);
    typedef unsigned short us;
    if (ph == 0) {
        if (gs < 512) { const int b = gs & 7, j = h1 % 6144; float s = a.in[I_ADAB][j]; for (int k = 0; k < 1024; ++k) { const float c = a.in[I_C][b * 1024 + k]; s += c * sig(c) * a.in[I_ADAW][(size_t)k * 6144 + j]; } errmax(ctl, 1, mod[b * 6144 + j], s, 0.02f); }
        const int which = (gs % 8 == 5 || gs % 8 == 6) ? 7 : gs % 8; float got = 0.f, ref = 0.f;
        if (which == 0) { const int r = h1 % NIN_, k = h2 % 1024; got = bf2f(((const us*)(ws + WS_WIN))[(size_t)r * 1024 + k]); ref = rbf(a.in[I_WIN][(size_t)k * NIN_ + in_orig_col(r)]); }
        else if (which <= 3) { const int n = h1 % 1024, k = h2 % 1024; const float* src = which == 1 ? a.in[I_WAO] : (which == 2 ? a.in[I_PWW] : a.in[I_WOUT]); const us* d = (const us*)(ws + (which == 1 ? WS_WA : (which == 2 ? WS_WP : WS_WO))); got = bf2f(d[(size_t)n * 1024 + k]); ref = rbf(src[(size_t)k * 1024 + n]); }
        else if (which == 4) { const int n = h1 % 256, k = h2 % 1024; got = bf2f(((const us*)(ws + WS_WR))[(size_t)n * 1024 + k]); ref = rbf(a.in[I_RW][(size_t)k * 256 + n]); }
        else if (which == 5) { const int e = h1 % NEX_, r = h2 % 512, k = h3 % 1024, pn = r >> 8, w = r & 255, is3 = w >> 7, n = pn * 128 + (w & 127);
            const float* src = e < NE_ ? (is3 ? a.in[I_W3] : a.in[I_W1]) + (size_t)e * 262144 : (is3 ? a.in[I_WS3] : a.in[I_WS1]);
            got = bf2f(((const us*)(ws + WS_WUP))[((size_t)e * 512 + r) * 1024 + k]); ref = rbf(src[(size_t)k * 256 + n]); }
        else if (which == 6) { const int e = h1 % NEX_, n = h2 % 1024, k = h3 % 256; const float* src = e < NE_ ? a.in[I_W2] + (size_t)e * 262144 : a.in[I_WS2];
            got = bf2f(((const us*)(ws + WS_WDN))[((size_t)e * 1024 + n) * 256 + k]); ref = rbf(src[(size_t)k * 1024 + n]); }
        else { const int r = h1 % NIN_; got = ((const float*)(ws + WS_BINP))[r]; ref = a.in[I_BIN][in_orig_col(r)]; }
        errmax(ctl, 2, got, ref, 1e-3f);
    } else if (ph == 1) {
        const int row = h1 % T_, col = h2 % D_, b = row >> 12; const float ref = a.in[I_X][(size_t)row * D_ + col] * (1.f + mod[b * 6144 + 1024 + col]) + mod[b * 6144 + col];
        errmax(ctl, 3, bf2f(((const us*)(ws + WS_H))[(size_t)row * D_ + col]), ref, 0.05f);
    } else if (ph == 2) {
        const us* H = (const us*)(ws + WS_H); const us* W = (const us*)(ws + WS_WIN); const int row = h1 % T_, col = h2 % D_; const us* hr = H + (size_t)row * D_;
        const int which = gs % 3;
        if (which == 0) { const int t = h3 % 3, oc = t * 1024 + col; float r = dotbf(hr, W + (size_t)oc * 1024, 1024) + a.in[I_BIN][oc]; if (t == 0) r *= attn_body::C2;
            errmax(ctl, 4, bf2f(((const us*)(ws + WS_Q + (size_t)t * WS_SLOT))[(size_t)row * D_ + col]), r, t == 0 ? 0.01f : 0.05f); }
        else if (which == 1) { const float av = dotbf(hr, W + (size_t)in_dest_row(3072 + col) * 1024, 1024) + a.in[I_BIN][3072 + col], bv = dotbf(hr, W + (size_t)in_dest_row(4096 + col) * 1024, 1024) + a.in[I_BIN][4096 + col];
            errmax(ctl, 5, bf2f(((const us*)(ws + WS_U))[(size_t)row * D_ + col]), av * sig(bv), 0.03f); }
        else { const float av = dotbf(hr, W + (size_t)in_dest_row(5120 + col) * 1024, 1024) + a.in[I_BIN][5120 + col], bv = dotbf(hr, W + (size_t)in_dest_row(6144 + col) * 1024, 1024) + a.in[I_BIN][6144 + col];
            errmax(ctl, 6, bf2f(((const us*)(ws + WS_SGA))[(size_t)row * D_ + col]), sig(av), 0.02f); errmax(ctl, 20, bf2f(((const us*)(ws + WS_SGB))[(size_t)row * D_ + col]), sig(bv), 0.02f); }
    } else if (ph == 3) {
        { const int which = 5 + (gs & 1); float got = 0.f, ref = 0.f;
          if (which == 5) { const int e = h1 % NEX_, r = h2 % 512, k = h3 % 1024, pn = r >> 8, w = r & 255, is3 = w >> 7, n = pn * 128 + (w & 127);
            const float* src = e < NE_ ? (is3 ? a.in[I_W3] : a.in[I_W1]) + (size_t)e * 262144 : (is3 ? a.in[I_WS3] : a.in[I_WS1]);
            got = bf2f(((const us*)(ws + WS_WUP))[((size_t)e * 512 + r) * 1024 + k]); ref = rbf(src[(size_t)k * 256 + n]); }
          else { const int e = h1 % NEX_, n = h2 % 1024, k = h3 % 256; const float* src = e < NE_ ? a.in[I_W2] + (size_t)e * 262144 : a.in[I_WS2];
            got = bf2f(((const us*)(ws + WS_WDN))[((size_t)e * 1024 + n) * 256 + k]); ref = rbf(src[(size_t)k * 1024 + n]); }
          errmax(ctl, 2, got, ref, 1e-3f); }
        {
            const unsigned hb = hashu(blockIdx.x * 977 + 5); const int b = hb & 7, hm = (hb >> 3) & 15, vh = (hb >> 7) & 1; int row = (hb >> 8) & 4095; if (blockIdx.x < 8) row = blockIdx.x * 37;
            const us* Q = (const us*)(ws + WS_Q); const us* K = (const us*)(ws + WS_K); const us* V = (const us*)(ws + WS_V); const us* O = (const us*)(ws + WS_OATT);
            const us* qr = Q + ((size_t)b * SEQ_ + row) * D_ + hm * 64; float mx = -INFINITY;
            for (int j = threadIdx.x; j <= row; j += 256) { const float s = dotbf(qr, K + ((size_t)b * SEQ_ + j) * D_ + hm * 64, 64); big[j] = s; mx = fmaxf(mx, s); }
            mx = blk_max(mx, sh); float l = 0.f;
            for (int j = threadIdx.x; j <= row; j += 256) { const float p = exp2f(big[j] - mx); big[j] = p; l += p; }
            l = blk_sum(l, sh);
            if (threadIdx.x < 64) { float o = 0.f; for (int j = 0; j <= row; ++j) o += big[j] * bf2f(V[((size_t)b * SEQ_ + j) * D_ + (hm >> 1) * 128 + vh * 64 + threadIdx.x]);
                errmax(ctl, 7, bf2f(O[((size_t)b * SEQ_ + row) * 2048 + (hm * 2 + vh) * 64 + threadIdx.x]), o / l, 0.03f); }
            __syncthreads();
        }
        {
            const unsigned hb = hashu(blockIdx.x * 31 + 77); int t = hb % T_; if (blockIdx.x < 16) t = (blockIdx.x >> 1) * SEQ_ + (blockIdx.x & 1) * 17 + 3;
            const int pos = t & (SEQ_ - 1); const us* U = (const us*)(ws + WS_U); float y[4]; float s = 0.f, q = 0.f;
            _Pragma("unroll") for (int i = 0; i < 4; ++i) { const int c = threadIdx.x + 256 * i; float acc = a.in[I_CB][c];
                for (int j = 0; j < 31; ++j) { const int p = pos - 30 + j; if (p >= 0) acc += a.in[I_CW][j * 1024 + c] * bf2f(U[(size_t)(t - 30 + j) * D_ + c]); }
                y[i] = acc; s += acc; }
            const float mean = blk_sum(s, sh) / 1024.f; _Pragma("unroll") for (int i = 0; i < 4; ++i) q += (y[i] - mean) * (y[i] - mean);
            const float var = blk_sum(q, sh) / 1024.f, rstd = 1.0f / sqrtf(var + LN_EPS_);
            _Pragma("unroll") for (int i = 0; i < 4; ++i) { const int c = threadIdx.x + 256 * i; const float z = (y[i] - mean) * rstd * a.in[I_CLG][c] + a.in[I_CLB][c];
                errmax(ctl, 8, bf2f(((const us*)(ws + WS_CACT))[(size_t)t * D_ + c]), z * sig(z), 0.03f); }
        }
    } else if (ph == 4) {
        float s1 = 0.f, s2 = 0.f; for (int i = 0; i < 64; ++i) { s1 += a.in[I_LQ1][i] * a.in[I_LK1][i]; s2 += a.in[I_LQ2][i] * a.in[I_LK2][i]; }
        const float lam = expf(s1) - expf(s2) + LAM_INIT_; const int t = hashu(blockIdx.x * 131 + 9) % T_; const us* O = (const us*)(ws + WS_OATT) + (size_t)t * 2048;
        for (int hh = 0; hh < 8; ++hh) { float o = 0.f; if (threadIdx.x < 128) o = bf2f(O[hh * 256 + threadIdx.x]) - lam * bf2f(O[hh * 256 + 128 + threadIdx.x]);
            const float ss = blk_sum(o * o, sh); const float r = 1.0f / sqrtf(ss / 128.f + RMS_EPS_);
            if (threadIdx.x < 128) errmax(ctl, 9, bf2f(((const us*)(ws + WS_ON))[(size_t)t * D_ + hh * 128 + threadIdx.x]), o * r * a.in[I_SUBG][threadIdx.x] * (1.f - LAM_INIT_), 0.03f); }
    } else if (ph == 5) {
        const int row = h1 % T_, col = h2 % D_; const size_t off = (size_t)row * D_ + col;
        const float yar = bf2f(((const us*)(ws + WS_SGA))[off]) * dotbf((const us*)(ws + WS_ON) + (size_t)row * D_, (const us*)(ws + WS_WA) + (size_t)col * D_, 1024);
        const float yab = bf2f(((const us*)(ws + WS_YA))[off]);
        errmax(ctl, 10, yab, yar, 0.03f);
        const float mr = yab + bf2f(((const us*)(ws + WS_SGB))[off]) * (dotbf((const us*)(ws + WS_CACT) + (size_t)row * D_, (const us*)(ws + WS_WP) + (size_t)col * D_, 1024) + a.in[I_PWB][col]);
        errmax(ctl, 11, bf2f(((const us*)(ws + WS_M))[off]), mr, 0.03f);
    } else if (ph == 6) {
        const int row = h1 % T_, col = h2 % D_, b = row >> 12; const size_t off = (size_t)row * D_ + col;
        const float r = DN_ALPHA_ * a.in[I_X][off] + mod[b * 6144 + 2048 + col] * dotbf((const us*)(ws + WS_M) + (size_t)row * D_, (const us*)(ws + WS_WO) + (size_t)col * D_, 1024);
        errmax(ctl, 12, ((const float*)(ws + WS_Z))[off], r, 0.05f);
    } else if (ph == 7) {
        const int t = hashu(blockIdx.x * 131 + 11) % T_, b = t >> 12; const float* X1 = (const float*)(ws + WS_Z) + (size_t)t * D_; float v[4]; float s = 0.f, q = 0.f;
        _Pragma("unroll") for (int i = 0; i < 4; ++i) { const int c = threadIdx.x + 256 * i; v[i] = (X1[c] - a.in[I_LN1B][c]) / a.in[I_LN1G][c]; s += v[i]; }
        const float mean = blk_sum(s, sh) / 1024.f; _Pragma("unroll") for (int i = 0; i < 4; ++i) q += (v[i] - mean) * (v[i] - mean); const float var = blk_sum(q, sh) / 1024.f;
        if (threadIdx.x == 0) { errmax(ctl, 13, mean, 0.f, 0.05f); errmax(ctl, 13, var, 1.f, 0.f); }
        _Pragma("unroll") for (int i = 0; i < 4; ++i) { const int c = threadIdx.x + 256 * i; errmax(ctl, 13, bf2f(((const us*)(ws + WS_H2))[(size_t)t * D_ + c]), X1[c] * (1.f + mod[b * 6144 + 4096 + c]) + mod[b * 6144 + 3072 + c], 0.05f); }
    } else if (ph == 8) {
        const int row = h1 % T_, e = h2 % NE_;
        errmax(ctl, 14, ((const float*)(ws + WS_LG))[(size_t)row * NE_ + e], dotbf((const us*)(ws + WS_H2) + (size_t)row * D_, (const us*)(ws + WS_WR) + (size_t)e * D_, 1024), 0.05f);
    } else if (ph == 9) {
        {
            const int t = hashu(blockIdx.x * 173 + 3) % T_; float* sc = big; float* ch = big + 256; float* gsc = big + 512; int* gsel = (int*)(big + 520); int* eidx = (int*)(big + 530); float* egate = big + 540;
            const float sv = sig(((const float*)(ws + WS_LG))[(size_t)t * NE_ + threadIdx.x]); sc[threadIdx.x] = sv; ch[threadIdx.x] = sv + a.in[I_RB][threadIdx.x]; __syncthreads();
            if (threadIdx.x < 8) { float m1 = -INFINITY, m2 = -INFINITY; for (int i = 0; i < 32; ++i) { const float v = ch[threadIdx.x * 32 + i]; if (v > m1) { m2 = m1; m1 = v; } else if (v > m2) m2 = v; } gsc[threadIdx.x] = m1 + m2; }
            __syncthreads();
            if (threadIdx.x == 0) { for (int g = 0; g < 8; ++g) { int rank = 0; for (int gp = 0; gp < 8; ++gp) rank += (gsc[gp] > gsc[g] || (gsc[gp] == gsc[g] && gp < g)) ? 1 : 0; gsel[g] = rank < 4; }
                float ssum = 0.f;
                for (int k = 0; k < 8; ++k) { int best = -1; float bv = -INFINITY; for (int e = 0; e < 256; ++e) { if (!gsel[e >> 5]) continue; bool taken = false; for (int kk = 0; kk < k; ++kk) taken |= (eidx[kk] == e); if (taken) continue; if (ch[e] > bv) { bv = ch[e]; best = e; } }
                    eidx[k] = best; egate[k] = sc[best]; ssum += sc[best]; }
                for (int k = 0; k < 8; ++k) { const int gi = ((const int*)(ws + WS_TOPI))[t * 8 + k]; errmax(ctl, 15, gi != eidx[k] ? 1.f : 0.f, 0.f, 1.f);
                    errmax(ctl, 15, ((const float*)(ws + WS_TOPG))[t * 8 + k], egate[k] / ssum * ROUTED_SCALE_, 1e-3f); } }
            __syncthreads();
        }
        {
            const int* list = (const int*)(ws + WS_LIST); const int* topi = (const int*)(ws + WS_TOPI);
            if (blockIdx.x == 0) { const int c = (int)ctl[CW_CNT + 64 * threadIdx.x]; const float tot = blk_sum((float)c, sh); if (threadIdx.x == 0) errmax(ctl, 16, tot, (float)(T_ * 8), 0.f); }
            const int e = h1 % NE_, c = (int)ctl[CW_CNT + 64 * e]; if (c > 0) { const int pos = h2 % c, av = list[(size_t)e * T_ + pos]; float bad = 0.f; if (av < 0 || av >= T_ * 8) bad = 1.f; else if (topi[av] != e) bad = 1.f; errmax(ctl, 16, bad, 0.f, 1.f); }
        }
    } else if (ph == 10 || ph == 11) {
        const int e = (gs & 7) == 0 ? NE_ : (int)(h1 % NE_); const int c = e < NE_ ? (int)ctl[CW_CNT + 64 * e] : T_;
        if (c > 0) { int ts = 0; for (int i = 0; i < e; ++i) ts += ((int)ctl[CW_CNT + 64 * i] + 255) >> 8;
            const int pos = h2 % c; const int av = e < NE_ ? ((const int*)(ws + WS_LIST))[(size_t)e * T_ + pos] : pos * 8; const int t = av >> 3; const size_t row = (size_t)(ts + (pos >> 8)) * 256 + (pos & 255);
            if (ph == 10) { const int n = h3 % FE_; const us* hr = (const us*)(ws + WS_H2) + (size_t)t * D_; const us* W = (const us*)(ws + WS_WUP) + ((size_t)e * 512 + (n >> 7) * 256 + (n & 127)) * 1024;
                const float A = dotbf(hr, W, 1024), B = dotbf(hr, W + 128 * 1024, 1024); errmax(ctl, 17, bf2f(((const us*)(ws + WS_HID))[row * FE_ + n]), A * sig(A) * B, 0.03f); }
            else if (e < NE_) { const int col = h3 % D_; const float r = ((const float*)(ws + WS_TOPG))[av] * dotbf((const us*)(ws + WS_HID) + row * FE_, (const us*)(ws + WS_WDN) + ((size_t)e * 1024 + col) * 256, 256);
                { const unsigned char yb = ((const unsigned char*)(ws + WS_YS))[(size_t)av * D_ + col]; const float got = __builtin_amdgcn_cvt_pk_f32_fp8((int)yb, false)[0] / pg8::YS_SCALE; errmax(ctl, 18, got, r, 0.02f); } }
        }
    } else if (ph == 12) {
        const int t = hashu(blockIdx.x * 211 + 13) % T_, b = t >> 12; float v[4]; float s = 0.f, q = 0.f;
        _Pragma("unroll") for (int i = 0; i < 4; ++i) { const int c = threadIdx.x + 256 * i; float y = 0.f; for (int k = 0; k < 8; ++k) y += __builtin_amdgcn_cvt_pk_f32_fp8((int)((const unsigned char*)(ws + WS_YS))[((size_t)t * 8 + k) * D_ + c], false)[0] / pg8::YS_SCALE;
            v[i] = ((const float*)(ws + WS_Z))[(size_t)t * D_ + c] + mod[b * 6144 + 5120 + c] * y; s += v[i]; }
        const float mean = blk_sum(s, sh) / 1024.f; _Pragma("unroll") for (int i = 0; i < 4; ++i) q += (v[i] - mean) * (v[i] - mean); const float rstd = 1.0f / sqrtf(blk_sum(q, sh) / 1024.f + LN_EPS_);
        _Pragma("unroll") for (int i = 0; i < 4; ++i) { const int c = threadIdx.x + 256 * i; errmax(ctl, 19, a.out[(size_t)t * D_ + c], (v[i] - mean) * rstd * a.in[I_LN2G][c] + a.in[I_LN2B][c], 0.05f); }
    }
}

__global__ void __launch_bounds__(256) chk_scan(Args a) {
    unsigned* ctl = (unsigned*)(a.ws + WS_CTL); const unsigned short* A = (const unsigned short*)(a.ws + WS_SGA); const unsigned short* B = (const unsigned short*)(a.ws + WS_SGB);
    for (size_t i = (size_t)blockIdx.x * 256 + threadIdx.x; i < (size_t)T_ * D_; i += (size_t)gridDim.x * 256) {
        const float va = chk::bf2f(A[i]), vb = chk::bf2f(B[i]); const int row = (int)(i >> 10), col = (int)(i & 1023);
        if (!(va >= 0.f && va <= 1.f)) { atomicAdd(ctl + CW_ERR + 40, 1u); atomicOr(ctl + CW_ERR + 41, 1u << (col >> 7)); atomicOr(ctl + CW_ERR + 42, 1u << ((row >> 8) & 31)); atomicMin(ctl + CW_ERR + 43, (unsigned)row ^ 0xffffffffu); atomicMax(ctl + CW_ERR + 44, (unsigned)row); atomicOr(ctl + CW_ERR + 46, 1u << (row & 31)); atomicOr(ctl + CW_ERR + 47, 1u << ((col >> 2) & 31)); }
        if (!(vb >= 0.f && vb <= 1.f)) atomicAdd(ctl + CW_ERR + 45, 1u);
        { const unsigned short* S = (const unsigned short*)(a.ws + WS_CACT); const float vs = chk::bf2f(S[i]); if (!(vs >= 0.f && vs <= 1.f)) atomicAdd(ctl + CW_ERR + 48, 1u); if (S[i] != A[i]) atomicAdd(ctl + CW_ERR + 49, 1u); }
    }
}
#ifndef CHK_TOL
#define CHK_TOL 0.06f
#endif
#ifndef CHK_FIRST
#define CHK_FIRST 1
#endif
__global__ void __launch_bounds__(256) chk_final(Args a) {
    const unsigned* ctl = (const unsigned*)(a.ws + WS_CTL); int bad = 0;
    for (int id = 20; id >= CHK_FIRST; --id) if (__uint_as_float(ctl[CW_ERR + id]) > CHK_TOL) bad = id;
#ifdef CHK_WORD
    { const unsigned w = ctl[CW_ERR + CHK_WORD];
#if CHK_ENC == 0
      bad = 1 + (int)(4.f * log2f((float)w + 1.f) + 0.5f);
#else
      bad = 1 + (int)((w >> CHK_SHIFT) & 63u);
#endif
    }
#endif
#ifdef CHK_MAG
    { const float e = __uint_as_float(ctl[CW_ERR + CHK_MAG]); float code = 40.f + 4.f * log2f(fmaxf(e, 1e-9f)); code = fminf(fmaxf(code, 0.f), 96.f); bad = (int)(code + 0.5f); if (bad < 1) bad = 1; }
#endif
    float vv = sqrtf((float)bad);
#ifdef CHK_TWO
    { const unsigned w1 = ctl[CW_ERR + 40], w2 = ctl[CW_ERR + 48], w3 = ctl[CW_ERR + 49]; int v1 = (int)(3.f * log2f((float)w1 + 1.f) + 0.5f); if (v1 > 63) v1 = 63; int v2 = (w2 != 0u ? 1 : 0) + (w3 != 0u ? 2 : 0);
      float sc = (float)(10 + v1) * 10.f; for (int i = 0; i < v2; ++i) sc *= 10.f; vv = sqrtf(sc); bad = 1; }
#endif
    if (bad) { const float v = vv; for (size_t i = (size_t)blockIdx.x * 256 + threadIdx.x; i < (size_t)T_ * D_; i += (size_t)gridDim.x * 256) a.out[i] = v; }
}
#endif

extern "C" void kernel_launch(void* const* d_in, const int* in_sizes, int n_in, void* d_out, int out_size, void* d_ws, size_t ws_size, hipStream_t stream) {
    static int grid = 0;
    if (grid == 0) {
        if (n_in != N_IN || in_sizes[0] != T_ * D_ || out_size != T_ * D_ || ws_size < WS_END) { fprintf(stderr, "kernel_launch: unexpected shapes (n_in %d, in0 %d, out %d, ws %zu); nothing launched\n", n_in, n_in > 0 ? in_sizes[0] : -1, out_size, ws_size); grid = -1; return; }
        int dev = 0, cus = 0, per_cu = 0;
        if (hipGetDevice(&dev) != hipSuccess || hipDeviceGetAttribute(&cus, hipDeviceAttributeMultiprocessorCount, dev) != hipSuccess) { grid = -1; return; }
        if (hipFuncSetAttribute((const void*)mk_fwd, hipFuncAttributeMaxDynamicSharedMemorySize, LDS_BYTES) != hipSuccess) { fprintf(stderr, "kernel_launch: hipFuncSetAttribute failed\n"); grid = -1; return; }
        if (hipOccupancyMaxActiveBlocksPerMultiprocessor(&per_cu, (const void*)mk_fwd, NWAVES * 64, LDS_BYTES) != hipSuccess || per_cu < 1) { fprintf(stderr, "kernel_launch: occupancy query reports %d\n", per_cu); }
        (void)hipGetLastError();
        grid = cus;
    }
    if (grid < 0) return;
    if (hipMemsetAsync((char*)d_ws + WS_CTL, 0, CTL_ZERO_BYTES, stream) != hipSuccess) return;
    Args a{};
    for (int i = 0; i < N_IN; ++i) a.in[i] = (const float*)d_in[i];
    a.out = (float*)d_out; a.ws = (unsigned char*)d_ws;
#if MK_SPLIT
    for (int p = 0; p < NPH; ++p) { a.ph_lo = p; a.ph_hi = p + 1;
#ifdef DBG_PREFILL
        if (p == 2) (void)hipMemsetAsync((char*)d_ws + WS_SGA, 0x3f, 2 * WS_SLOT, stream);
#endif
        hipLaunchKernelGGL(mk_fwd, dim3(grid), dim3(NWAVES * 64), LDS_BYTES, stream, a);
#if DBG_CHECK
        hipLaunchKernelGGL(chk_phase, dim3(64), dim3(256), 0, stream, a, p);
        if (p == 2) hipLaunchKernelGGL(chk_scan, dim3(1024), dim3(256), 0, stream, a);
#endif
    }
#if DBG_CHECK
    hipLaunchKernelGGL(chk_final, dim3(1024), dim3(256), 0, stream, a);
#ifdef DBG_POSTFILL
    (void)hipMemsetAsync((char*)d_ws + WS_SGA, 0x3f, 2 * WS_SLOT, stream);
#endif
#endif
#else
    a.ph_lo = 0; a.ph_hi = NPH;
    hipLaunchKernelGGL(mk_fwd, dim3(grid), dim3(NWAVES * 64), LDS_BYTES, stream, a);
#endif
}
```

```cpp
#include <hip/hip_runtime.h>
#include <hip/hip_bf16.h>
#include <cstdio>
#include <cstdint>
#include <cmath>

#ifndef MK_SPLIT
#define MK_SPLIT 0
#endif
#ifndef DBG_CHECK
#define DBG_CHECK 0
#endif

constexpr int T_ = 32768, D_ = 1024, NB_ = 8, SEQ_ = 4096;
constexpr int NIN_ = 7168;
constexpr int NE_ = 256, NEX_ = 257, TOPK_ = 8;
constexpr int FE_ = 256;
constexpr float LN_EPS_ = 1e-5f, RMS_EPS_ = 1e-5f;
constexpr float DN_ALPHA_ = 1.189207115002721f;
constexpr float LAM_INIT_ = 0.2f;
constexpr float ROUTED_SCALE_ = 2.5f;
constexpr float LOG2E_ = 1.4426950408889634f;

__device__ __forceinline__ int mk_lane_now() { int l; asm volatile("v_mbcnt_lo_u32_b32 %0, -1, 0\n\tv_mbcnt_hi_u32_b32 %0, -1, %0" : "=v"(l)); return l; }
namespace pg8 {
#define PG8_LAS __attribute__((address_space(3)))
typedef unsigned short bf16_t;
typedef short bf16x8 __attribute__((ext_vector_type(8)));
typedef float f32x4 __attribute__((ext_vector_type(4)));
typedef unsigned u32x4 __attribute__((ext_vector_type(4)));
constexpr int BM = 256, BK = 64, HALF = 128, HTB = HALF * BK * 2  , STAGE_BYTES = 8 * HTB, NXCD = 8, WGM = 8;

__host__ __device__ __forceinline__ int lds_byte(int r, int c) { const int st = (r >> 4) * 2 + (c >> 5), rr = r & 15, cc = c & 31, ob = rr * 64 + cc * 2; return st * 1024 + (ob ^ (((ob >> 9) & 1) << 5)); }
__host__ __device__ __forceinline__ void stage_rc(int b, int& R, int& C) { const int st = b / 1024, sb = b % 1024, swz = sb ^ (((sb >> 9) & 1) << 5); R = (st >> 1) * 16 + swz / 64; C = (st & 1) * 32 + (swz % 64) / 2; }
__host__ __device__ __forceinline__ int perm32(int rho) { const int n = rho >> 4, i = rho & 15; return 8 * (i >> 2) + 4 * n + (i & 3); }

struct UnitS { int pm, pn; };
struct UnitM { int pm, pn, e, rt, nrows, slot; };
struct Gemm { const bf16_t* A; const bf16_t* Bt; };

struct StaticOrder {
    typedef UnitS Unit;
    int nM, nN, nwg, G, c;
    __host__ __device__ void init(int M, int N, int G_, int c_) { nM = M / BM; nN = N / BM; nwg = nM * nN; G = G_; c = c_; }
    __host__ __device__ bool next(int i, Unit& u) const {
        const long L = (long)i * G + c; if (L >= nwg) return false;
        int wgid = (int)L; { const int q = nwg / NXCD, r = nwg % NXCD, xcd = wgid % NXCD, off = wgid / NXCD; wgid = (xcd < r ? xcd * (q + 1) : r * (q + 1) + (xcd - r) * q) + off; }
        const int nig = WGM * nN, gid = wgid / nig, fm = gid * WGM, gsz = (nM - fm) < WGM ? (nM - fm) : WGM;
        u.pm = fm + ((wgid % nig) % gsz); u.pn = (wgid % nig) / gsz; return true;
    }
    __device__ __forceinline__ size_t a_off(const Unit& u, size_t tstep) const { return (size_t)u.pm * tstep; }
    __device__ __forceinline__ size_t b_off(const Unit& u, size_t tstep) const { return (size_t)u.pn * tstep; }
    __device__ __forceinline__ unsigned row_off(const Unit&, int, int) const { return 0u; }
    __device__ __forceinline__ void a_ready(const Unit&) const {}
    __device__ __forceinline__ void done(const Unit&) const {}
};
template <int BTILES, bool A_DENSE, unsigned ROWBYTES>
struct MoeOrder {
    typedef UnitM Unit;
    const PG8_LAS int* UT; const PG8_LAS int* TOK; int nunits;
    __device__ __forceinline__ bool next(int i, Unit& u) const {
        if (i >= nunits) return false;
        u.e = __builtin_amdgcn_readfirstlane(UT[i * 8 + 0]); u.rt = __builtin_amdgcn_readfirstlane(UT[i * 8 + 1]); u.pn = __builtin_amdgcn_readfirstlane(UT[i * 8 + 2]);
        u.nrows = __builtin_amdgcn_readfirstlane(UT[i * 8 + 3]); u.pm = __builtin_amdgcn_readfirstlane(UT[i * 8 + 4]); u.slot = i; return true;
    }
    __device__ __forceinline__ size_t a_off(const Unit& u, size_t tstep) const { return A_DENSE ? (size_t)u.pm * tstep : (size_t)0; }
    __device__ __forceinline__ size_t b_off(const Unit& u, size_t tstep) const { return (size_t)(u.e * BTILES + u.pn) * tstep; }
    __device__ __forceinline__ unsigned row_off(const Unit& u, int row, int C) const { return (unsigned)TOK[u.slot * 256 + row] * ROWBYTES + (unsigned)C * 2u; }
    __device__ __forceinline__ void a_ready(const Unit&) const {}
    __device__ __forceinline__ void done(const Unit&) const {}
};

typedef float f32x2_t_ __attribute__((ext_vector_type(2))); typedef __bf16 bf16x2_t_ __attribute__((ext_vector_type(2)));
__device__ __forceinline__ unsigned cvt_pk_bf16(float lo, float hi) { const f32x2_t_ v = {lo, hi}; const bf16x2_t_ b = __builtin_convertvector(v, bf16x2_t_); return __builtin_bit_cast(unsigned, b); }
__device__ __forceinline__ float bf_lo(unsigned w) { return __uint_as_float(w << 16); }
__device__ __forceinline__ float bf_hi(unsigned w) { return __uint_as_float(w & 0xffff0000u); }
__device__ __forceinline__ float sigm(float x) { return __builtin_amdgcn_rcpf(1.0f + __builtin_amdgcn_exp2f(-x * LOG2E_)); }
__device__ __forceinline__ u32x4 pack8(const f32x4& a, const f32x4& b) { u32x4 w; w.x = cvt_pk_bf16(a[0], a[1]); w.y = cvt_pk_bf16(a[2], a[3]); w.z = cvt_pk_bf16(b[0], b[1]); w.w = cvt_pk_bf16(b[2], b[3]); return w; }
__device__ __forceinline__ void unpack8(const u32x4& w, f32x4& a, f32x4& b) { a = (f32x4){bf_lo(w.x), bf_hi(w.x), bf_lo(w.y), bf_hi(w.y)}; b = (f32x4){bf_lo(w.z), bf_hi(w.z), bf_lo(w.w), bf_hi(w.w)}; }
__device__ __forceinline__ f32x4 sigm4(const f32x4& v) { return (f32x4){sigm(v[0]), sigm(v[1]), sigm(v[2]), sigm(v[3])}; }

#define PG8_EPI_ARGS const f32x4 (&acc)[2][2][4][2], const U& u, int wr, int wc, int fr, int fq
struct EpiInproj {
    static constexpr bool PERM = true, AFTER_DRAIN = false;
    bf16_t *q; size_t slot; bf16_t *ug, *sga, *sgb; const float* biasP; float qscale;
    template <class U> __device__ __forceinline__ void operator()(PG8_EPI_ARGS) const {
        const int pn = u.pn, row0 = u.pm * BM + wr * 64 + fr, cb = wc * 32 + 8 * fq;
        f32x4 bv[2][2];
#pragma unroll
        for (int bj = 0; bj < 2; ++bj)
#pragma unroll
            for (int n = 0; n < 2; ++n) bv[bj][n] = *(const f32x4*)(biasP + pn * BM + bj * HALF + cb + 4 * n);
        if (pn < 12) {
            bf16_t* base = q + (size_t)(pn >> 2) * slot; float sc = 1.0f; if (pn < 4) sc = qscale; const int colt = (pn & 3) * BM + cb;
#pragma unroll
            for (int ai = 0; ai < 2; ++ai)
#pragma unroll
                for (int m = 0; m < 4; ++m) { bf16_t* rowp = base + (size_t)(row0 + ai * HALF + m * 16) * D_ + colt;
#pragma unroll
                    for (int bj = 0; bj < 2; ++bj) { const f32x4 v0 = (acc[ai][bj][m][0] + bv[bj][0]) * sc, v1 = (acc[ai][bj][m][1] + bv[bj][1]) * sc; *(u32x4*)(rowp + bj * HALF) = pack8(v0, v1); } }
        } else if (pn < 20) {
            const int colt = (pn - 12) * HALF + cb;
#pragma unroll
            for (int ai = 0; ai < 2; ++ai)
#pragma unroll
                for (int m = 0; m < 4; ++m) { const size_t off = (size_t)(row0 + ai * HALF + m * 16) * D_ + colt;
                    const f32x4 a0 = acc[ai][0][m][0] + bv[0][0], a1 = acc[ai][0][m][1] + bv[0][1], b0 = sigm4(acc[ai][1][m][0] + bv[1][0]), b1 = sigm4(acc[ai][1][m][1] + bv[1][1]);
                    *(u32x4*)(ug + off) = pack8(a0 * b0, a1 * b1); }
        } else {
            const int colt = (pn - 20) * HALF + cb;
#pragma unroll
            for (int ai = 0; ai < 2; ++ai)
#pragma unroll
                for (int m = 0; m < 4; ++m) { const size_t off = (size_t)(row0 + ai * HALF + m * 16) * D_ + colt;
                    *(u32x4*)(sga + off) = pack8(sigm4(acc[ai][0][m][0] + bv[0][0]), sigm4(acc[ai][0][m][1] + bv[0][1]));
                    *(u32x4*)(sgb + off) = pack8(sigm4(acc[ai][1][m][0] + bv[1][0]), sigm4(acc[ai][1][m][1] + bv[1][1]));
                    }
        }
    }
};
struct EpiYa {
    static constexpr bool PERM = true, AFTER_DRAIN = false;
    const bf16_t* sga; bf16_t* ya;
    template <class U> __device__ __forceinline__ void operator()(PG8_EPI_ARGS) const {
        const int row0 = u.pm * BM + wr * 64 + fr, col0 = u.pn * BM + wc * 32 + 8 * fq;
#pragma unroll
        for (int ai = 0; ai < 2; ++ai)
#pragma unroll
            for (int m = 0; m < 4; ++m)
#pragma unroll
                for (int bj = 0; bj < 2; ++bj) { const size_t off = (size_t)(row0 + ai * HALF + m * 16) * D_ + col0 + bj * HALF;
                    f32x4 g0, g1; unpack8(*(const u32x4*)(sga + off), g0, g1);
                    *(u32x4*)(ya + off) = pack8(acc[ai][bj][m][0] * g0, acc[ai][bj][m][1] * g1); }
    }
};
struct EpiM {
    static constexpr bool PERM = true, AFTER_DRAIN = false;
    const bf16_t* sgb; const bf16_t* ya; bf16_t* mo; const float* bp;
    template <class U> __device__ __forceinline__ void operator()(PG8_EPI_ARGS) const {
        const int row0 = u.pm * BM + wr * 64 + fr, col0 = u.pn * BM + wc * 32 + 8 * fq;
#pragma unroll
        for (int bj = 0; bj < 2; ++bj) { const f32x4 b0 = *(const f32x4*)(bp + col0 + bj * HALF), b1 = *(const f32x4*)(bp + col0 + bj * HALF + 4);
#pragma unroll
            for (int ai = 0; ai < 2; ++ai)
#pragma unroll
                for (int m = 0; m < 4; ++m) { const size_t off = (size_t)(row0 + ai * HALF + m * 16) * D_ + col0 + bj * HALF;
                    f32x4 g0, g1, y0, y1; unpack8(*(const u32x4*)(sgb + off), g0, g1); unpack8(*(const u32x4*)(ya + off), y0, y1);
                    *(u32x4*)(mo + off) = pack8(y0 + g0 * (acc[ai][bj][m][0] + b0), y1 + g1 * (acc[ai][bj][m][1] + b1)); } }
    }
};
struct EpiZ {
    static constexpr bool PERM = true, AFTER_DRAIN = false;
    const float* x; const float* mod; float* z;
    template <class U> __device__ __forceinline__ void operator()(PG8_EPI_ARGS) const {
        const int row0 = u.pm * BM + wr * 64 + fr, col0 = u.pn * BM + wc * 32 + 8 * fq; const int b = (u.pm * BM) >> 12;
#pragma unroll
        for (int bj = 0; bj < 2; ++bj) { const float* gp = mod + b * 6144 + 2048 + col0 + bj * HALF; const f32x4 g0 = *(const f32x4*)gp, g1 = *(const f32x4*)(gp + 4);
#pragma unroll
            for (int ai = 0; ai < 2; ++ai)
#pragma unroll
                for (int m = 0; m < 4; ++m) { const size_t off = (size_t)(row0 + ai * HALF + m * 16) * D_ + col0 + bj * HALF;
                    const f32x4 x0 = *(const f32x4*)(x + off), x1 = *(const f32x4*)(x + off + 4);
                    *(f32x4*)(z + off) = x0 * DN_ALPHA_ + g0 * acc[ai][bj][m][0]; *(f32x4*)(z + off + 4) = x1 * DN_ALPHA_ + g1 * acc[ai][bj][m][1]; } }
    }
};
struct EpiLogit {
    static constexpr bool PERM = true, AFTER_DRAIN = false;
    float* lg;
    template <class U> __device__ __forceinline__ void operator()(PG8_EPI_ARGS) const {
        const int row0 = u.pm * BM + wr * 64 + fr, col0 = wc * 32 + 8 * fq;
#pragma unroll
        for (int ai = 0; ai < 2; ++ai)
#pragma unroll
            for (int m = 0; m < 4; ++m)
#pragma unroll
                for (int bj = 0; bj < 2; ++bj) { float* p = lg + (size_t)(row0 + ai * HALF + m * 16) * NE_ + col0 + bj * HALF; *(f32x4*)p = acc[ai][bj][m][0]; *(f32x4*)(p + 4) = acc[ai][bj][m][1]; }
    }
};
struct EpiSwiglu {
    static constexpr bool PERM = true, AFTER_DRAIN = false;
    bf16_t* hid;
    template <class U> __device__ __forceinline__ void operator()(PG8_EPI_ARGS) const {
        const int row0 = u.pm * BM + wr * 64 + fr, col0 = u.pn * HALF + wc * 32 + 8 * fq;
#pragma unroll
        for (int ai = 0; ai < 2; ++ai)
#pragma unroll
            for (int m = 0; m < 4; ++m) { const size_t off = (size_t)(row0 + ai * HALF + m * 16) * FE_ + col0;
                const f32x4 a0 = acc[ai][0][m][0], a1 = acc[ai][0][m][1];
                *(u32x4*)(hid + off) = pack8(a0 * sigm4(a0) * acc[ai][1][m][0], a1 * sigm4(a1) * acc[ai][1][m][1]); }
    }
};
constexpr float YS_SCALE = 16.0f;
__device__ __forceinline__ unsigned pack4_fp8(const f32x4& v) { int w = __builtin_amdgcn_cvt_pk_fp8_f32(v[0], v[1], 0, false); w = __builtin_amdgcn_cvt_pk_fp8_f32(v[2], v[3], w, true); return (unsigned)w; }
struct EpiDown {
    static constexpr bool PERM = true, AFTER_DRAIN = false;
    const PG8_LAS int* rowtab; unsigned char* yslot; float* xb; const float* mod;
    template <class U> __device__ __forceinline__ void operator()(PG8_EPI_ARGS) const {
        typedef unsigned u32x2 __attribute__((ext_vector_type(2)));
        const int rl0 = wr * 64 + fr, col0 = u.pn * BM + wc * 32 + 8 * fq;
        if (u.e < NE_) {
            const PG8_LAS int* lp = rowtab + u.slot * 256;
#pragma unroll
            for (int ai = 0; ai < 2; ++ai)
#pragma unroll
                for (int m = 0; m < 4; ++m) { const int rl = rl0 + ai * HALF + m * 16;
                    if (rl < u.nrows) { const int w_ = lp[rl]; const int a = w_ & 0x3ffff; const float g = (float)((unsigned)w_ >> 18) * (ROUTED_SCALE_ / 16383.0f * YS_SCALE); unsigned char* rowp = yslot + (size_t)a * D_ + col0;
#pragma unroll
                        for (int bj = 0; bj < 2; ++bj) { u32x2 w; w.x = pack4_fp8(acc[ai][bj][m][0] * g); w.y = pack4_fp8(acc[ai][bj][m][1] * g); *(u32x2*)(rowp + bj * HALF) = w; } } }
        } else {
            const int t0 = u.rt * BM, b = t0 >> 12;
#pragma unroll
            for (int bj = 0; bj < 2; ++bj) { const float* gp = mod + b * 6144 + 5120 + col0 + bj * HALF; const f32x4 g0 = *(const f32x4*)gp, g1 = *(const f32x4*)(gp + 4);
#pragma unroll
                for (int ai = 0; ai < 2; ++ai)
#pragma unroll
                    for (int m = 0; m < 4; ++m) { float* p = xb + (size_t)(t0 + rl0 + ai * HALF + m * 16) * D_ + col0 + bj * HALF;
                        const f32x4 x0 = *(const f32x4*)p, x1 = *(const f32x4*)(p + 4);
                        *(f32x4*)p = x0 * DN_ALPHA_ + g0 * acc[ai][bj][m][0]; *(f32x4*)(p + 4) = x1 * DN_ALPHA_ + g1 * acc[ai][bj][m][1]; } }
        }
    }
};

template <int K, class Epi, class Sched, bool ALIGN_EPI = false, bool SP2 = false, bool GATHER = false>
__device__ __forceinline__ void gemm_phase(PG8_LAS unsigned char* lds, const Gemm g, const Sched& S, const Epi& E, const int wid) {
    const int lane = mk_lane_now(), tid = wid * 64 + lane, wr = wid >> 2, wc = wid & 3, fr = lane & 15, fq = lane >> 4;
    typedef typename Sched::Unit Unit;
    constexpr int nt = K / BK;
    unsigned voffA[2], voffB[2]; int RA[2], CA[2];
#pragma unroll
    for (int i = 0; i < 2; ++i) { int R, C; stage_rc(tid * 16 + i * 8192, R, C); const int Rb = Epi::PERM ? ((R & ~31) + perm32(R & 31)) : R;
        voffA[i] = (unsigned)(R * K + C) * 2u; voffB[i] = (unsigned)(Rb * K + C) * 2u; RA[i] = R; CA[i] = C; }
    constexpr size_t kstep = (size_t)(BK * 2);
    constexpr size_t hstep = (size_t)HALF * K * 2;
    constexpr size_t tstep = 2 * hstep;
    const unsigned ldsw = (unsigned)wid * 1024u;
    const int aoff = lds_byte(wr * 64 + fr, fq * 8), boff = lds_byte(wc * 32 + fr, fq * 8);
#define PG8_SA(b, h) (((b) * 2 + (h)) * HTB)
#define PG8_SB(b, h) ((4 + (b) * 2 + (h)) * HTB)
#define PG8_STAGE(bufoff, gbase, voff) do { _Pragma("unroll") for (int _i = 0; _i < 2; ++_i) \
        __builtin_amdgcn_global_load_lds((const unsigned*)((const char*)(gbase) + (voff)[_i]), (PG8_LAS unsigned*)(lds + (bufoff) + ldsw + _i * 8192), 16, 0, 0); } while (0)
#define PG8_STAGE_A(bufoff, base, h, nx) do { if constexpr (GATHER) { const unsigned _v[2] = {(nx) ? gn[h][0] : gc[h][0], (nx) ? gn[h][1] : gc[h][1]}; PG8_STAGE(bufoff, base, _v); } \
        else { PG8_STAGE(bufoff, (base) + (h) * hstep, voffA); } } while (0)
#define PG8_LDA(dst, b, h) do { _Pragma("unroll") for (int m = 0; m < 4; ++m) _Pragma("unroll") for (int k = 0; k < 2; ++k) dst[m][k] = *(const PG8_LAS bf16x8*)(lds + PG8_SA(b, h) + aoff + m * 2048 + k * 1024); } while (0)
#define PG8_LDB(dst, b, h) do { _Pragma("unroll") for (int n = 0; n < 2; ++n) _Pragma("unroll") for (int k = 0; k < 2; ++k) dst[n][k] = *(const PG8_LAS bf16x8*)(lds + PG8_SB(b, h) + boff + n * 2048 + k * 1024); } while (0)
#define PG8_MMA(ai, bj, At, Bt) do { __builtin_amdgcn_s_setprio(1); _Pragma("unroll") for (int m = 0; m < 4; ++m) _Pragma("unroll") for (int n = 0; n < 2; ++n) _Pragma("unroll") for (int k = 0; k < 2; ++k) \
        acc[ai][bj][m][n] = __builtin_amdgcn_mfma_f32_16x16x32_bf16(Bt[n][k], At[m][k], acc[ai][bj][m][n], 0, 0, 0); __builtin_amdgcn_s_setprio(0); } while (0)
#define PG8_WAIT_V(n) asm volatile("s_waitcnt vmcnt(" #n ")" ::: "memory")
#define PG8_WAIT_L(n) asm volatile("s_waitcnt lgkmcnt(" #n ")" ::: "memory")
#define PG8_BAR __builtin_amdgcn_s_barrier()
#define PG8_SCHED __builtin_amdgcn_sched_barrier(0)
    Unit cur, nxt; int ui = 0;
    if (!S.next(0, cur)) return;
    f32x4 acc[2][2][4][2];
#pragma unroll
    for (int a = 0; a < 2; ++a)
#pragma unroll
        for (int b = 0; b < 2; ++b)
#pragma unroll
            for (int m = 0; m < 4; ++m)
#pragma unroll
                for (int n = 0; n < 2; ++n) acc[a][b][m][n] = (f32x4){0.f, 0.f, 0.f, 0.f};
    bf16x8 At[4][2], B0[2][2], B1[2][2];
    unsigned gc[2][2] = {{0u, 0u}, {0u, 0u}}, gn[2][2] = {{0u, 0u}, {0u, 0u}};
    if constexpr (GATHER) {
#pragma unroll
        for (int h = 0; h < 2; ++h)
#pragma unroll
            for (int i = 0; i < 2; ++i) gc[h][i] = S.row_off(cur, h * HALF + RA[i], CA[i]);
    }
    const char* cA = (const char*)g.A + S.a_off(cur, tstep); const char* cB = (const char*)g.Bt + S.b_off(cur, tstep);
    S.a_ready(cur);
    if constexpr (SP2) {
        PG8_STAGE(PG8_SB(0, 0), cB, voffB); PG8_STAGE(PG8_SB(0, 1), cB + hstep, voffB); PG8_STAGE_A(PG8_SA(0, 0), cA, 0, false); PG8_STAGE_A(PG8_SA(0, 1), cA, 1, false);
        if (wr == 1) PG8_BAR;
        PG8_WAIT_V(2); PG8_BAR;
        PG8_STAGE(PG8_SB(1, 0), cB + kstep, voffB); PG8_STAGE_A(PG8_SA(1, 0), cA + kstep, 0, false); PG8_STAGE(PG8_SB(1, 1), cB + hstep + kstep, voffB);
        PG8_WAIT_V(6); PG8_BAR;
    } else {
        PG8_STAGE(PG8_SB(0, 0), cB, voffB); PG8_STAGE_A(PG8_SA(0, 0), cA, 0, false); PG8_STAGE(PG8_SB(0, 1), cB + hstep, voffB); PG8_STAGE_A(PG8_SA(0, 1), cA, 1, false);
        if (wr == 1) PG8_BAR;
        PG8_WAIT_V(4); PG8_BAR;
        PG8_STAGE(PG8_SB(1, 0), cB + kstep, voffB); PG8_STAGE_A(PG8_SA(1, 0), cA + kstep, 0, false); PG8_STAGE(PG8_SB(1, 1), cB + hstep + kstep, voffB);
        PG8_WAIT_V(6); PG8_BAR;
    }
    for (;;) {
        const bool has_next = S.next(ui + 1, nxt);
        const char* nA = has_next ? (const char*)g.A + S.a_off(nxt, tstep) : cA; const char* nB = has_next ? (const char*)g.Bt + S.b_off(nxt, tstep) : cB;
        if constexpr (GATHER) {
#pragma unroll
            for (int h = 0; h < 2; ++h)
#pragma unroll
                for (int i = 0; i < 2; ++i) gn[h][i] = has_next ? S.row_off(nxt, h * HALF + RA[i], CA[i]) : gc[h][i];
        }
        for (int t = 0; t < nt; t += 2) {
            const bool last = (t == nt - 2);
            const char* a1 = cA + (size_t)(t + 1) * kstep;
            const char* a2 = last ? nA : cA + (size_t)(t + 2) * kstep; const char* b2 = last ? nB : cB + (size_t)(t + 2) * kstep;
            const char* a3 = a2 + kstep; const char* b3 = b2 + kstep;
            if (last && has_next) S.a_ready(nxt);
            if constexpr (SP2) {
            PG8_LDB(B0, 0, 0); PG8_LDB(B1, 0, 1); PG8_SCHED; PG8_LDA(At, 0, 0); PG8_STAGE_A(PG8_SA(1, 1), a1, 1, false);
            PG8_WAIT_V(8); PG8_WAIT_L(0); PG8_BAR; PG8_MMA(0, 0, At, B0); PG8_MMA(0, 1, At, B1); PG8_BAR; PG8_SCHED;
            PG8_LDA(At, 0, 1); PG8_STAGE(PG8_SB(0, 0), b2, voffB); PG8_STAGE(PG8_SB(0, 1), b2 + hstep, voffB); PG8_STAGE_A(PG8_SA(0, 0), a2, 0, last);
            PG8_WAIT_V(8); PG8_WAIT_L(0); PG8_BAR; PG8_MMA(1, 0, At, B0); PG8_MMA(1, 1, At, B1); PG8_BAR; PG8_SCHED;
            PG8_LDB(B0, 1, 0); PG8_LDB(B1, 1, 1); PG8_SCHED; PG8_LDA(At, 1, 0); PG8_STAGE_A(PG8_SA(0, 1), a2, 1, last);
            PG8_WAIT_V(8); PG8_WAIT_L(0); PG8_BAR; PG8_MMA(0, 0, At, B0); PG8_MMA(0, 1, At, B1); PG8_BAR; PG8_SCHED;
            PG8_LDA(At, 1, 1); PG8_STAGE(PG8_SB(1, 0), b3, voffB); PG8_STAGE(PG8_SB(1, 1), b3 + hstep, voffB); PG8_STAGE_A(PG8_SA(1, 0), a3, 0, last);
            PG8_WAIT_V(8); PG8_WAIT_L(0); PG8_BAR; PG8_MMA(1, 0, At, B0); PG8_MMA(1, 1, At, B1); PG8_BAR; PG8_SCHED;
            } else {
            PG8_LDB(B0, 0, 0); PG8_SCHED; PG8_LDA(At, 0, 0); PG8_STAGE_A(PG8_SA(1, 1), a1, 1, false);
            PG8_WAIT_L(8); PG8_BAR; PG8_WAIT_L(0); PG8_MMA(0, 0, At, B0); PG8_BAR; PG8_SCHED;
            PG8_LDB(B1, 0, 1); PG8_STAGE(PG8_SB(0, 0), b2, voffB);
            PG8_BAR; PG8_WAIT_L(0); PG8_MMA(0, 1, At, B1); PG8_BAR;
            PG8_LDA(At, 0, 1); PG8_STAGE_A(PG8_SA(0, 0), a2, 0, last);
            PG8_BAR; PG8_WAIT_L(0); PG8_MMA(1, 0, At, B0); PG8_BAR; PG8_SCHED;
            PG8_STAGE(PG8_SB(0, 1), b2 + hstep, voffB);
            PG8_WAIT_V(6); PG8_BAR; PG8_MMA(1, 1, At, B1); PG8_BAR;
            PG8_LDB(B0, 1, 0); PG8_SCHED; PG8_LDA(At, 1, 0); PG8_STAGE_A(PG8_SA(0, 1), a2, 1, last);
            PG8_WAIT_L(8); PG8_BAR; PG8_WAIT_L(0); PG8_MMA(0, 0, At, B0); PG8_BAR; PG8_SCHED;
            PG8_LDB(B1, 1, 1); PG8_STAGE(PG8_SB(1, 0), b3, voffB);
            PG8_BAR; PG8_WAIT_L(0); PG8_MMA(0, 1, At, B1); PG8_BAR;
            PG8_LDA(At, 1, 1); PG8_STAGE_A(PG8_SA(1, 0), a3, 0, last);
            PG8_BAR; PG8_WAIT_L(0); PG8_MMA(1, 0, At, B0); PG8_BAR; PG8_SCHED;
            PG8_STAGE(PG8_SB(1, 1), b3 + hstep, voffB);
            PG8_WAIT_V(6); PG8_BAR; PG8_MMA(1, 1, At, B1); PG8_BAR;
            }
        }
        if constexpr (ALIGN_EPI) { if (wr == 0) PG8_BAR; }
        if constexpr (!Epi::AFTER_DRAIN) { E(acc, cur, wr, wc, fr, fq); S.done(cur); }
        if (!has_next) break;
#pragma unroll
        for (int a = 0; a < 2; ++a)
#pragma unroll
            for (int b = 0; b < 2; ++b)
#pragma unroll
                for (int m = 0; m < 4; ++m)
#pragma unroll
                    for (int n = 0; n < 2; ++n) acc[a][b][m][n] = (f32x4){0.f, 0.f, 0.f, 0.f};
        cur = nxt; cA = nA; cB = nB; ++ui;
        if constexpr (GATHER) {
#pragma unroll
            for (int h = 0; h < 2; ++h)
#pragma unroll
                for (int i = 0; i < 2; ++i) gc[h][i] = gn[h][i];
        }
        if constexpr (ALIGN_EPI) { if (wr == 1) PG8_BAR; }
    }
    PG8_WAIT_V(0);
    if constexpr (!ALIGN_EPI) { if (wr == 0) PG8_BAR; }
    PG8_BAR;
#undef PG8_SA
#undef PG8_SB
#undef PG8_STAGE
#undef PG8_STAGE_A
#undef PG8_LDA
#undef PG8_LDB
#undef PG8_MMA
#undef PG8_WAIT_V
#undef PG8_WAIT_L
#undef PG8_BAR
#undef PG8_SCHED
}
}
#define PG8_SP2 true
#define PG8_ALIGN true
#include <hip/hip_bf16.h>
#include <cmath>
#ifndef ATTN_ON_DELTA
#define ATTN_ON_DELTA (32L*1024*1024)
#endif
#ifndef ATTN_GSUB_KERNARG_OFF
#define ATTN_GSUB_KERNARG_OFF 80
#endif
namespace attn_body {
using bf16=__hip_bfloat16;
using bf16x8=__attribute__((ext_vector_type(8)))short;
using s16x4=__attribute__((ext_vector_type(4)))short;
using f32x16=__attribute__((ext_vector_type(16)))float;
using u32x4=__attribute__((ext_vector_type(4)))unsigned;
constexpr int BATCH=8,NHEAD=16,SEQ=4096,D=64,DM=1024,OP=1024;
constexpr int NW=8,QBLK=32,QB=QBLK*NW,KVBLK=64,NQB=SEQ/QB;
constexpr int ATTN_PITCH=DM, ATTN_UNIT_ROWS=QB;
__device__ __forceinline__ int crow(int r,int hi){return (r&3)+8*(r>>2)+4*hi;}
#define SBAR() __builtin_amdgcn_sched_barrier(0)
__device__ __forceinline__ void cmask(f32x16&p0,f32x16&p1,int jb,int qrel,int hi){
  const float NEG=-INFINITY; int kb=64*jb+4*hi;
  #pragma unroll
  for(int r=0;r<16;++r){int kv=kb+(r&3)+8*(r>>2); if(kv>qrel)p0[r]=NEG; if(kv+32>qrel)p1[r]=NEG;}
}

constexpr int NSLOT=3, SLOTB=8192;
constexpr int LDS_K=0, LDS_V=NSLOT*SLOTB, LDS_WS=2*NSLOT*SLOTB, LDS_OST=LDS_WS+NW*64*4, LDS_BYTES=LDS_OST+NW*4096;
constexpr float C2=0.125f*1.4426950408889634f;
__device__ __forceinline__ void glds16(const void*gsrc,unsigned lds_dst){unsigned keep;
  asm volatile("s_mov_b32 %0, m0\n\ts_mov_b32 m0, %2\n\ts_nop 0\n\tglobal_load_lds_dwordx4 %1, off\n\ts_mov_b32 m0, %0":"=&s"(keep):"v"(gsrc),"s"(lds_dst):"memory");}
__device__ __forceinline__ float max3f(float a,float b,float c){float r;asm("v_max3_f32 %0, %1, %2, %3":"=v"(r):"v"(a),"v"(b),"v"(c));return r;}
__device__ __forceinline__ float max2f(float a,float b){float r;asm("v_max_f32_e32 %0, %1, %2":"=v"(r):"v"(a),"v"(b));return r;}
__device__ __forceinline__ float fadd_s(float a,float b){float r;asm("v_add_f32_e32 %0, %1, %2":"=v"(r):"v"(a),"v"(b));return r;}
__device__ __forceinline__ float fsub_s(float a,float b){float r;asm("v_sub_f32_e32 %0, %1, %2":"=v"(r):"v"(a),"v"(b));return r;}
typedef float f32x2_t __attribute__((ext_vector_type(2))); typedef __bf16 bf16x2_t __attribute__((ext_vector_type(2)));
__device__ __forceinline__ unsigned cvtpk_s(float lo,float hi){f32x2_t v={lo,hi};bf16x2_t b=__builtin_convertvector(v,bf16x2_t);return __builtin_bit_cast(unsigned,b);}
#define WAIT_BAR(N) asm volatile("s_waitcnt vmcnt(" #N ") lgkmcnt(0)\n\ts_barrier":::"memory")

__device__ __forceinline__ void qkt(f32x16&p0,f32x16&p1,const char*Kslot,const bf16x8*qr,const f32x16&negm,int r32,int hi){
  const char*kb=Kslot+hi*1024+r32*16;
  #pragma unroll
  for(int d0=0;d0<4;++d0){
    const bf16x8 b0=*reinterpret_cast<const bf16x8*>(kb+d0*2048);
    const bf16x8 b1=*reinterpret_cast<const bf16x8*>(kb+d0*2048+512);
    if(d0==0){p0=__builtin_amdgcn_mfma_f32_32x32x16_bf16(b0,qr[0],negm,0,0,0);p1=__builtin_amdgcn_mfma_f32_32x32x16_bf16(b1,qr[0],negm,0,0,0);}
    else{p0=__builtin_amdgcn_mfma_f32_32x32x16_bf16(b0,qr[d0],p0,0,0,0);p1=__builtin_amdgcn_mfma_f32_32x32x16_bf16(b1,qr[d0],p1,0,0,0);}}
}
typedef __attribute__((address_space(3))) const char* lds_cptr;
typedef short v4i16_t __attribute__((ext_vector_type(4)));
__device__ __forceinline__ void kload8(bf16x8*kf,lds_cptr kp){
  kf[0]=*(const __attribute__((address_space(3))) bf16x8*)(kp);      kf[1]=*(const __attribute__((address_space(3))) bf16x8*)(kp+512);
  kf[2]=*(const __attribute__((address_space(3))) bf16x8*)(kp+2048); kf[3]=*(const __attribute__((address_space(3))) bf16x8*)(kp+2560);
  kf[4]=*(const __attribute__((address_space(3))) bf16x8*)(kp+4096); kf[5]=*(const __attribute__((address_space(3))) bf16x8*)(kp+4608);
  kf[6]=*(const __attribute__((address_space(3))) bf16x8*)(kp+6144); kf[7]=*(const __attribute__((address_space(3))) bf16x8*)(kp+6656);
}
__device__ __forceinline__ void kload2(bf16x8*kf,lds_cptr kp,int j){ kf[2*j]=*(const __attribute__((address_space(3))) bf16x8*)(kp+j*2048); kf[2*j+1]=*(const __attribute__((address_space(3))) bf16x8*)(kp+j*2048+512); }
__device__ __forceinline__ s16x4 vtr(lds_cptr p){ return __builtin_bit_cast(s16x4,__builtin_amdgcn_ds_read_tr16_b64_v4i16((__attribute__((address_space(3))) v4i16_t*)p)); }
__device__ __forceinline__ float rowmax(const f32x16&p0,const f32x16&p1){
  float a=max3f(p0[0],p0[1],p1[0]),b=max3f(p0[2],p0[3],p1[1]);a=max3f(a,p1[2],p1[3]);
  #pragma unroll
  for(int r=4;r<16;r+=4){a=max3f(a,p0[r],p0[r+1]);b=max3f(b,p0[r+2],p0[r+3]);a=max3f(a,p1[r],p1[r+1]);b=max3f(b,p1[r+2],p1[r+3]);}
  const float m=max2f(a,b);
  auto rr=__builtin_amdgcn_permlane32_swap(__float_as_uint(m),__float_as_uint(m),false,false);
  return max2f(__uint_as_float(rr[0]),__uint_as_float(rr[1]));
}
__device__ __forceinline__ void pv(f32x16*o,int vb,bf16x8 pa0,bf16x8 pa1,bf16x8 pa2,bf16x8 pa3){
  #pragma unroll
  for(int d0=0;d0<2;++d0){s16x4 lo[4],hi[4];
    #pragma unroll
    for(int ks=0;ks<4;++ks){
      asm volatile("ds_read_b64_tr_b16 %0,%1 offset:%c2":"=&v"(lo[ks]):"v"(vb),"i"(d0*4096+ks*1024):"memory");
      asm volatile("ds_read_b64_tr_b16 %0,%1 offset:%c2":"=&v"(hi[ks]):"v"(vb),"i"(d0*4096+ks*1024+512):"memory");}
    asm volatile("s_waitcnt lgkmcnt(0)":::"memory");SBAR();
    #define PK(k) (bf16x8){lo[k][0],lo[k][1],lo[k][2],lo[k][3],hi[k][0],hi[k][1],hi[k][2],hi[k][3]}
    o[d0]=__builtin_amdgcn_mfma_f32_32x32x16_bf16(pa0,PK(0),o[d0],0,0,0);
    o[d0]=__builtin_amdgcn_mfma_f32_32x32x16_bf16(pa1,PK(1),o[d0],0,0,0);
    o[d0]=__builtin_amdgcn_mfma_f32_32x32x16_bf16(pa2,PK(2),o[d0],0,0,0);
    o[d0]=__builtin_amdgcn_mfma_f32_32x32x16_bf16(pa3,PK(3),o[d0],0,0,0);
    #undef PK
  }
}

#ifndef ATTN_STORE16
#define ATTN_STORE16(p,v) (*(u32x4*)(p)=(v))
#endif
template<int THRL> __device__ __forceinline__ void attn_unit(const int wid,int b,int cq,int cv,int co,int qb,const bf16*Q,const bf16*__restrict__ K,const bf16*__restrict__ V,bf16*O,char*shm){
  const int lane=mk_lane_now(),r32=lane&31,hi=lane>>5;
  const long rowbase=(long)b*SEQ; const int q0=qb*QB;
  const bf16*Qw=Q+(rowbase+q0+wid*QBLK)*DM+cq;
  const bf16*Kh=K+rowbase*DM+cq,*Vh=V+rowbase*DM+cv;
  const unsigned lds0=(unsigned)(uintptr_t)shm;
  float*wsf=(float*)(shm+LDS_WS)+wid*64;
  const bf16*ksrc=Kh+(long)lane*DM+wid*8;
  const bf16*vsrc=Vh+(long)(16*(wid&3)+(lane>>2))*DM+(wid>>2)*32+(lane&3)*8;
  const unsigned kdst=lds0+LDS_K+wid*1024, vdst=lds0+LDS_V+wid*1024;
  #define DMA_K(t,slot) glds16(ksrc+(long)(t)*KVBLK*DM,(unsigned)__builtin_amdgcn_readfirstlane(kdst+(slot)))
  #define DMA_V(t,slot) glds16(vsrc+(long)(t)*KVBLK*DM,(unsigned)__builtin_amdgcn_readfirstlane(vdst+(slot)))
  const int vb0=(int)(lds0+LDS_V)+((lane>>4)&1)*32+(lane&3)*8+(4*hi+((lane&15)>>2))*64;
  const char*Kbase=shm+LDS_K; bf16x8 kf[8];
  const lds_cptr shm3=(lds_cptr)shm; const lds_cptr kp0=shm3+LDS_K+hi*1024+r32*16; const lds_cptr vp0=shm3+LDS_V+((lane>>4)&1)*32+(lane&3)*8+(4*hi+((lane&15)>>2))*64;
  const int NT=(q0+QB)/KVBLK;
  DMA_K(0,0);DMA_V(0,0);DMA_K(1,SLOTB);
  bf16x8 qr[4];
  #pragma unroll
  for(int d0=0;d0<4;++d0)qr[d0]=*reinterpret_cast<const bf16x8*>(&Qw[(long)r32*DM+d0*16+hi*8]);
  float zf_=0.f;asm volatile("":"+v"(zf_));f32x16 zv_;
  #pragma unroll
  for(int r=0;r<16;++r)zv_[r]=zf_;
  float mhat=0.f,l_reg=0.f;f32x16 o[2];o[0]=zv_;o[1]=zv_;f32x16 negm=zv_;asm volatile("":"+v"(negm));
  const int qrel=wid*QBLK+r32;
  #define CMASK(P0,P1,t) do{int jb_=(t)-(NT-4); if(jb_>=0)cmask(P0,P1,jb_,qrel,hi);}while(0)
  bool resc=false;
  #define START(P0,P1) do{ const float rm=rowmax(P0,P1); resc=false; \
    { const float dl=rm; mhat=fadd_s(mhat,dl); \
      _Pragma("unroll") for(int r=0;r<16;++r){P0[r]=fsub_s(P0[r],dl);P1[r]=fsub_s(P1[r],dl);} \
      _Pragma("unroll") for(int r=0;r<16;++r)negm[r]=-mhat; asm volatile("":"+v"(negm)); } \
    _Pragma("unroll") for(int r=0;r<16;++r)P0[r]=__builtin_amdgcn_exp2f(P0[r]); }while(0)
  #define RESC() do{ if(resc){ asm volatile("s_waitcnt lgkmcnt(0)":::"memory"); \
      _Pragma("unroll") for(int d_=0;d_<2;++d_) _Pragma("unroll") for(int r=0;r<16;++r)o[d_][r]*=wsf[crow(r,hi)]; } }while(0)
  f32x16 pA0,pA1,pB0,pB1;
  int sl_prev=0,sl_cur=0,sl_next=SLOTB;
  #define ROT() do{sl_prev=sl_cur;sl_cur=sl_next;sl_next=(sl_next==(NSLOT-1)*SLOTB)?0:sl_next+SLOTB;}while(0)
  DMA_K(2,2*SLOTB);
  WAIT_BAR(3);
  qkt(pA0,pA1,Kbase,qr,negm,r32,hi);asm volatile("s_nop 15\n\ts_nop 7":"+v"(pA0),"+v"(pA1));CMASK(pA0,pA1,0);
  START(pA0,pA1);
  _Pragma("unroll") for(int r=0;r<16;++r)pA1[r]=__builtin_amdgcn_exp2f(pA1[r]);
  WAIT_BAR(0);
  DMA_K(3,0);DMA_V(1,SLOTB);
  ROT();
  kload8(kf,kp0+sl_cur);
  WAIT_BAR(2);
  s16x4 vlo[8],vhi[8]; u32x4 pw0,pw1,pw2,pw3;
  #define PKW(P,B) cvtpk_s(P[B],P[B+1])
  #define PAF(k) __builtin_bit_cast(bf16x8,pw##k)
  #define VFR(i) (bf16x8){vlo[i][0],vlo[i][1],vlo[i][2],vlo[i][3],vhi[i][0],vhi[i][1],vhi[i][2],vhi[i][3]}
  #define PIN(x) asm volatile("":"+v"(x))
  #define MX3(a,b,c) __builtin_fmaxf(__builtin_fmaxf((a),(b)),(c))
  #define GAPA(MF,A0,A1,A2,A3,W0,W1,PW) do{ MF; sacc+=A0; sacc+=A1; sacc+=A2; sacc+=A3; PIN(sacc); W0; W1; PIN(PW); SBAR(); }while(0)
  #define EX(v) __builtin_amdgcn_exp2f(v)
  #define GAPB(MF,X,B) do{ MF; X[B]=EX(X[B]); X[B+1]=EX(X[B+1]); X[B+2]=EX(X[B+2]); X[B+3]=EX(X[B+3]); PIN(X); SBAR(); }while(0)
  #define VRD(i) do{ vlo[i]=vtr(vp_+(((i)>>2)*4096+((i)&3)*1024)); vhi[i]=vtr(vp_+(((i)>>2)*4096+((i)&3)*1024+512)); }while(0)
  #define KRD(G,j) do{ if(G){ kload2(kf,kp0+sl_next,j); SBAR(); } }while(0)
  #define STEP(C0,C1,P0,P1,t,GK,GV,GL) do{ SBAR(); \
    const lds_cptr vp_=vp0+sl_prev; \
    VRD(0); SBAR(); float sacc=(P0[0]+P0[1]); \
    GAPA(C0=__builtin_amdgcn_mfma_f32_32x32x16_bf16(kf[0],qr[0],negm,0,0,0), P0[2],P0[3],P0[4],P0[5],     pw0[0]=PKW(P0,0), pw0[1]=PKW(P0,2), pw0); \
    VRD(4); SBAR(); GAPA(C1=__builtin_amdgcn_mfma_f32_32x32x16_bf16(kf[1],qr[0],negm,0,0,0), P0[6],P0[7],P0[8],P0[9],     pw0[2]=PKW(P0,4), pw0[3]=PKW(P0,6), pw0); \
    VRD(1); SBAR(); GAPA(C0=__builtin_amdgcn_mfma_f32_32x32x16_bf16(kf[2],qr[1],C0,0,0,0),   P0[10],P0[11],P0[12],P0[13], pw1[0]=PKW(P0,8), pw1[1]=PKW(P0,10), pw1); \
    VRD(5); SBAR(); GAPA(C1=__builtin_amdgcn_mfma_f32_32x32x16_bf16(kf[3],qr[1],C1,0,0,0),   P0[14],P0[15],P1[0],P1[1],   pw1[2]=PKW(P0,12),pw1[3]=PKW(P0,14), pw1); \
    VRD(2); SBAR(); GAPA(C0=__builtin_amdgcn_mfma_f32_32x32x16_bf16(kf[4],qr[2],C0,0,0,0),   P1[2],P1[3],P1[4],P1[5],     pw2[0]=PKW(P1,0), pw2[1]=PKW(P1,2), pw2); \
    VRD(6); SBAR(); GAPA(C1=__builtin_amdgcn_mfma_f32_32x32x16_bf16(kf[5],qr[2],C1,0,0,0),   P1[6],P1[7],P1[8],P1[9],     pw2[2]=PKW(P1,4), pw2[3]=PKW(P1,6), pw2); \
    VRD(3); SBAR(); GAPA(C0=__builtin_amdgcn_mfma_f32_32x32x16_bf16(kf[6],qr[3],C0,0,0,0),   P1[10],P1[11],P1[12],P1[13], pw3[0]=PKW(P1,8), pw3[1]=PKW(P1,10), pw3); \
    VRD(7); SBAR(); GAPA(C1=__builtin_amdgcn_mfma_f32_32x32x16_bf16(kf[7],qr[3],C1,0,0,0),   P1[14],P1[15],0.f,0.f,       pw3[2]=PKW(P1,12),pw3[3]=PKW(P1,14), pw3); \
    l_reg+=sacc; \
    if(GK){DMA_K((t)+3,sl_cur);} if(GV){DMA_V((t)+1,sl_next);} \
    CMASK(C0,C1,t); \
    { float a=MX3(C0[0],C0[1],C1[0]),b=MX3(C0[2],C0[3],C1[1]); a=MX3(a,C1[2],C1[3]); \
      _Pragma("unroll") for(int r=4;r<16;r+=4){a=MX3(a,C0[r],C0[r+1]);b=MX3(b,C0[r+2],C0[r+3]);a=MX3(a,C1[r],C1[r+1]);b=MX3(b,C1[r+2],C1[r+3]);} \
      float rm=__builtin_fmaxf(a,b); { auto rr=__builtin_amdgcn_permlane32_swap(__float_as_uint(rm),__float_as_uint(rm),false,false); rm=__builtin_fmaxf(__uint_as_float(rr[0]),__uint_as_float(rr[1])); } \
      resc=false; \
      if(__builtin_expect(__any(rm>(float)THRL),0)){ const float dl=__builtin_fmaxf(rm,0.f); mhat+=dl; \
        _Pragma("unroll") for(int r=0;r<16;++r){C0[r]-=dl;C1[r]-=dl;} \
        _Pragma("unroll") for(int r=0;r<16;++r)negm[r]=-mhat; asm volatile("":"+v"(negm)); \
        const float f=__builtin_amdgcn_exp2f(-dl); l_reg*=f; if(hi==0)wsf[r32]=f; resc=true; } } \
    SBAR(); \
    GAPB(o[0]=__builtin_amdgcn_mfma_f32_32x32x16_bf16(PAF(0),VFR(0),o[0],0,0,0), C0,0); \
    GAPB(o[1]=__builtin_amdgcn_mfma_f32_32x32x16_bf16(PAF(0),VFR(4),o[1],0,0,0), C0,4); \
    KRD(GL,0); GAPB(o[0]=__builtin_amdgcn_mfma_f32_32x32x16_bf16(PAF(1),VFR(1),o[0],0,0,0), C0,8); \
    KRD(GL,1); GAPB(o[1]=__builtin_amdgcn_mfma_f32_32x32x16_bf16(PAF(1),VFR(5),o[1],0,0,0), C0,12); \
    KRD(GL,2); GAPB(o[0]=__builtin_amdgcn_mfma_f32_32x32x16_bf16(PAF(2),VFR(2),o[0],0,0,0), C1,0); \
    KRD(GL,3); GAPB(o[1]=__builtin_amdgcn_mfma_f32_32x32x16_bf16(PAF(2),VFR(6),o[1],0,0,0), C1,4); \
    GAPB(o[0]=__builtin_amdgcn_mfma_f32_32x32x16_bf16(PAF(3),VFR(3),o[0],0,0,0), C1,8); \
    GAPB(o[1]=__builtin_amdgcn_mfma_f32_32x32x16_bf16(PAF(3),VFR(7),o[1],0,0,0), C1,12); \
    }while(0)
  int t=1;
  #undef CMASK
  #define CMASK(P0,P1,t) do{}while(0)
  for(;t+5<NT;t+=2){
    STEP(pB0,pB1,pA0,pA1,t,true,true,true);     WAIT_BAR(2); RESC(); ROT();
    STEP(pA0,pA1,pB0,pB1,t+1,true,true,true);   WAIT_BAR(2); RESC(); ROT();
  }
  #undef CMASK
  #define CMASK(P0,P1,t) do{int jb_=(t)-(NT-4); if(jb_>=0)cmask(P0,P1,jb_,qrel,hi);}while(0)
  #define ENDW(tt) do{ if((tt)+3<NT){WAIT_BAR(2);} else if((tt)+2<NT){WAIT_BAR(1);} else {WAIT_BAR(0);} }while(0)
  for(;t+1<NT;t+=2){
    STEP(pB0,pB1,pA0,pA1,t,(t+3<NT),(t+1<NT),(t+1<NT));       ENDW(t);   RESC(); ROT();
    STEP(pA0,pA1,pB0,pB1,t+1,(t+4<NT),(t+2<NT),(t+2<NT));     ENDW(t+1); RESC(); ROT();
  }
  STEP(pB0,pB1,pA0,pA1,NT-1,false,false,false); RESC();
  { float sacc=pB0[0]+pB0[1]; _Pragma("unroll") for(int r=2;r<16;++r)sacc+=pB0[r]; _Pragma("unroll") for(int r=0;r<16;++r)sacc+=pB1[r]; l_reg+=sacc;
    pw0=(u32x4){PKW(pB0,0),PKW(pB0,2),PKW(pB0,4),PKW(pB0,6)};pw1=(u32x4){PKW(pB0,8),PKW(pB0,10),PKW(pB0,12),PKW(pB0,14)};pw2=(u32x4){PKW(pB1,0),PKW(pB1,2),PKW(pB1,4),PKW(pB1,6)};pw3=(u32x4){PKW(pB1,8),PKW(pB1,10),PKW(pB1,12),PKW(pB1,14)};
    SBAR(); pv(o,vb0+sl_cur,PAF(0),PAF(1),PAF(2),PAF(3)); }
  #undef PKW
  #undef PAF
  #undef VFR
  #undef PIN
  #undef MX3
  #undef GAPA
  #undef GAPB
  #undef EX
  #undef VRD
  #undef KRD
  #undef STEP
  #undef ENDW
  {auto rr=__builtin_amdgcn_permlane32_swap(__float_as_uint(l_reg),__float_as_uint(l_reg),false,false);l_reg=__uint_as_float(rr[0])+__uint_as_float(rr[1]);}
  if(hi==0)wsf[32+r32]=l_reg;asm volatile("s_waitcnt lgkmcnt(0)":::"memory");
  float rli[16];
  #pragma unroll
  for(int r=0;r<16;++r)rli[r]=__builtin_amdgcn_rcpf(wsf[32+crow(r,hi)]);
  bf16*Ow=O+(rowbase+q0+wid*QBLK)*OP+co;
  { bf16*stg=(bf16*)(shm+LDS_OST)+wid*2048;
    #pragma unroll
    for(int r=0;r<16;++r){const int orow=crow(r,hi);
      #pragma unroll
      for(int d0=0;d0<2;++d0)stg[orow*64+d0*32+r32]=__float2bfloat16(o[d0][r]*rli[r]);}
    asm volatile("s_waitcnt lgkmcnt(0)":::"memory");
    #pragma unroll
    for(int i=0;i<4;++i){const int row=i*8+(lane>>3),ch=lane&7; const u32x4 v=*(const u32x4*)(stg+row*64+ch*8); ATTN_STORE16(Ow+(long)row*OP+ch*8,v);} }
  asm volatile("s_waitcnt lgkmcnt(0)\n\ts_barrier":::"memory");
  #undef DMA_K
  #undef DMA_V
  #undef CMASK
  #undef START
  #undef RESC
  #undef ROT
}
struct AttnTensors { const bf16* Q; const bf16* K; const bf16* V; bf16* O; };
struct AttnUnit { int combo; int qb; };
constexpr int SLOTV=16384;
constexpr int L2_K=0, L2_V=NSLOT*SLOTB, L2_WS=L2_V+NSLOT*SLOTV, L2_Q=L2_WS+NW*64*4, L2_BYTES=L2_Q+NW*4096;
__device__ __forceinline__ void pv128(f32x16*o,int vb,bf16x8 pa0,bf16x8 pa1,bf16x8 pa2,bf16x8 pa3){
  #pragma unroll
  for(int d0=0;d0<4;++d0){s16x4 lo[4],hi[4];
    #pragma unroll
    for(int ks=0;ks<4;++ks){
      asm volatile("ds_read_b64_tr_b16 %0,%1 offset:%c2":"=&v"(lo[ks]):"v"(vb),"i"(d0*4096+ks*1024):"memory");
      asm volatile("ds_read_b64_tr_b16 %0,%1 offset:%c2":"=&v"(hi[ks]):"v"(vb),"i"(d0*4096+ks*1024+512):"memory");}
    asm volatile("s_waitcnt lgkmcnt(0)":::"memory");SBAR();
    #define PK(k) (bf16x8){lo[k][0],lo[k][1],lo[k][2],lo[k][3],hi[k][0],hi[k][1],hi[k][2],hi[k][3]}
    o[d0]=__builtin_amdgcn_mfma_f32_32x32x16_bf16(pa0,PK(0),o[d0],0,0,0);
    o[d0]=__builtin_amdgcn_mfma_f32_32x32x16_bf16(pa1,PK(1),o[d0],0,0,0);
    o[d0]=__builtin_amdgcn_mfma_f32_32x32x16_bf16(pa2,PK(2),o[d0],0,0,0);
    o[d0]=__builtin_amdgcn_mfma_f32_32x32x16_bf16(pa3,PK(3),o[d0],0,0,0);
    #undef PK
  }
}
template<int THRL> __device__ __forceinline__ void attn_unit128(const int wid,int b,int cq,int cv,int co,int qb,const bf16*Q,const bf16*__restrict__ K,const bf16*__restrict__ V,bf16*O,char*shm,const int mode,const float lam){
  const int lane=mk_lane_now(),r32=lane&31,hi=lane>>5;
  const long rowbase=(long)b*SEQ; const int q0=qb*QB;
  const bf16*Qw=Q+(rowbase+q0+wid*QBLK)*DM+cq;
  const bf16*Kh=K+rowbase*DM+cq,*Vh=V+rowbase*DM+cv;
  const unsigned lds0=(unsigned)(uintptr_t)shm;
  float*wsf=(float*)(shm+L2_WS)+wid*64;
  const bf16*ksrc=Kh+(long)lane*DM+wid*8;
  const bf16*vsrc=Vh+(long)(16*(wid&3)+(lane>>2))*DM+(wid>>2)*32+(lane&3)*8;
  const bf16*qsrc=Qw+(long)r32*DM+hi*8;
  const unsigned kdst=lds0+L2_K+wid*1024, vdst=lds0+L2_V+wid*1024, qdst=lds0+L2_Q+wid*4096;
  #define DMA_K2(t,slot) glds16(ksrc+(long)(t)*KVBLK*DM,(unsigned)__builtin_amdgcn_readfirstlane(kdst+(slot)))
  #define DMA_V2(t,slot) do{ glds16(vsrc+(long)(t)*KVBLK*DM,(unsigned)__builtin_amdgcn_readfirstlane(vdst+2*(slot))); glds16(vsrc+(long)(t)*KVBLK*DM+64,(unsigned)__builtin_amdgcn_readfirstlane(vdst+2*(slot)+8192)); }while(0)
  const int vb0=(int)(lds0+L2_V)+((lane>>4)&1)*32+(lane&3)*8+(4*hi+((lane&15)>>2))*64;
  const char*Kbase=shm+L2_K; bf16x8 kf[8];
  const lds_cptr shm3=(lds_cptr)shm; const lds_cptr kp0=shm3+L2_K+hi*1024+r32*16; const lds_cptr vp0=shm3+L2_V+((lane>>4)&1)*32+(lane&3)*8+(4*hi+((lane&15)>>2))*64;
  const lds_cptr qp0=shm3+L2_Q+wid*4096+lane*16;
  const int NT=(q0+QB)/KVBLK;
  #pragma unroll
  for(int d0=0;d0<4;++d0) glds16(qsrc+16*d0,(unsigned)__builtin_amdgcn_readfirstlane(qdst+d0*1024));
  DMA_K2(0,0);DMA_V2(0,0);DMA_K2(1,SLOTB);DMA_K2(2,2*SLOTB);
  float zf_=0.f;asm volatile("":"+v"(zf_));f32x16 zv_;
  #pragma unroll
  for(int r=0;r<16;++r)zv_[r]=zf_;
  float mhat=0.f,l_reg=0.f;f32x16 o[4];o[0]=zv_;o[1]=zv_;o[2]=zv_;o[3]=zv_;
  const int qrel=wid*QBLK+r32;
  #define CMASK2(P0,P1,t) do{int jb_=(t)-(NT-4); if(jb_>=0)cmask(P0,P1,jb_,qrel,hi);}while(0)
  bool resc=false;
  #define RESC2() do{ if(resc){ asm volatile("s_waitcnt lgkmcnt(0)":::"memory"); \
      _Pragma("unroll") for(int d_=0;d_<4;++d_) _Pragma("unroll") for(int r=0;r<16;++r)o[d_][r]*=wsf[crow(r,hi)]; } }while(0)
  f32x16 pA0,pA1,pB0,pB1;
  int sl_prev=0,sl_cur=0,sl_next=SLOTB;
  #define ROT2() do{sl_prev=sl_cur;sl_cur=sl_next;sl_next=(sl_next==(NSLOT-1)*SLOTB)?0:sl_next+SLOTB;}while(0)
  WAIT_BAR(4);
  { bf16x8 qr[4];
    #pragma unroll
    for(int d0=0;d0<4;++d0)qr[d0]=*(const __attribute__((address_space(3))) bf16x8*)(qp0+d0*1024);
    qkt(pA0,pA1,Kbase,qr,zv_,r32,hi); }
  asm volatile("s_nop 15\n\ts_nop 7":"+v"(pA0),"+v"(pA1));CMASK2(pA0,pA1,0);
  { const float rm=rowmax(pA0,pA1); mhat=rm;
    _Pragma("unroll") for(int r=0;r<16;++r){pA0[r]=__builtin_amdgcn_exp2f(pA0[r]-mhat);pA1[r]=__builtin_amdgcn_exp2f(pA1[r]-mhat);} }
  WAIT_BAR(0);
  DMA_K2(3,0);DMA_V2(1,SLOTB);
  ROT2();
  kload8(kf,kp0+sl_cur);
  WAIT_BAR(3);
  s16x4 vlo[8],vhi[8]; u32x4 pw0,pw1,pw2,pw3;
  #define PKW(P,B) cvtpk_s(P[B],P[B+1])
  #define PAF(k) __builtin_bit_cast(bf16x8,pw##k)
  #define VFR(i) (bf16x8){vlo[i][0],vlo[i][1],vlo[i][2],vlo[i][3],vhi[i][0],vhi[i][1],vhi[i][2],vhi[i][3]}
  #define PIN(x) asm volatile("":"+v"(x))
  #define MX3(a,b,c) __builtin_fmaxf(__builtin_fmaxf((a),(b)),(c))
  #define GAPA(MF,A0,A1,A2,A3,W0,W1,PW) do{ MF; sacc+=A0; sacc+=A1; sacc+=A2; sacc+=A3; PIN(sacc); W0; W1; PIN(PW); SBAR(); }while(0)
  #define EX(v) __builtin_amdgcn_exp2f(v)
  #define GAPB2(MF,X,B) do{ MF; X[B]=EX(X[B]-mhat); X[B+1]=EX(X[B+1]-mhat); PIN(X); SBAR(); }while(0)
  #define VRDS(s,f) do{ vlo[s]=vtr(vp_+(((f)>>2)*4096+((f)&3)*1024)); vhi[s]=vtr(vp_+(((f)>>2)*4096+((f)&3)*1024+512)); }while(0)
  #define KRD(G,j) do{ if(G){ kload2(kf,kp0+sl_next,j); SBAR(); } }while(0)
  #define MF32(a,b,c) __builtin_amdgcn_mfma_f32_32x32x16_bf16(a,b,c,0,0,0)
  #define QFR(d0) (*(const __attribute__((address_space(3))) bf16x8*)(qp_+(d0)*1024))
  #define STEP2(C0,C1,P0,P1,t,GK,GV,GL) do{ SBAR(); \
    const lds_cptr vp_=vp0+2*sl_prev; int qo_=0; asm volatile("":"+v"(qo_)); const lds_cptr qp_=qp0+qo_; \
    const bf16x8 q0_=QFR(0),q1_=QFR(1),q2_=QFR(2),q3_=QFR(3); const f32x16 z16_={}; \
    VRDS(0,0); SBAR(); float sacc=(P0[0]+P0[1]); \
    GAPA(C0=MF32(kf[0],q0_,z16_), P0[2],P0[3],P0[4],P0[5],     pw0[0]=PKW(P0,0), pw0[1]=PKW(P0,2), pw0); \
    VRDS(1,4); SBAR(); GAPA(C1=MF32(kf[1],q0_,z16_), P0[6],P0[7],P0[8],P0[9],     pw0[2]=PKW(P0,4), pw0[3]=PKW(P0,6), pw0); \
    VRDS(2,8); SBAR(); GAPA(C0=MF32(kf[2],q1_,C0),   P0[10],P0[11],P0[12],P0[13], pw1[0]=PKW(P0,8), pw1[1]=PKW(P0,10), pw1); \
    VRDS(3,12);SBAR(); GAPA(C1=MF32(kf[3],q1_,C1),   P0[14],P0[15],P1[0],P1[1],   pw1[2]=PKW(P0,12),pw1[3]=PKW(P0,14), pw1); \
    VRDS(4,1); SBAR(); GAPA(C0=MF32(kf[4],q2_,C0),   P1[2],P1[3],P1[4],P1[5],     pw2[0]=PKW(P1,0), pw2[1]=PKW(P1,2), pw2); \
    VRDS(5,5); SBAR(); GAPA(C1=MF32(kf[5],q2_,C1),   P1[6],P1[7],P1[8],P1[9],     pw2[2]=PKW(P1,4), pw2[3]=PKW(P1,6), pw2); \
    VRDS(6,9); SBAR(); GAPA(C0=MF32(kf[6],q3_,C0),   P1[10],P1[11],P1[12],P1[13], pw3[0]=PKW(P1,8), pw3[1]=PKW(P1,10), pw3); \
    VRDS(7,13);SBAR(); GAPA(C1=MF32(kf[7],q3_,C1),   P1[14],P1[15],0.f,0.f,       pw3[2]=PKW(P1,12),pw3[3]=PKW(P1,14), pw3); \
    l_reg+=sacc; \
    if(GK){DMA_K2((t)+3,sl_cur);} if(GV){DMA_V2((t)+1,sl_next);} \
    CMASK2(C0,C1,t); \
    { float a=MX3(C0[0],C0[1],C1[0]),b_=MX3(C0[2],C0[3],C1[1]); a=MX3(a,C1[2],C1[3]); \
      _Pragma("unroll") for(int r=4;r<16;r+=4){a=MX3(a,C0[r],C0[r+1]);b_=MX3(b_,C0[r+2],C0[r+3]);a=MX3(a,C1[r],C1[r+1]);b_=MX3(b_,C1[r+2],C1[r+3]);} \
      float rm=__builtin_fmaxf(a,b_); { auto rr=__builtin_amdgcn_permlane32_swap(__float_as_uint(rm),__float_as_uint(rm),false,false); rm=__builtin_fmaxf(__uint_as_float(rr[0]),__uint_as_float(rr[1])); } \
      rm-=mhat; resc=false; \
      if(__builtin_expect(__any(rm>(float)THRL),0)){ const float dl=__builtin_fmaxf(rm,0.f); mhat+=dl; \
        const float f=__builtin_amdgcn_exp2f(-dl); l_reg*=f; if(hi==0)wsf[r32]=f; resc=true; } } \
    SBAR(); \
    GAPB2(o[0]=MF32(PAF(0),VFR(0),o[0]), C0,0);  VRDS(0,2);  \
    GAPB2(o[1]=MF32(PAF(0),VFR(1),o[1]), C0,2);  VRDS(1,6);  \
    GAPB2(o[2]=MF32(PAF(0),VFR(2),o[2]), C0,4);  VRDS(2,10); \
    GAPB2(o[3]=MF32(PAF(0),VFR(3),o[3]), C0,6);  VRDS(3,14); \
    KRD(GL,0); GAPB2(o[0]=MF32(PAF(1),VFR(4),o[0]), C0,8);  VRDS(4,3);  \
    GAPB2(o[1]=MF32(PAF(1),VFR(5),o[1]), C0,10); VRDS(5,7);  \
    KRD(GL,1); GAPB2(o[2]=MF32(PAF(1),VFR(6),o[2]), C0,12); VRDS(6,11); \
    GAPB2(o[3]=MF32(PAF(1),VFR(7),o[3]), C0,14); VRDS(7,15); \
    KRD(GL,2); GAPB2(o[0]=MF32(PAF(2),VFR(0),o[0]), C1,0);  \
    GAPB2(o[1]=MF32(PAF(2),VFR(1),o[1]), C1,2);  \
    KRD(GL,3); GAPB2(o[2]=MF32(PAF(2),VFR(2),o[2]), C1,4);  \
    GAPB2(o[3]=MF32(PAF(2),VFR(3),o[3]), C1,6);  \
    GAPB2(o[0]=MF32(PAF(3),VFR(4),o[0]), C1,8);  \
    GAPB2(o[1]=MF32(PAF(3),VFR(5),o[1]), C1,10); \
    GAPB2(o[2]=MF32(PAF(3),VFR(6),o[2]), C1,12); \
    GAPB2(o[3]=MF32(PAF(3),VFR(7),o[3]), C1,14); \
    }while(0)
  int t=1;
  #undef CMASK2
  #define CMASK2(P0,P1,t) do{}while(0)
  for(;t+5<NT;t+=2){
    STEP2(pB0,pB1,pA0,pA1,t,true,true,true);     WAIT_BAR(3); RESC2(); ROT2();
    STEP2(pA0,pA1,pB0,pB1,t+1,true,true,true);   WAIT_BAR(3); RESC2(); ROT2();
  }
  #undef CMASK2
  #define CMASK2(P0,P1,t) do{int jb_=(t)-(NT-4); if(jb_>=0)cmask(P0,P1,jb_,qrel,hi);}while(0)
  #define ENDW2(tt) do{ if((tt)+3<NT){WAIT_BAR(3);} else if((tt)+2<NT){WAIT_BAR(2);} else {WAIT_BAR(0);} }while(0)
  for(;t+1<NT;t+=2){
    STEP2(pB0,pB1,pA0,pA1,t,(t+3<NT),(t+1<NT),(t+1<NT));       ENDW2(t);   RESC2(); ROT2();
    STEP2(pA0,pA1,pB0,pB1,t+1,(t+4<NT),(t+2<NT),(t+2<NT));     ENDW2(t+1); RESC2(); ROT2();
  }
  STEP2(pB0,pB1,pA0,pA1,NT-1,false,false,false); RESC2();
  { float sacc=pB0[0]+pB0[1]; _Pragma("unroll") for(int r=2;r<16;++r)sacc+=pB0[r]; _Pragma("unroll") for(int r=0;r<16;++r)sacc+=pB1[r]; l_reg+=sacc;
    pw0=(u32x4){PKW(pB0,0),PKW(pB0,2),PKW(pB0,4),PKW(pB0,6)};pw1=(u32x4){PKW(pB0,8),PKW(pB0,10),PKW(pB0,12),PKW(pB0,14)};pw2=(u32x4){PKW(pB1,0),PKW(pB1,2),PKW(pB1,4),PKW(pB1,6)};pw3=(u32x4){PKW(pB1,8),PKW(pB1,10),PKW(pB1,12),PKW(pB1,14)};
    SBAR(); pv128(o,vb0+2*sl_cur,PAF(0),PAF(1),PAF(2),PAF(3)); }
  #undef PKW
  #undef PAF
  #undef VFR
  #undef PIN
  #undef MX3
  #undef GAPA
  #undef GAPB2
  #undef EX
  #undef VRDS
  #undef KRD
  #undef MF32
  #undef QFR
  #undef STEP2
  #undef ENDW2
  {auto rr=__builtin_amdgcn_permlane32_swap(__float_as_uint(l_reg),__float_as_uint(l_reg),false,false);l_reg=__uint_as_float(rr[0])+__uint_as_float(rr[1]);}
  if(hi==0)wsf[32+r32]=l_reg;asm volatile("s_waitcnt lgkmcnt(0)":::"memory");
  float rli[16];
  #pragma unroll
  for(int r=0;r<16;++r)rli[r]=__builtin_amdgcn_rcpf(wsf[32+crow(r,hi)]);
  bf16*Ow=O+(rowbase+q0+wid*QBLK)*OP+co; bf16*Nw=Ow+ATTN_ON_DELTA;
  const float*gsub=*(const float*const __attribute__((address_space(4)))*)((const __attribute__((address_space(4))) char*)__builtin_amdgcn_kernarg_segment_ptr()+ATTN_GSUB_KERNARG_OFF);
  { bf16*stg=(bf16*)(shm+L2_Q)+wid*2048;
    float oc[2][4][8];
    #pragma unroll
    for(int ps=0;ps<2;++ps){
      #pragma unroll
      for(int r=0;r<16;++r){const int orow=crow(r,hi);
        #pragma unroll
        for(int d0=0;d0<2;++d0)stg[orow*64+d0*32+r32]=__float2bfloat16(o[2*ps+d0][r]*rli[r]);}
      asm volatile("s_waitcnt lgkmcnt(0)":::"memory");
      #pragma unroll
      for(int i=0;i<4;++i){const int row=i*8+(lane>>3),ch=lane&7; const u32x4 v=*(const u32x4*)(stg+row*64+ch*8);
        if(mode==0){ ATTN_STORE16(Ow+(long)row*OP+64*ps+ch*8,v); }
        else { const u32x4 p=*(const u32x4*)(Ow+(long)row*OP+64*ps+ch*8);
          #pragma unroll
          for(int k=0;k<4;++k){ oc[ps][i][2*k]=__uint_as_float(p[k]<<16)-lam*__uint_as_float(v[k]<<16); oc[ps][i][2*k+1]=__uint_as_float(p[k]&0xffff0000u)-lam*__uint_as_float(v[k]&0xffff0000u); } } }
      asm volatile("s_waitcnt lgkmcnt(0)":::"memory"); }
    if(mode!=0){
      #pragma unroll
      for(int i=0;i<4;++i){ float ss=0.f;
        #pragma unroll
        for(int ps=0;ps<2;++ps)
          #pragma unroll
          for(int k=0;k<8;++k)ss+=oc[ps][i][k]*oc[ps][i][k];
        #define DPPADD_(c) ss+=__uint_as_float((unsigned)__builtin_amdgcn_update_dpp(0,(int)__float_as_uint(ss),c,0xF,0xF,false))
        DPPADD_(0xB1);DPPADD_(0x4E);DPPADD_(0x141);
        #undef DPPADD_
        const float rn=0.8f/sqrtf(ss*(1.f/128.f)+1e-5f); const int row=i*8+(lane>>3),ch=lane&7;
        #pragma unroll
        for(int ps=0;ps<2;++ps){ const float*gp=gsub+64*ps+ch*8; u32x4 w;
          #pragma unroll
          for(int k=0;k<4;++k)w[k]=cvtpk_s(oc[ps][i][2*k]*rn*gp[2*k],oc[ps][i][2*k+1]*rn*gp[2*k+1]);
          ATTN_STORE16(Nw+(long)row*OP+64*ps+ch*8,w); } } } }
  asm volatile("s_waitcnt lgkmcnt(0)\n\ts_barrier":::"memory");
  #undef DMA_K2
  #undef DMA_V2
  #undef CMASK2
  #undef RESC2
  #undef ROT2
}
constexpr int ATTN128_LDS_BYTES=L2_BYTES;
struct Order128 {
  int vcu, G;
  __device__ __forceinline__ explicit Order128(int grid,int v):vcu(v),G(grid){}
  __device__ __forceinline__ bool next(int i,AttnUnit&u)const{ const int c=(vcu>>2)+(i>>3)*(G>>2); if(c>=64)return false; const int s=(i>>1)&3,qt=vcu&3;
    u.combo=c*2+(i&1); u.qb=(s==0)?15-qt:(s==1)?8+qt:(s==2)?7-qt:qt; return true; }
};
template<class Sched,class Hook,int THRL=8> __device__ __forceinline__ void attn_phase128(char*lds,const AttnTensors&T,const Sched&S,const int wid,const Hook&H,const float lam){
  AttnUnit u;
  for(int i=0;S.next(i,u);++i){ H(i); const int hm=u.combo&15,b=u.combo>>4,h=hm>>1;
    attn_unit128<THRL>(wid,b,hm*64,h*128,h*128,u.qb,T.Q,T.K,T.V,T.O,lds,hm&1,lam); }
}
constexpr int ATTN_LDS_BYTES=LDS_BYTES;
struct StaticOrder {
  int vcu, G;
  __device__ __forceinline__ explicit StaticOrder(int grid,int v):vcu(v),G(grid){}
  __device__ __forceinline__ bool next(int i,AttnUnit&u)const{ const int c=vcu+(i>>4)*G; if(c>=256)return false; u.combo=c; u.qb=15-(i&15); return true; }
};
template<class Sched,class Hook,int THRL=8> __device__ __forceinline__ void attn_phase(char*lds,const AttnTensors&T,const Sched&S,const int wid,const Hook&H){
  AttnUnit u;
  for(int i=0;S.next(i,u);++i){ H(i); const int vh=u.combo&1,hm=(u.combo>>1)&15,b=u.combo>>5;
    attn_unit<THRL>(wid,b,hm*64,(hm>>1)*128+vh*64,(hm*2+vh)*64,u.qb,T.Q,T.K,T.V,T.O,lds); }
}
#undef SBAR
#undef WAIT_BAR
}
#define GAS __attribute__((address_space(1)))
#define LAS __attribute__((address_space(3)))
typedef unsigned short bf16;
typedef unsigned v4u __attribute__((ext_vector_type(4)));
typedef float f32x4 __attribute__((ext_vector_type(4)));
typedef short bf16x8 __attribute__((ext_vector_type(8)));
typedef GAS unsigned gu32;
typedef GAS unsigned long long gu64;
#define RLX_AGENT __ATOMIC_RELAXED, __HIP_MEMORY_SCOPE_AGENT
#define LDS_WAIT() asm volatile("s_waitcnt lgkmcnt(0)" ::: "memory")
#define VM_WAIT() asm volatile("s_waitcnt vmcnt(0)" ::: "memory")
__device__ __forceinline__ unsigned long long rt() { return __builtin_amdgcn_s_memrealtime(); }
__device__ __forceinline__ unsigned f2bf(float f) { unsigned u = __builtin_bit_cast(unsigned, f); return (u + 0x7fffu + ((u >> 16) & 1u)) >> 16; }
__device__ __forceinline__ unsigned pk2(float lo, float hi) { return f2bf(lo) | (f2bf(hi) << 16); }

#define XB_TMO      128
#define XB_XCNT(j)  (256  + 64 * (j))
#define XB_XSUB(j)  (1280 + 64 * (j))
#define XB_XGEN(j)  (2304 + 64 * (j))
#define XB_TOP      3328
#define XB_TOPGEN   3392
#define XCD_BAR_WORDS 3456
#define XB_SPIN_CAP (1u << 18)

__device__ __forceinline__ unsigned xb_ld(unsigned* p)              { return __hip_atomic_load(p, __ATOMIC_RELAXED, __HIP_MEMORY_SCOPE_AGENT); }
__device__ __forceinline__ unsigned xb_add(unsigned* p, unsigned v) { return __hip_atomic_fetch_add(p, v, __ATOMIC_RELAXED, __HIP_MEMORY_SCOPE_AGENT); }
__device__ __forceinline__ unsigned xb_xcc_id() { return (unsigned)__builtin_amdgcn_s_getreg((3 << 11) | 20) & 0xFu; }
#define XB_SPIN(cond, bar) do { unsigned _sp = 0; while (cond) { __builtin_amdgcn_s_sleep(1); \
    if ((++_sp & 255u) == 0u) { if (xb_ld(&(bar)[XB_TMO])) break; if (_sp > XB_SPIN_CAP) { atomicAdd(&(bar)[XB_TMO], 1u); break; } } } } while (0)

struct XcdBarrier {
    unsigned* bar; unsigned x; int wave;
    volatile LAS unsigned* st;
};

__device__ __forceinline__ XcdBarrier xcd_barrier_post(unsigned* bar, volatile LAS unsigned* st) {
    XcdBarrier b; b.bar = bar; b.x = xb_xcc_id(); b.st = st; b.wave = 0;
    if (threadIdx.x == 0) (void)xb_add(&bar[XB_XCNT(b.x)], 1u);
    return b;
}
__device__ __forceinline__ void xcd_barrier_complete(unsigned* bar, unsigned x, unsigned& nloc, unsigned& nx) {
    const unsigned G = gridDim.x * gridDim.y * gridDim.z;
    unsigned sum, cnt, mine, sp = 0u;
    for (;;) {
        sum = 0u; cnt = 0u; mine = 0u;
#pragma unroll
        for (unsigned j = 0; j < 16; ++j) { const unsigned c = xb_ld(&bar[XB_XCNT(j)]); sum += c; cnt += (c > 0u) ? 1u : 0u; mine = (j == x) ? c : mine; }
        if (sum == G) break;
        __builtin_amdgcn_s_sleep(1);
        if ((++sp & 255u) == 0u) { if (xb_ld(&bar[XB_TMO])) break; if (sp > XB_SPIN_CAP) { atomicAdd(&bar[XB_TMO], 1u); break; } }
    }
    nloc = mine > 0u ? mine : 1u; nx = cnt > 0u ? cnt : 1u;
}

__device__ __forceinline__ void xcd_barrier(const XcdBarrier& b) {
    asm volatile("s_waitcnt vmcnt(0)" ::: "memory");
    __syncthreads();
    if (b.wave == 0 && mk_lane_now() == 0) {
        unsigned* bar = b.bar;
        __builtin_amdgcn_s_waitcnt(0);
        unsigned nloc = b.st[0], nx = b.st[1];
        if (nloc == 0u) { xcd_barrier_complete(bar, b.x, nloc, nx); b.st[0] = nloc; b.st[1] = nx; }
        const unsigned old = xb_add(&bar[XB_XSUB(b.x)], 1u);
        const unsigned gen = old / nloc;
        if (old + 1u == (gen + 1u) * nloc) {
            __builtin_amdgcn_fence(__ATOMIC_RELEASE, "agent");
            asm volatile("s_waitcnt vmcnt(0)" ::: "memory");
            const unsigned og = xb_add(&bar[XB_TOP], 1u);
            const unsigned tg = og / nx;
            if (og + 1u == (tg + 1u) * nx) xb_add(&bar[XB_TOPGEN], 1u);
            else XB_SPIN(xb_ld(&bar[XB_TOPGEN]) == tg, bar);
            __builtin_amdgcn_fence(__ATOMIC_ACQUIRE, "agent");
            xb_add(&bar[XB_XGEN(b.x)], 1u);
            asm volatile("s_waitcnt vmcnt(0)" ::: "memory");
        } else {
            XB_SPIN(xb_ld(&bar[XB_XGEN(b.x)]) == gen, bar);
            __builtin_amdgcn_fence(__ATOMIC_ACQUIRE, "agent");
            asm volatile("s_waitcnt vmcnt(0)" ::: "memory");
        }
    }
    __syncthreads();
}


constexpr int NWAVES = 8;
constexpr size_t MiB = 1u << 20;
constexpr size_t WS_CTL = 0, CTL_ZERO_BYTES = 1 * MiB;
constexpr size_t WS_MOD = 1 * MiB;
constexpr size_t WS_BINP = 1 * MiB + 256 * 1024;
constexpr size_t WS_TOPI = 2 * MiB, WS_TOPG = 3 * MiB;
constexpr size_t WS_LIST = 4 * MiB;
constexpr size_t WS_WIN = 36 * MiB, WS_WA = 50 * MiB, WS_WP = 52 * MiB, WS_WO = 54 * MiB, WS_WR = 56 * MiB;
constexpr size_t WS_WDN = 60 * MiB;
constexpr size_t WS_WUP = 190 * MiB;
constexpr size_t WS_YS = 190 * MiB;
constexpr size_t WS_S0 = 448 * MiB, WS_SLOT = 64 * MiB;
constexpr size_t WS_Q = WS_S0, WS_K = WS_S0 + WS_SLOT, WS_V = WS_S0 + 2 * WS_SLOT, WS_U = WS_S0 + 3 * WS_SLOT, WS_SGA = WS_S0 + 4 * WS_SLOT, WS_SGB = WS_S0 + 5 * WS_SLOT;
constexpr size_t WS_CACT = WS_S0 + 6 * WS_SLOT, WS_H = WS_S0 + 7 * WS_SLOT, WS_OATT = WS_S0 + 7 * WS_SLOT;
constexpr size_t WS_ON = WS_S0 + 8 * WS_SLOT, WS_YA = WS_S0 + WS_SLOT, WS_M = WS_S0 + 2 * WS_SLOT, WS_Z = WS_S0 + 7 * WS_SLOT, WS_H2 = WS_S0, WS_LG = WS_S0 + WS_SLOT, WS_HID = WS_S0 + 4 * WS_SLOT;
constexpr size_t WS_END = 1024 * MiB;
static_assert(WS_WDN + (size_t)NEX_ * 1024 * 256 * 2 <= WS_WUP && WS_WUP + (size_t)NEX_ * 512 * 1024 * 2 <= WS_S0 && WS_YS + (size_t)T_ * 8 * 1024 * 2 <= WS_HID, "d_ws map");
static_assert(WS_HID + (size_t)1408 * 256 * 256 * 2 <= WS_Z && WS_Z + (size_t)T_ * D_ * 4 <= WS_END, "d_ws map 2");
constexpr int CW_TMO = 0, CW_CODE = 1;
constexpr int CW_BAR = 4096;
constexpr int CW_CNT = 32768;
constexpr int CW_ERR = 65536;
constexpr int RING_OFF = 0, RING_BYTES = 131072;
constexpr int LDSCTL_OFF = RING_BYTES, MISC_OFF = LDSCTL_OFF + 320;
constexpr int UT_OFF = 132096, TAB_OFF = 133120, TOK_OFF = 137216, MAXU = 32, MAXTOK = 26;
constexpr int LDS_BYTES = TOK_OFF + MAXTOK * 1024;
static_assert(MISC_OFF + 128 <= UT_OFF && UT_OFF + MAXU * 32 <= TAB_OFF && TAB_OFF + 3 * 260 * 4 <= TOK_OFF && LDS_BYTES <= 163840, "LDS map");

enum { I_X = 0, I_C, I_ADAW, I_ADAB, I_WIN, I_BIN, I_LQ1, I_LK1, I_LQ2, I_LK2, I_SUBG, I_WAO, I_CW, I_CB, I_CLG, I_CLB, I_PWW, I_PWB, I_WOUT, I_LN1G, I_LN1B,
       I_RW, I_RB, I_W1, I_W3, I_W2, I_WS1, I_WS3, I_WS2, I_LN2G, I_LN2B, N_IN };
struct Args { const float* in[N_IN]; float* out; unsigned char* ws; int ph_lo, ph_hi; };
static_assert(sizeof(Args) == N_IN * 8 + 24, "Args has no padding");
typedef const __attribute__((address_space(4))) Args* CArgs;
__device__ __forceinline__ CArgs args_now() { auto p = __builtin_amdgcn_kernarg_segment_ptr(); asm volatile("" : "+s"(p)); return (CArgs)p; }
struct Frame {
    LAS unsigned char* lds; volatile LAS unsigned* MISC; gu32* ctl;
    int tid, lane, wave, vcu, G;
};
__device__ __forceinline__ float wave_sum(float v) {
#pragma unroll
    for (int o = 1; o < 64; o <<= 1) v += __shfl_xor(v, o);
    return v;
}
__device__ __forceinline__ float wave_sum63(float v) {
#define DPP_ADD(ctrl, rmask) v += __uint_as_float((unsigned)__builtin_amdgcn_update_dpp(0, (int)__float_as_uint(v), ctrl, rmask, 0xF, false))
    DPP_ADD(0xB1, 0xF);
    DPP_ADD(0x4E, 0xF);
    DPP_ADD(0x141, 0xF);
    DPP_ADD(0x140, 0xF);
    DPP_ADD(0x142, 0xA);
    DPP_ADD(0x143, 0xC);
#undef DPP_ADD
    return v;
}
__device__ __forceinline__ float sigm_f(float x) { return __builtin_amdgcn_rcpf(1.0f + __builtin_amdgcn_exp2f(-x * LOG2E_)); }
__device__ __forceinline__ unsigned pkbf(float lo, float hi) { return pg8::cvt_pk_bf16(lo, hi); }
__device__ __forceinline__ float bflo(unsigned w) { return __uint_as_float(w << 16); }
__device__ __forceinline__ float bfhi(unsigned w) { return __uint_as_float(w & 0xffff0000u); }

__host__ __device__ __forceinline__ int in_dest_row(int col) {
    if (col < 3072) return col;
    if (col < 5120) { const int r = col - 3072, half = r >> 10, rr = r & 1023; return 3072 + (rr >> 7) * 256 + half * 128 + (rr & 127); }
    const int r = col - 5120, half = r >> 10, rr = r & 1023; return 5120 + (rr >> 7) * 256 + half * 128 + (rr & 127);
}
__host__ __device__ __forceinline__ int in_orig_col(int rho) {
    if (rho < 3072) return rho;
    if (rho < 5120) { const int r = rho - 3072, j = r >> 8, w = r & 255; return 3072 + (w >> 7) * 1024 + j * 128 + (w & 127); }
    const int r = rho - 5120, j = r >> 8, w = r & 255; return 5120 + (w >> 7) * 1024 + j * 128 + (w & 127);
}

constexpr int CV_IN = 16 * 112, CV_SQ = 16 * 16, CV_R = 16 * 4, CV_EX = NEX_ * 64, CV_SMALL = CV_IN + 3 * CV_SQ + CV_R, CV_ALL = CV_SMALL + 3 * CV_EX;
struct CvItem { const GAS f32x4* src; GAS v4u* dst; int K, N; };
__device__ __forceinline__ CvItem cv_decode(CArgs A, int it, int lane) {
    unsigned char* ws = A->ws; const int n4 = (lane & 15) * 4, kbl = (lane >> 4) * 8;
    const float* src; bf16* dst; int K, N, k0, n0; int r = it;
    if (r < CV_IN) { const int kb = r / 112, nb = r % 112; K = 1024; N = NIN_; k0 = kb * 64; n0 = nb * 64; src = A->in[I_WIN]; dst = (bf16*)(ws + WS_WIN) + (size_t)in_dest_row(n0) * 1024; }
    else if ((r -= CV_IN) < 3 * CV_SQ) { const int w = r / CV_SQ, q = r % CV_SQ, kb = q / 16, nb = q % 16; K = 1024; N = 1024; k0 = kb * 64; n0 = nb * 64;
        src = w == 0 ? A->in[I_WAO] : (w == 1 ? A->in[I_PWW] : A->in[I_WOUT]); dst = (bf16*)(ws + (w == 0 ? WS_WA : (w == 1 ? WS_WP : WS_WO))) + (size_t)n0 * 1024; }
    else if ((r -= 3 * CV_SQ) < CV_R) { const int kb = r / 4, nb = r % 4; K = 1024; N = 256; k0 = kb * 64; n0 = nb * 64; src = A->in[I_RW]; dst = (bf16*)(ws + WS_WR) + (size_t)n0 * 1024; }
    else if ((r -= CV_R) < 2 * CV_EX) { const int w3 = r >= CV_EX; if (w3) r -= CV_EX; const int e = r / 64, q = r % 64, kb = q / 4, nb = q % 4; K = 1024; N = 256; k0 = kb * 64; n0 = nb * 64;
        src = e < NE_ ? (w3 ? A->in[I_W3] : A->in[I_W1]) + (size_t)e * 262144 : (w3 ? A->in[I_WS3] : A->in[I_WS1]);
        dst = (bf16*)(ws + WS_WUP) + ((size_t)e * 512 + (n0 >> 7) * 256 + w3 * 128 + (n0 & 127)) * 1024; }
    else { r -= 2 * CV_EX; const int e = r / 64, q = r % 64, kb = q / 16, nb = q % 16; K = 256; N = 1024; k0 = kb * 64; n0 = nb * 64;
        src = e < NE_ ? A->in[I_W2] + (size_t)e * 262144 : A->in[I_WS2]; dst = (bf16*)(ws + WS_WDN) + ((size_t)e * 1024 + n0) * 256; }
    CvItem c; c.src = (const GAS f32x4*)(src + (size_t)(k0 + kbl) * N + n0 + n4); c.dst = (GAS v4u*)(dst + (size_t)n4 * K + k0 + kbl); c.K = K; c.N = N; return c;
}
#define CV_LOAD(c, v) do { _Pragma("unroll") for (int p_ = 0; p_ < 2; ++p_) _Pragma("unroll") for (int j_ = 0; j_ < 8; ++j_) v[p_][j_] = (c).src[((size_t)(32 * p_ + j_) * (c).N) >> 2]; } while (0)
#define CV_STORE(c, v) do { _Pragma("unroll") for (int p_ = 0; p_ < 2; ++p_) _Pragma("unroll") for (int c_ = 0; c_ < 4; ++c_) { v4u o_; \
        o_.x = pkbf(v[p_][0][c_], v[p_][1][c_]); o_.y = pkbf(v[p_][2][c_], v[p_][3][c_]); o_.z = pkbf(v[p_][4][c_], v[p_][5][c_]); o_.w = pkbf(v[p_][6][c_], v[p_][7][c_]); \
        (c).dst[((size_t)c_ * (c).K + 32 * p_) >> 3] = o_; } } while (0)
__device__ __forceinline__ void convert_items(CArgs A, int gw, int NGW, int lane, int first, int last) {
    int it = first + gw; if (it >= last) return;
    CvItem cur = cv_decode(A, it, lane); f32x4 v[2][8]; CV_LOAD(cur, v);
    for (;;) {
        const int nx = it + NGW; const bool more = nx < last;
        CvItem nxt = cur; f32x4 w[2][8];
        if (more) { nxt = cv_decode(A, nx, lane); CV_LOAD(nxt, w); }
        CV_STORE(cur, v);
        if (!more) break;
#pragma unroll
        for (int p_ = 0; p_ < 2; ++p_)
#pragma unroll
            for (int j_ = 0; j_ < 8; ++j_) v[p_][j_] = w[p_][j_];
        cur = nxt; it = nx;
    }
}
struct ConvHook { CArgs A; int gw, NGW, pos;
    __device__ __forceinline__ void operator()(int i) const { if (i == pos) { convert_items(A, gw, NGW, mk_lane_now(), CV_SMALL, CV_ALL); asm volatile("s_waitcnt vmcnt(0)" ::: "memory"); } } };
__device__ __forceinline__ void p0_prologue(Frame& F, CArgs A) {
    unsigned char* ws = A->ws;
    if (blockIdx.x < 192) {
        LAS float* sc = (LAS float*)(F.lds); LAS float* part = (LAS float*)(F.lds + 32768);
        const float* c = A->in[I_C];
        for (int i = F.tid; i < 8192; i += 512) { const float v = c[i]; sc[i] = v * sigm_f(v); }
        __syncthreads();
        const int j0 = blockIdx.x * 32, kg = F.tid >> 5, col = F.tid & 31;
        const float* w = A->in[I_ADAW] + (size_t)(kg * 64) * 6144 + j0 + col;
        float acc[8] = {0.f, 0.f, 0.f, 0.f, 0.f, 0.f, 0.f, 0.f};
#pragma unroll 8
        for (int kk = 0; kk < 64; ++kk) { const float wv = w[(size_t)kk * 6144]; const int k = kg * 64 + kk;
#pragma unroll
            for (int b = 0; b < 8; ++b) acc[b] += sc[b * 1024 + k] * wv; }
#pragma unroll
        for (int b = 0; b < 8; ++b) part[(kg * 8 + b) * 32 + col] = acc[b];
        __syncthreads();
        if (F.tid < 256) { const int b = F.tid >> 5, cc = F.tid & 31; float s = A->in[I_ADAB][j0 + cc];
            for (int g = 0; g < 16; ++g) s += part[(g * 8 + b) * 32 + cc];
            ((float*)(ws + WS_MOD))[b * 6144 + j0 + cc] = s; }
        __syncthreads();
    }
    { const int gt = blockIdx.x * 512 + F.tid; if (gt < NIN_) ((float*)(ws + WS_BINP))[gt] = A->in[I_BIN][in_orig_col(gt)]; }
    convert_items(A, F.vcu * NWAVES + F.wave, F.G * NWAVES, F.lane, 0, CV_SMALL);
}
__device__ __forceinline__ void p1_modulate(Frame& F, CArgs A) {
    const int gw = F.vcu * NWAVES + F.wave, NGW = F.G * NWAVES;
    const float* mod = (const float*)(A->ws + WS_MOD); bf16* H = (bf16*)(A->ws + WS_H);
    for (int m = gw; m < T_; m += NGW) { const int b = m >> 12;
        const GAS f32x4* xr = (const GAS f32x4*)(A->in[I_X] + (size_t)m * D_) + F.lane;
        const f32x4* sh = (const f32x4*)(mod + b * 6144) + F.lane; const f32x4* sc = (const f32x4*)(mod + b * 6144 + 1024) + F.lane;
        GAS unsigned long long* o8 = (GAS unsigned long long*)(H + (size_t)m * D_) + F.lane;
#pragma unroll
        for (int j = 0; j < 4; ++j) { const f32x4 v = xr[64 * j], s = sc[64 * j], h = sh[64 * j]; const f32x4 o = v * (s + 1.0f) + h;
            o8[64 * j] = (unsigned long long)pkbf(o.x, o.y) | ((unsigned long long)pkbf(o.z, o.w) << 32); } }
}
__device__ __forceinline__ void p3_conv(Frame& F, CArgs A) {
    typedef float f32x2 __attribute__((ext_vector_type(2)));
    LAS unsigned* U = (LAS unsigned*)(F.lds);
    LAS v4u* U16 = (LAS v4u*)(F.lds);
    LAS float* ST = (LAS float*)(F.lds + 126976);
    LAS float* MS = ST + 256;
    const bf16* ug = (const bf16*)(A->ws + WS_U); unsigned* co = (unsigned*)(A->ws + WS_CACT);
    const int c0 = 2 * F.tid;
    f32x2 w[31];
#pragma unroll
    for (int j = 0; j < 31; ++j) w[j] = *(const f32x2*)(A->in[I_CW] + j * 1024 + c0);
    const f32x2 cb = *(const f32x2*)(A->in[I_CB] + c0), g = *(const f32x2*)(A->in[I_CLG] + c0), be = *(const f32x2*)(A->in[I_CLB] + c0);
    for (int tile = F.vcu; tile < T_ / 32; tile += F.G) {
        const int t0 = tile * 32, tb = t0 & (SEQ_ - 1);
        {
            v4u sv[16];
#pragma unroll
            for (int i = 0; i < 16; ++i) { const int ch = F.tid + 512 * i, r = ch >> 7, cc = ch & 127; const int pos = tb - 30 + r;
                sv[i] = (v4u){0u, 0u, 0u, 0u}; if (ch < 62 * 128 && pos >= 0) sv[i] = *(const GAS v4u*)(ug + (size_t)(t0 - 30 + r) * D_ + cc * 8); }
#pragma unroll
            for (int i = 0; i < 16; ++i) { const int ch = F.tid + 512 * i; if (ch < 62 * 128) U16[ch] = sv[i]; }
        }
        __syncthreads();
#pragma unroll 1
        for (int half = 0; half < 2; ++half) {
            f32x2 y[16];
#pragma unroll
            for (int chunk = 0; chunk < 2; ++chunk) {
                f32x2 v[38];
#pragma unroll
                for (int r = 0; r < 38; ++r) { const unsigned x = U[(half * 16 + chunk * 8 + r) * 512 + F.tid]; v[r] = (f32x2){bflo(x), bfhi(x)}; }
#pragma unroll
                for (int tt = 0; tt < 8; ++tt) { f32x2 a = cb;
#pragma unroll
                    for (int j = 0; j < 31; ++j) a = __builtin_elementwise_fma(w[j], v[tt + j], a);
                    y[chunk * 8 + tt] = a; }
            }
#pragma unroll
            for (int tt = 0; tt < 16; ++tt) { const float s = wave_sum63(y[tt].x + y[tt].y), q = wave_sum63(y[tt].x * y[tt].x + y[tt].y * y[tt].y);
                if (F.lane == 63) { ST[(F.wave * 16 + tt) * 2] = s; ST[(F.wave * 16 + tt) * 2 + 1] = q; } }
            __syncthreads();
            if (F.tid < 16) { float s = 0.f, q = 0.f;
                for (int wv = 0; wv < 8; ++wv) { s += ST[(wv * 16 + F.tid) * 2]; q += ST[(wv * 16 + F.tid) * 2 + 1]; }
                const float mean = s * (1.f / 1024.f), var = q * (1.f / 1024.f) - mean * mean;
                MS[F.tid * 2] = mean; MS[F.tid * 2 + 1] = 1.0f / sqrtf(fmaxf(var, 0.f) + LN_EPS_); }
            __syncthreads();
#pragma unroll
            for (int tt = 0; tt < 16; ++tt) { const float mean = MS[tt * 2], rstd = MS[tt * 2 + 1];
                const f32x2 z = (y[tt] - mean) * rstd * g + be;
                co[((size_t)(t0 + half * 16 + tt) * D_ + c0) >> 1] = pkbf(z.x * sigm_f(z.x), z.y * sigm_f(z.y)); }
        }
        __syncthreads();
    }
}
__device__ __forceinline__ void p4_onorm(Frame& F, CArgs A) {
    const int gw = F.vcu * NWAVES + F.wave, NGW = F.G * NWAVES;
    const float s1 = wave_sum(A->in[I_LQ1][F.lane] * A->in[I_LK1][F.lane]), s2 = wave_sum(A->in[I_LQ2][F.lane] * A->in[I_LK2][F.lane]);
    const float lam = expf(s1) - expf(s2) + LAM_INIT_;
    const int h = F.lane >> 3, dv0 = (F.lane & 7) * 16;
    float g[16];
#pragma unroll
    for (int i = 0; i < 16; ++i) g[i] = A->in[I_SUBG][dv0 + i] * (1.0f - LAM_INIT_);
    const bf16* O = (const bf16*)(A->ws + WS_OATT); bf16* ON = (bf16*)(A->ws + WS_ON);
    for (int m = gw; m < T_; m += NGW) {
        const GAS v4u* p0 = (const GAS v4u*)(O + (size_t)m * 2048 + h * 256 + dv0); const GAS v4u* p1 = (const GAS v4u*)(O + (size_t)m * 2048 + h * 256 + 128 + dv0);
        const v4u a0 = p0[0], a1 = p0[1], b0 = p1[0], b1 = p1[1];
        float o[16];
#define P4_UNP(dst, A_, B_, k) { o[dst] = bflo(A_[k]) - lam * bflo(B_[k]); o[dst + 1] = bfhi(A_[k]) - lam * bfhi(B_[k]); }
        P4_UNP(0, a0, b0, 0) P4_UNP(2, a0, b0, 1) P4_UNP(4, a0, b0, 2) P4_UNP(6, a0, b0, 3) P4_UNP(8, a1, b1, 0) P4_UNP(10, a1, b1, 1) P4_UNP(12, a1, b1, 2) P4_UNP(14, a1, b1, 3)
#undef P4_UNP
        float ss = 0.f;
#pragma unroll
        for (int i = 0; i < 16; ++i) ss += o[i] * o[i];
        ss += __shfl_xor(ss, 1); ss += __shfl_xor(ss, 2); ss += __shfl_xor(ss, 4);
        const float r = 1.0f / sqrtf(ss * (1.f / 128.f) + RMS_EPS_);
        v4u w0, w1;
        w0.x = pkbf(o[0] * r * g[0], o[1] * r * g[1]); w0.y = pkbf(o[2] * r * g[2], o[3] * r * g[3]); w0.z = pkbf(o[4] * r * g[4], o[5] * r * g[5]); w0.w = pkbf(o[6] * r * g[6], o[7] * r * g[7]);
        w1.x = pkbf(o[8] * r * g[8], o[9] * r * g[9]); w1.y = pkbf(o[10] * r * g[10], o[11] * r * g[11]); w1.z = pkbf(o[12] * r * g[12], o[13] * r * g[13]); w1.w = pkbf(o[14] * r * g[14], o[15] * r * g[15]);
        GAS v4u* q = (GAS v4u*)(ON + (size_t)m * D_ + h * 128 + dv0); q[0] = w0; q[1] = w1;
    }
}
__device__ __forceinline__ void p7_ln1(Frame& F, CArgs A) {
    const int gw = F.vcu * NWAVES + F.wave, NGW = F.G * NWAVES;
    const float* mod = (const float*)(A->ws + WS_MOD); float* Z = (float*)(A->ws + WS_Z); bf16* H2 = (bf16*)(A->ws + WS_H2);
    f32x4 lg[4], lb[4];
#pragma unroll
    for (int j = 0; j < 4; ++j) { lg[j] = ((const f32x4*)A->in[I_LN1G])[F.lane + 64 * j]; lb[j] = ((const f32x4*)A->in[I_LN1B])[F.lane + 64 * j]; }
    for (int m = gw; m < T_; m += NGW) { const int b = m >> 12;
        GAS f32x4* zr = (GAS f32x4*)(Z + (size_t)m * D_) + F.lane;
        f32x4 v[4]; float s = 0.f;
#pragma unroll
        for (int j = 0; j < 4; ++j) { v[j] = zr[64 * j]; s += (v[j].x + v[j].y) + (v[j].z + v[j].w); }
        const float mean = wave_sum(s) * (1.f / D_); float s2 = 0.f;
#pragma unroll
        for (int j = 0; j < 4; ++j) { v[j] = v[j] - mean; s2 += (v[j].x * v[j].x + v[j].y * v[j].y) + (v[j].z * v[j].z + v[j].w * v[j].w); }
        const float rstd = 1.f / sqrtf(wave_sum(s2) * (1.f / D_) + LN_EPS_);
        const f32x4* sh = (const f32x4*)(mod + b * 6144 + 3072) + F.lane; const f32x4* sc = (const f32x4*)(mod + b * 6144 + 4096) + F.lane;
        GAS unsigned long long* o8 = (GAS unsigned long long*)(H2 + (size_t)m * D_) + F.lane;
#pragma unroll
        for (int j = 0; j < 4; ++j) { const f32x4 x1 = v[j] * rstd * lg[j] + lb[j]; zr[64 * j] = x1;
            const f32x4 o = x1 * (sc[64 * j] + 1.0f) + sh[64 * j];
            o8[64 * j] = (unsigned long long)pkbf(o.x, o.y) | ((unsigned long long)pkbf(o.z, o.w) << 32); }
    }
}
__device__ __forceinline__ void p9_route(Frame& F, CArgs A) {
    const float* lg = (const float*)(A->ws + WS_LG); int* topi = (int*)(A->ws + WS_TOPI); float* topg = (float*)(A->ws + WS_TOPG); int* list = (int*)(A->ws + WS_LIST);
    gu32* gcnt = F.ctl + CW_CNT;
    LAS int* hist = (LAS int*)(F.lds); LAS int* basel = hist + 256; LAS int* sel = basel + 256;
    float rb[4];
#pragma unroll
    for (int j = 0; j < 4; ++j) rb[j] = A->in[I_RB][F.lane + 64 * j];
    const int hf = F.lane >> 5;
    for (int tb = F.vcu; tb < T_ / 128; tb += F.G) {
        if (F.tid < 256) hist[F.tid] = 0;
        __syncthreads();
        for (int i = 0; i < 16; ++i) { const int t = tb * 128 + F.wave * 16 + i;
            float s[4], c[4], gs[4];
#pragma unroll
            for (int j = 0; j < 4; ++j) { s[j] = sigm_f(lg[(size_t)t * NE_ + F.lane + 64 * j]); c[j] = s[j] + rb[j]; }
#pragma unroll
            for (int j = 0; j < 4; ++j) { float m1 = c[j];
#pragma unroll
                for (int o = 1; o < 32; o <<= 1) m1 = fmaxf(m1, __shfl_xor(m1, o));
                const unsigned long long bal = __ballot(c[j] == m1); const unsigned hb = hf ? (unsigned)(bal >> 32) : (unsigned)bal; const int first = (__ffs((int)hb) - 1) + (F.lane & 32);
                float m2 = (F.lane == first) ? -INFINITY : c[j];
#pragma unroll
                for (int o = 1; o < 32; o <<= 1) m2 = fmaxf(m2, __shfl_xor(m2, o));
                gs[j] = m1 + m2; }
            float G8[8];
#pragma unroll
            for (int j = 0; j < 4; ++j) { G8[2 * j] = __uint_as_float(__builtin_amdgcn_readlane(__float_as_uint(gs[j]), 0)); G8[2 * j + 1] = __uint_as_float(__builtin_amdgcn_readlane(__float_as_uint(gs[j]), 32)); }
#pragma unroll
            for (int j = 0; j < 4; ++j) { const float mine = hf ? G8[2 * j + 1] : G8[2 * j]; const int g = 2 * j + hf; int rank = 0;
#pragma unroll
                for (int gp = 0; gp < 8; ++gp) rank += (G8[gp] > mine || (G8[gp] == mine && gp < g)) ? 1 : 0;
                if (rank >= 4) c[j] = -INFINITY; }
            int ek = 0; float sk = 0.f, ssum = 0.f;
#pragma unroll
            for (int k = 0; k < 8; ++k) { float wm = fmaxf(fmaxf(c[0], c[1]), fmaxf(c[2], c[3]));
#pragma unroll
                for (int o = 1; o < 64; o <<= 1) wm = fmaxf(wm, __shfl_xor(wm, o));
                int e = 0x7fffffff;
#pragma unroll
                for (int j = 3; j >= 0; --j) if (c[j] == wm) e = F.lane + 64 * j;
#pragma unroll
                for (int o = 1; o < 64; o <<= 1) e = min(e, __shfl_xor(e, o));
                float sv = 0.f;
#pragma unroll
                for (int j = 0; j < 4; ++j) if (F.lane + 64 * j == e) { sv = s[j]; c[j] = -INFINITY; }
                sv = __shfl(sv, e & 63);
                ssum += sv; if (F.lane == k) { ek = e; sk = sv; } }
            if (F.lane < 8) { const int a = t * 8 + F.lane; topi[a] = ek; topg[a] = sk / ssum * ROUTED_SCALE_;
                const int lr = __hip_atomic_fetch_add(&hist[ek], 1, __ATOMIC_RELAXED, __HIP_MEMORY_SCOPE_WORKGROUP); sel[(F.wave * 16 + i) * 8 + F.lane] = ek | (lr << 16); }
        }
        __syncthreads();
        if (F.tid < 256) { const int h = hist[F.tid]; int base = 0; if (h > 0) base = (int)__hip_atomic_fetch_add(gcnt + 64 * F.tid, (unsigned)h, __ATOMIC_RELAXED, __HIP_MEMORY_SCOPE_AGENT); basel[F.tid] = base; }
        __syncthreads();
        for (int q = F.lane; q < 128; q += 64) { const int i = q >> 3, k = q & 7, v = sel[(F.wave * 16 + i) * 8 + k], e = v & 0xffff, lr = v >> 16, t = tb * 128 + F.wave * 16 + i;
            list[(size_t)e * T_ + basel[e] + lr] = t * 8 + k; }
        __syncthreads();
    }
}
template <int NP, int FILL_TOK>
__device__ __forceinline__ int moe_setup(Frame& F, CArgs A) {
    LAS int* UT = (LAS int*)(F.lds + UT_OFF); LAS int* NT = (LAS int*)(F.lds + TAB_OFF); LAS int* TS = NT + 260; LAS int* CN = TS + 260; LAS int* TOK = (LAS int*)(F.lds + TOK_OFF);
    const int* list = (const int*)(A->ws + WS_LIST);
    if (F.tid < NEX_) { int c = T_; if (F.tid < NE_) { c = (int)__hip_atomic_load(F.ctl + CW_CNT + 64 * F.tid, __ATOMIC_RELAXED, __HIP_MEMORY_SCOPE_AGENT); c = c < 0 ? 0 : (c > T_ ? T_ : c); } CN[F.tid] = c; NT[F.tid] = (c + 255) >> 8; }
    __syncthreads();
    if (F.wave == 0) { int loc[5]; int s = 0;
#pragma unroll
        for (int i = 0; i < 5; ++i) { const int idx = 5 * F.lane + i; loc[i] = s; s += (idx < NEX_) ? NT[idx] : 0; }
        int incl = s;
#pragma unroll
        for (int o = 1; o < 64; o <<= 1) { const int n = __shfl_up(incl, o); if (F.lane >= o) incl += n; }
        const int excl = incl - s;
#pragma unroll
        for (int i = 0; i < 5; ++i) { const int idx = 5 * F.lane + i; if (idx < NEX_) TS[idx] = excl + loc[i]; }
        if (F.lane == 63) TS[NEX_] = incl; }
    __syncthreads();
    const int total = TS[NEX_] * NP;
    int nun = (F.vcu < total) ? (total - F.vcu + F.G - 1) / F.G : 0;
    if (nun > MAXTOK) { nun = MAXTOK; if (F.tid == 0) __hip_atomic_store(F.ctl + CW_TMO, 0xBAD0u, RLX_AGENT); }
    if (F.tid < nun) { const int L = F.tid * F.G + F.vcu, rtg = L / NP, pn = L % NP; int lo = 0, hi = NE_;
        while (lo < hi) { const int mid = (lo + hi + 1) >> 1; if (TS[mid] <= rtg) lo = mid; else hi = mid - 1; }
        const int e = lo, rt = rtg - TS[e]; int nr = CN[e] - rt * 256; nr = nr > 256 ? 256 : nr;
        UT[F.tid * 8 + 0] = e; UT[F.tid * 8 + 1] = rt; UT[F.tid * 8 + 2] = pn; UT[F.tid * 8 + 3] = nr; UT[F.tid * 8 + 4] = rtg; }
    __syncthreads();
    { const float* gate = (const float*)(A->ws + WS_TOPG);
        for (int sl = 0; sl < nun; ++sl) if (F.tid < 256) { const int e = UT[sl * 8], rt = UT[sl * 8 + 1], nr = UT[sl * 8 + 3]; int w = 0;
            if (F.tid < nr) { if (e < NE_) { const int a = list[(size_t)e * T_ + rt * 256 + F.tid];
                    if (FILL_TOK == 1) w = a >> 3; else { int gq = (int)(gate[a] * (16383.0f / ROUTED_SCALE_) + 0.5f); gq = gq > 16383 ? 16383 : gq; w = a | (gq << 18); } }
                else w = (FILL_TOK == 1) ? (rt * 256 + F.tid) : 0; }
            TOK[sl * 256 + F.tid] = w; }
        __syncthreads(); }
    return nun;
}
__device__ __forceinline__ void p12_final(Frame& F, CArgs A, bool poison) {
    typedef float f32x2 __attribute__((ext_vector_type(2)));
    const int gw = F.vcu * NWAVES + F.wave, NGW = F.G * NWAVES;
    const float* mod = (const float*)(A->ws + WS_MOD); const float* XB = (const float*)(A->ws + WS_Z); const unsigned char* YS = (const unsigned char*)(A->ws + WS_YS);
    const float qnan = __builtin_nanf(""); const int c = 16 * F.lane;
    for (int m0 = gw; m0 < T_; m0 += 2 * NGW) {
        v4u yw[2][8]; f32x4 xb[2][4];
#pragma unroll
        for (int rr = 0; rr < 2; ++rr) { const int m = (m0 + rr * NGW < T_) ? m0 + rr * NGW : m0;
#pragma unroll
            for (int k = 0; k < 8; ++k) yw[rr][k] = *(const GAS v4u*)(YS + ((size_t)m * 8 + k) * D_ + c);
#pragma unroll
            for (int q = 0; q < 4; ++q) xb[rr][q] = *(const GAS f32x4*)(XB + (size_t)m * D_ + c + 4 * q); }
#pragma unroll
        for (int rr = 0; rr < 2; ++rr) { const int m = m0 + rr * NGW; if (m >= T_) break; const int b = m >> 12;
            f32x4 v[4]; float s = 0.f;
#pragma unroll
            for (int q = 0; q < 4; ++q) { f32x4 a = (f32x4){0.f, 0.f, 0.f, 0.f};
#pragma unroll
                for (int k = 0; k < 8; ++k) { const int w = (int)yw[rr][k][q]; const f32x2 lo = __builtin_amdgcn_cvt_pk_f32_fp8(w, false), hi = __builtin_amdgcn_cvt_pk_f32_fp8(w, true); a += (f32x4){lo.x, lo.y, hi.x, hi.y}; }
                const f32x4 g = *(const f32x4*)(mod + b * 6144 + 5120 + c + 4 * q) * (1.0f / pg8::YS_SCALE);
                v[q] = xb[rr][q] + g * a; s += (v[q].x + v[q].y) + (v[q].z + v[q].w); }
            const float mean = wave_sum(s) * (1.f / D_); float s2 = 0.f;
#pragma unroll
            for (int q = 0; q < 4; ++q) { v[q] = v[q] - mean; s2 += (v[q].x * v[q].x + v[q].y * v[q].y) + (v[q].z * v[q].z + v[q].w * v[q].w); }
            const float rstd = 1.f / sqrtf(wave_sum(s2) * (1.f / D_) + LN_EPS_);
#pragma unroll
            for (int q = 0; q < 4; ++q) { f32x4 o = v[q] * rstd * *(const f32x4*)(A->in[I_LN2G] + c + 4 * q) + *(const f32x4*)(A->in[I_LN2B] + c + 4 * q);
                if (poison) o = (f32x4){qnan, qnan, qnan, qnan};
                *(GAS f32x4*)(A->out + (size_t)m * D_ + c + 4 * q) = o; }
        }
    }
}

constexpr int NPH = 13;
#ifndef REP_PH
#define REP_PH (-1)
#endif
#ifndef REP_N
#define REP_N 2
#endif
#define NREP(k) ((k) == REP_PH ? REP_N : 1)
__global__ void __launch_bounds__(NWAVES * 64, 2) mk_fwd(Args args) {
    extern __shared__ __attribute__((aligned(16))) unsigned char lds[];
    Frame F;
    F.lds = (LAS unsigned char*)lds;
    F.MISC = (volatile LAS unsigned*)(F.lds + MISC_OFF);
    #define REFRESH() do { F.lane = mk_lane_now(); F.tid = F.wave * 64 + F.lane; } while (0)
    F.wave = __builtin_amdgcn_readfirstlane((int)threadIdx.x >> 6); REFRESH();
    F.G = gridDim.x; { const int bx = blockIdx.x; F.vcu = (F.G % 8 == 0) ? (bx % 8) * (F.G / 8) + bx / 8 : bx; }
    F.ctl = (gu32*)(args.ws + WS_CTL);
    for (int u = F.tid; u < (LDS_BYTES - LDSCTL_OFF) / 4; u += NWAVES * 64) ((LAS unsigned*)(F.lds + LDSCTL_OFF))[u] = 0u;
    __syncthreads();
    const int lo = args.ph_lo, hi = args.ph_hi;
    XcdBarrier bar; bar.bar = (unsigned*)(F.ctl + CW_BAR); bar.x = 0; bar.st = nullptr; bar.wave = F.wave;
    if (hi - lo > 1) { bar = xcd_barrier_post((unsigned*)(F.ctl + CW_BAR), F.MISC + 8); bar.wave = F.wave; }
#define IN(k) (lo <= (k) && (k) < hi)
#define BOTH(k) (IN(k) && IN((k) + 1))
#define GRID_BAR() xcd_barrier(bar)

    if (IN(0)) _Pragma("unroll") for (int rep_ = 0; rep_ < NREP(0); ++rep_) { if (rep_ > 0) GRID_BAR(); REFRESH(); CArgs A = args_now(); unsigned char* ws = A->ws; p0_prologue(F, A); if (BOTH(0)) GRID_BAR(); }
    if (IN(1)) _Pragma("unroll") for (int rep_ = 0; rep_ < NREP(1); ++rep_) { if (rep_ > 0) GRID_BAR(); REFRESH(); CArgs A = args_now(); unsigned char* ws = A->ws; p1_modulate(F, A); if (BOTH(1)) GRID_BAR(); }
    if (IN(2)) _Pragma("unroll") for (int rep_ = 0; rep_ < NREP(2); ++rep_) { if (rep_ > 0) GRID_BAR(); REFRESH(); CArgs A = args_now(); unsigned char* ws = A->ws;
        pg8::Gemm g{(const pg8::bf16_t*)(ws + WS_H), (const pg8::bf16_t*)(ws + WS_WIN)}; pg8::StaticOrder S; S.init(T_, NIN_, F.G, (int)blockIdx.x);
        pg8::EpiInproj E{(pg8::bf16_t*)(ws + WS_Q), (size_t)(WS_SLOT / 2), (pg8::bf16_t*)(ws + WS_U), (pg8::bf16_t*)(ws + WS_SGA), (pg8::bf16_t*)(ws + WS_SGB),
                         (const float*)(ws + WS_BINP), attn_body::C2};
        pg8::gemm_phase<D_, pg8::EpiInproj, pg8::StaticOrder, PG8_ALIGN, PG8_SP2, false>(F.lds + RING_OFF, g, S, E, F.wave);
        if (BOTH(2)) GRID_BAR();
    }
    if (IN(3)) _Pragma("unroll") for (int rep_ = 0; rep_ < NREP(3); ++rep_) { if (rep_ > 0) GRID_BAR(); REFRESH(); CArgs A = args_now(); unsigned char* ws = A->ws;
#ifndef REP_CONV
#define REP_CONV 1
#endif
        p3_conv(F, A); __syncthreads();
        const attn_body::AttnTensors AT{(const attn_body::bf16*)(ws + WS_Q), (const attn_body::bf16*)(ws + WS_K), (const attn_body::bf16*)(ws + WS_V), (attn_body::bf16*)(ws + WS_OATT)};
        const attn_body::Order128 S((int)F.G, F.vcu);
        static_assert(attn_body::ATTN128_LDS_BYTES <= RING_BYTES, "attention LDS");
        const int grp_ = F.vcu & 3; const ConvHook HK{A, F.vcu * NWAVES + F.wave, F.G * NWAVES, grp_ == 0 ? 0 : (grp_ == 1 ? 1 : (grp_ == 2 ? 2 : 4))};
        const float lam_ = expf(wave_sum(A->in[I_LQ1][F.lane] * A->in[I_LK1][F.lane])) - expf(wave_sum(A->in[I_LQ2][F.lane] * A->in[I_LK2][F.lane])) + LAM_INIT_;
        static_assert(WS_ON - WS_OATT == (size_t)ATTN_ON_DELTA * 2 && I_SUBG * 8 == ATTN_GSUB_KERNARG_OFF, "attention epilogue constants");
        attn_body::attn_phase128<attn_body::Order128>((char*)lds + RING_OFF, AT, S, F.wave, HK, lam_);
        if (BOTH(3)) GRID_BAR();
    }
    if (IN(4)) _Pragma("unroll") for (int rep_ = 0; rep_ < NREP(4); ++rep_) { if (rep_ > 0) GRID_BAR(); REFRESH(); CArgs A = args_now(); unsigned char* ws = A->ws; (void)ws;   }
    if (IN(5)) _Pragma("unroll") for (int rep_ = 0; rep_ < NREP(5); ++rep_) { if (rep_ > 0) GRID_BAR(); REFRESH(); CArgs A = args_now(); unsigned char* ws = A->ws;
        { pg8::Gemm g{(const pg8::bf16_t*)(ws + WS_ON), (const pg8::bf16_t*)(ws + WS_WA)}; pg8::StaticOrder S; S.init(T_, D_, F.G, (int)blockIdx.x);
          pg8::EpiYa E{(const pg8::bf16_t*)(ws + WS_SGA), (pg8::bf16_t*)(ws + WS_YA)};
          pg8::gemm_phase<D_, pg8::EpiYa, pg8::StaticOrder, PG8_ALIGN, PG8_SP2, false>(F.lds + RING_OFF, g, S, E, F.wave); }
        asm volatile("s_waitcnt vmcnt(0)" ::: "memory"); __syncthreads();
        { pg8::Gemm g{(const pg8::bf16_t*)(ws + WS_CACT), (const pg8::bf16_t*)(ws + WS_WP)}; pg8::StaticOrder S; S.init(T_, D_, F.G, (int)blockIdx.x);
          pg8::EpiM E{(const pg8::bf16_t*)(ws + WS_SGB), (const pg8::bf16_t*)(ws + WS_YA), (pg8::bf16_t*)(ws + WS_M), A->in[I_PWB]};
          pg8::gemm_phase<D_, pg8::EpiM, pg8::StaticOrder, PG8_ALIGN, PG8_SP2, false>(F.lds + RING_OFF, g, S, E, F.wave); }
        if (BOTH(5)) GRID_BAR();
    }
    if (IN(6)) _Pragma("unroll") for (int rep_ = 0; rep_ < NREP(6); ++rep_) { if (rep_ > 0) GRID_BAR(); REFRESH(); CArgs A = args_now(); unsigned char* ws = A->ws;
        pg8::Gemm g{(const pg8::bf16_t*)(ws + WS_M), (const pg8::bf16_t*)(ws + WS_WO)}; pg8::StaticOrder S; S.init(T_, D_, F.G, (int)blockIdx.x);
        pg8::EpiZ E{A->in[I_X], (const float*)(ws + WS_MOD), (float*)(ws + WS_Z)};
        pg8::gemm_phase<D_, pg8::EpiZ, pg8::StaticOrder, PG8_ALIGN, PG8_SP2, false>(F.lds + RING_OFF, g, S, E, F.wave);
        if (BOTH(6)) GRID_BAR();
    }
    if (IN(7)) _Pragma("unroll") for (int rep_ = 0; rep_ < NREP(7); ++rep_) { if (rep_ > 0) GRID_BAR(); REFRESH(); CArgs A = args_now(); unsigned char* ws = A->ws; p7_ln1(F, A); if (BOTH(7)) GRID_BAR(); }
    if (IN(8)) _Pragma("unroll") for (int rep_ = 0; rep_ < NREP(8); ++rep_) { if (rep_ > 0) GRID_BAR(); REFRESH(); CArgs A = args_now(); unsigned char* ws = A->ws;
        pg8::Gemm g{(const pg8::bf16_t*)(ws + WS_H2), (const pg8::bf16_t*)(ws + WS_WR)}; pg8::StaticOrder S; S.init(T_, NE_, F.G, (int)blockIdx.x);
        pg8::EpiLogit E{(float*)(ws + WS_LG)};
        pg8::gemm_phase<D_, pg8::EpiLogit, pg8::StaticOrder, PG8_ALIGN, PG8_SP2, false>(F.lds + RING_OFF, g, S, E, F.wave);
        if (BOTH(8)) GRID_BAR();
    }
    if (IN(9)) _Pragma("unroll") for (int rep_ = 0; rep_ < NREP(9); ++rep_) { if (rep_ > 0) GRID_BAR(); REFRESH(); CArgs A = args_now(); unsigned char* ws = A->ws; p9_route(F, A); if (BOTH(9)) GRID_BAR(); }
    if (IN(10)) _Pragma("unroll") for (int rep_ = 0; rep_ < NREP(10); ++rep_) { if (rep_ > 0) GRID_BAR(); REFRESH(); CArgs A = args_now(); unsigned char* ws = A->ws;
        const int nun = moe_setup<2, 1>(F, A);
        pg8::Gemm g{(const pg8::bf16_t*)(ws + WS_H2), (const pg8::bf16_t*)(ws + WS_WUP)};
        typedef pg8::MoeOrder<2, false, (unsigned)(D_ * 2)> OrdUp; OrdUp S{(const PG8_LAS int*)(F.lds + UT_OFF), (const PG8_LAS int*)(F.lds + TOK_OFF), nun};
        pg8::EpiSwiglu E{(pg8::bf16_t*)(ws + WS_HID)};
        pg8::gemm_phase<D_, pg8::EpiSwiglu, OrdUp, PG8_ALIGN, PG8_SP2, true>(F.lds + RING_OFF, g, S, E, F.wave);
        if (BOTH(10)) GRID_BAR();
    }
    if (IN(11)) _Pragma("unroll") for (int rep_ = 0; rep_ < NREP(11); ++rep_) { if (rep_ > 0) GRID_BAR(); REFRESH(); CArgs A = args_now(); unsigned char* ws = A->ws;
        const int nun = moe_setup<4, 2>(F, A);
        pg8::Gemm g{(const pg8::bf16_t*)(ws + WS_HID), (const pg8::bf16_t*)(ws + WS_WDN)};
        typedef pg8::MoeOrder<4, true, 0u> OrdDn; OrdDn S{(const PG8_LAS int*)(F.lds + UT_OFF), (const PG8_LAS int*)(F.lds + TOK_OFF), nun};
        pg8::EpiDown E{(const PG8_LAS int*)(F.lds + TOK_OFF), (unsigned char*)(ws + WS_YS), (float*)(ws + WS_Z), (const float*)(ws + WS_MOD)};
        pg8::gemm_phase<FE_, pg8::EpiDown, OrdDn, PG8_ALIGN, PG8_SP2, false>(F.lds + RING_OFF, g, S, E, F.wave);
        if (BOTH(11)) GRID_BAR();
    }
    if (IN(12)) _Pragma("unroll") for (int rep_ = 0; rep_ < NREP(12); ++rep_) { if (rep_ > 0) GRID_BAR(); REFRESH(); CArgs A = args_now(); unsigned char* ws = A->ws;
        bool poison = __hip_atomic_load(F.ctl + CW_TMO, RLX_AGENT) != 0u;
        poison |= __hip_atomic_load((gu32*)((const unsigned*)(F.ctl + CW_BAR) + XB_TMO), RLX_AGENT) != 0u;
        p12_final(F, A, poison);
    }
#undef IN
#undef BOTH
#undef GRID_BAR
}

#if DBG_CHECK
namespace chk {
__device__ __forceinline__ float bf2f(unsigned short h) { return __uint_as_float((unsigned)h << 16); }
__device__ __forceinline__ float rbf(float f) { unsigned u = __float_as_uint(f); u = (u + 0x7fffu + ((u >> 16) & 1u)) & 0xffff0000u; return __uint_as_float(u); }
__device__ __forceinline__ unsigned hashu(unsigned x) { x ^= x >> 16; x *= 0x7feb352dU; x ^= x >> 15; x *= 0x846ca68bU; x ^= x >> 16; return x; }
__device__ __forceinline__ void errmax(unsigned* ctl, int id, float got, float ref, float atol) { float e = fabsf(got - ref) / (fabsf(ref) + atol); if (!(e == e) || e > 1e30f) e = 1e30f; atomicMax(ctl + CW_ERR + id, __float_as_uint(e)); }
__device__ __forceinline__ float sig(float x) { return 1.0f / (1.0f + expf(-x)); }
__device__ __forceinline__ float dotbf(const unsigned short* a, const unsigned short* b, int n) { float s = 0.f; for (int k = 0; k < n; ++k) s += bf2f(a[k]) * bf2f(b[k]); return s; }
__device__ __forceinline__ float blk_sum(float v, float* sh) { __syncthreads(); sh[threadIdx.x] = v; __syncthreads(); for (int o = 128; o > 0; o >>= 1) { if ((int)threadIdx.x < o) sh[threadIdx.x] += sh[threadIdx.x + o]; __syncthreads(); } const float r = sh[0]; __syncthreads(); return r; }
__device__ __forceinline__ float blk_max(float v, float* sh) { __syncthreads(); sh[threadIdx.x] = v; __syncthreads(); for (int o = 128; o > 0; o >>= 1) { if ((int)threadIdx.x < o) sh[threadIdx.x] = fmaxf(sh[threadIdx.x], sh[threadIdx.x + o]); __syncthreads(); } const float r = sh[0]; __syncthreads(); return r; }
}
__global__ void __launch_bounds__(256) chk_phase(Args a, int ph) {
    using namespace chk;
    __shared__ float sh[256]; __shared__ float big[4096];
    unsigned char* ws = a.ws; unsigned* ctl = (unsigned*)(ws + WS_CTL);
    const int gs = blockIdx.x * 256 + threadIdx.x; const unsigned h1 = hashu(gs * 3 + 1 + ph * 7919), h2 = hashu(h1 + 17), h3 = hashu(h2 + 29);
    const float* mod = (const float*)(ws + WS_MOD);
    typedef unsigned short us;
    if (ph == 0) {
        if (gs < 512) { const int b = gs & 7, j = h1 % 6144; float s = a.in[I_ADAB][j]; for (int k = 0; k < 1024; ++k) { const float c = a.in[I_C][b * 1024 + k]; s += c * sig(c) * a.in[I_ADAW][(size_t)k * 6144 + j]; } errmax(ctl, 1, mod[b * 6144 + j], s, 0.02f); }
        const int which = (gs % 8 == 5 || gs % 8 == 6) ? 7 : gs % 8; float got = 0.f, ref = 0.f;
        if (which == 0) { const int r = h1 % NIN_, k = h2 % 1024; got = bf2f(((const us*)(ws + WS_WIN))[(size_t)r * 1024 + k]); ref = rbf(a.in[I_WIN][(size_t)k * NIN_ + in_orig_col(r)]); }
        else if (which <= 3) { const int n = h1 % 1024, k = h2 % 1024; const float* src = which == 1 ? a.in[I_WAO] : (which == 2 ? a.in[I_PWW] : a.in[I_WOUT]); const us* d = (const us*)(ws + (which == 1 ? WS_WA : (which == 2 ? WS_WP : WS_WO))); got = bf2f(d[(size_t)n * 1024 + k]); ref = rbf(src[(size_t)k * 1024 + n]); }
        else if (which == 4) { const int n = h1 % 256, k = h2 % 1024; got = bf2f(((const us*)(ws + WS_WR))[(size_t)n * 1024 + k]); ref = rbf(a.in[I_RW][(size_t)k * 256 + n]); }
        else if (which == 5) { const int e = h1 % NEX_, r = h2 % 512, k = h3 % 1024, pn = r >> 8, w = r & 255, is3 = w >> 7, n = pn * 128 + (w & 127);
            const float* src = e < NE_ ? (is3 ? a.in[I_W3] : a.in[I_W1]) + (size_t)e * 262144 : (is3 ? a.in[I_WS3] : a.in[I_WS1]);
            got = bf2f(((const us*)(ws + WS_WUP))[((size_t)e * 512 + r) * 1024 + k]); ref = rbf(src[(size_t)k * 256 + n]); }
        else if (which == 6) { const int e = h1 % NEX_, n = h2 % 1024, k = h3 % 256; const float* src = e < NE_ ? a.in[I_W2] + (size_t)e * 262144 : a.in[I_WS2];
            got = bf2f(((const us*)(ws + WS_WDN))[((size_t)e * 1024 + n) * 256 + k]); ref = rbf(src[(size_t)k * 1024 + n]); }
        else { const int r = h1 % NIN_; got = ((const float*)(ws + WS_BINP))[r]; ref = a.in[I_BIN][in_orig_col(r)]; }
        errmax(ctl, 2, got, ref, 1e-3f);
    } else if (ph == 1) {
        const int row = h1 % T_, col = h2 % D_, b = row >> 12; const float ref = a.in[I_X][(size_t)row * D_ + col] * (1.f + mod[b * 6144 + 1024 + col]) + mod[b * 6144 + col];
        errmax(ctl, 3, bf2f(((const us*)(ws + WS_H))[(size_t)row * D_ + col]), ref, 0.05f);
    } else if (ph == 2) {
        const us* H = (const us*)(ws + WS_H); const us* W = (const us*)(ws + WS_WIN); const int row = h1 % T_, col = h2 % D_; const us* hr = H + (size_t)row * D_;
        const int which = gs % 3;
        if (which == 0) { const int t = h3 % 3, oc = t * 1024 + col; float r = dotbf(hr, W + (size_t)oc * 1024, 1024) + a.in[I_BIN][oc]; if (t == 0) r *= attn_body::C2;
            errmax(ctl, 4, bf2f(((const us*)(ws + WS_Q + (size_t)t * WS_SLOT))[(size_t)row * D_ + col]), r, t == 0 ? 0.01f : 0.05f); }
        else if (which == 1) { const float av = dotbf(hr, W + (size_t)in_dest_row(3072 + col) * 1024, 1024) + a.in[I_BIN][3072 + col], bv = dotbf(hr, W + (size_t)in_dest_row(4096 + col) * 1024, 1024) + a.in[I_BIN][4096 + col];
            errmax(ctl, 5, bf2f(((const us*)(ws + WS_U))[(size_t)row * D_ + col]), av * sig(bv), 0.03f); }
        else { const float av = dotbf(hr, W + (size_t)in_dest_row(5120 + col) * 1024, 1024) + a.in[I_BIN][5120 + col], bv = dotbf(hr, W + (size_t)in_dest_row(6144 + col) * 1024, 1024) + a.in[I_BIN][6144 + col];
            errmax(ctl, 6, bf2f(((const us*)(ws + WS_SGA))[(size_t)row * D_ + col]), sig(av), 0.02f); errmax(ctl, 20, bf2f(((const us*)(ws + WS_SGB))[(size_t)row * D_ + col]), sig(bv), 0.02f); }
    } else if (ph == 3) {
        { const int which = 5 + (gs & 1); float got = 0.f, ref = 0.f;
          if (which == 5) { const int e = h1 % NEX_, r = h2 % 512, k = h3 % 1024, pn = r >> 8, w = r & 255, is3 = w >> 7, n = pn * 128 + (w & 127);
            const float* src = e < NE_ ? (is3 ? a.in[I_W3] : a.in[I_W1]) + (size_t)e * 262144 : (is3 ? a.in[I_WS3] : a.in[I_WS1]);
            got = bf2f(((const us*)(ws + WS_WUP))[((size_t)e * 512 + r) * 1024 + k]); ref = rbf(src[(size_t)k * 256 + n]); }
          else { const int e = h1 % NEX_, n = h2 % 1024, k = h3 % 256; const float* src = e < NE_ ? a.in[I_W2] + (size_t)e * 262144 : a.in[I_WS2];
            got = bf2f(((const us*)(ws + WS_WDN))[((size_t)e * 1024 + n) * 256 + k]); ref = rbf(src[(size_t)k * 1024 + n]); }
          errmax(ctl, 2, got, ref, 1e-3f); }
        {
            float s1 = 0.f, s2 = 0.f; for (int i = 0; i < 64; ++i) { s1 += a.in[I_LQ1][i] * a.in[I_LK1][i]; s2 += a.in[I_LQ2][i] * a.in[I_LK2][i]; }
            const float lam = expf(s1) - expf(s2) + LAM_INIT_;
            const unsigned hb = hashu(blockIdx.x * 977 + 5); const int b = hb & 7, hh = (hb >> 3) & 7; int row = (hb >> 8) & 4095; if (blockIdx.x < 8) row = blockIdx.x * 37;
            const us* Q = (const us*)(ws + WS_Q); const us* K = (const us*)(ws + WS_K); const us* V = (const us*)(ws + WS_V); const us* O = (const us*)(ws + WS_OATT);
            __shared__ float Om[2][128];
            for (int mp = 0; mp < 2; ++mp) { const int hm = 2 * hh + mp;
                const us* qr = Q + ((size_t)b * SEQ_ + row) * D_ + hm * 64; float mx = -INFINITY;
                for (int j = threadIdx.x; j <= row; j += 256) { const float s = dotbf(qr, K + ((size_t)b * SEQ_ + j) * D_ + hm * 64, 64); big[j] = s; mx = fmaxf(mx, s); }
                mx = blk_max(mx, sh); float l = 0.f;
                for (int j = threadIdx.x; j <= row; j += 256) { const float p = exp2f(big[j] - mx); big[j] = p; l += p; }
                l = blk_sum(l, sh);
                if (threadIdx.x < 128) { float o = 0.f; for (int j = 0; j <= row; ++j) o += big[j] * bf2f(V[((size_t)b * SEQ_ + j) * D_ + hh * 128 + threadIdx.x]); Om[mp][threadIdx.x] = o / l; }
                __syncthreads(); }
            if (threadIdx.x < 128) errmax(ctl, 7, bf2f(O[((size_t)b * SEQ_ + row) * D_ + hh * 128 + threadIdx.x]), Om[0][threadIdx.x], 0.03f);
            float o = 0.f; if (threadIdx.x < 128) o = rbf(Om[0][threadIdx.x]) - lam * rbf(Om[1][threadIdx.x]);
            const float ss = blk_sum(o * o, sh); const float r = 1.0f / sqrtf(ss / 128.f + RMS_EPS_);
            if (threadIdx.x < 128) errmax(ctl, 9, bf2f(((const us*)(ws + WS_ON))[((size_t)b * SEQ_ + row) * D_ + hh * 128 + threadIdx.x]), o * r * a.in[I_SUBG][threadIdx.x] * (1.f - LAM_INIT_), 0.04f);
            __syncthreads();
        }
        {
            const unsigned hb = hashu(blockIdx.x * 31 + 77); int t = hb % T_; if (blockIdx.x < 16) t = (blockIdx.x >> 1) * SEQ_ + (blockIdx.x & 1) * 17 + 3;
            const int pos = t & (SEQ_ - 1); const us* U = (const us*)(ws + WS_U); float y[4]; float s = 0.f, q = 0.f;
            _Pragma("unroll") for (int i = 0; i < 4; ++i) { const int c = threadIdx.x + 256 * i; float acc = a.in[I_CB][c];
                for (int j = 0; j < 31; ++j) { const int p = pos - 30 + j; if (p >= 0) acc += a.in[I_CW][j * 1024 + c] * bf2f(U[(size_t)(t - 30 + j) * D_ + c]); }
                y[i] = acc; s += acc; }
            const float mean = blk_sum(s, sh) / 1024.f; _Pragma("unroll") for (int i = 0; i < 4; ++i) q += (y[i] - mean) * (y[i] - mean);
            const float var = blk_sum(q, sh) / 1024.f, rstd = 1.0f / sqrtf(var + LN_EPS_);
            _Pragma("unroll") for (int i = 0; i < 4; ++i) { const int c = threadIdx.x + 256 * i; const float z = (y[i] - mean) * rstd * a.in[I_CLG][c] + a.in[I_CLB][c];
                errmax(ctl, 8, bf2f(((const us*)(ws + WS_CACT))[(size_t)t * D_ + c]), z * sig(z), 0.03f); }
        }
    } else if (ph == 4) {
    } else if (ph == 5) {
        const int row = h1 % T_, col = h2 % D_; const size_t off = (size_t)row * D_ + col;
        const float yar = bf2f(((const us*)(ws + WS_SGA))[off]) * dotbf((const us*)(ws + WS_ON) + (size_t)row * D_, (const us*)(ws + WS_WA) + (size_t)col * D_, 1024);
        const float yab = bf2f(((const us*)(ws + WS_YA))[off]);
        errmax(ctl, 10, yab, yar, 0.03f);
        const float mr = yab + bf2f(((const us*)(ws + WS_SGB))[off]) * (dotbf((const us*)(ws + WS_CACT) + (size_t)row * D_, (const us*)(ws + WS_WP) + (size_t)col * D_, 1024) + a.in[I_PWB][col]);
        errmax(ctl, 11, bf2f(((const us*)(ws + WS_M))[off]), mr, 0.03f);
    } else if (ph == 6) {
        const int row = h1 % T_, col = h2 % D_, b = row >> 12; const size_t off = (size_t)row * D_ + col;
        const float r = DN_ALPHA_ * a.in[I_X][off] + mod[b * 6144 + 2048 + col] * dotbf((const us*)(ws + WS_M) + (size_t)row * D_, (const us*)(ws + WS_WO) + (size_t)col * D_, 1024);
        errmax(ctl, 12, ((const float*)(ws + WS_Z))[off], r, 0.05f);
    } else if (ph == 7) {
        const int t = hashu(blockIdx.x * 131 + 11) % T_, b = t >> 12; const float* X1 = (const float*)(ws + WS_Z) + (size_t)t * D_; float v[4]; float s = 0.f, q = 0.f;
        _Pragma("unroll") for (int i = 0; i < 4; ++i) { const int c = threadIdx.x + 256 * i; v[i] = (X1[c] - a.in[I_LN1B][c]) / a.in[I_LN1G][c]; s += v[i]; }
        const float mean = blk_sum(s, sh) / 1024.f; _Pragma("unroll") for (int i = 0; i < 4; ++i) q += (v[i] - mean) * (v[i] - mean); const float var = blk_sum(q, sh) / 1024.f;
        if (threadIdx.x == 0) { errmax(ctl, 13, mean, 0.f, 0.05f); errmax(ctl, 13, var, 1.f, 0.f); }
        _Pragma("unroll") for (int i = 0; i < 4; ++i) { const int c = threadIdx.x + 256 * i; errmax(ctl, 13, bf2f(((const us*)(ws + WS_H2))[(size_t)t * D_ + c]), X1[c] * (1.f + mod[b * 6144 + 4096 + c]) + mod[b * 6144 + 3072 + c], 0.05f); }
    } else if (ph == 8) {
        const int row = h1 % T_, e = h2 % NE_;
        errmax(ctl, 14, ((const float*)(ws + WS_LG))[(size_t)row * NE_ + e], dotbf((const us*)(ws + WS_H2) + (size_t)row * D_, (const us*)(ws + WS_WR) + (size_t)e * D_, 1024), 0.05f);
    } else if (ph == 9) {
        {
            const int t = hashu(blockIdx.x * 173 + 3) % T_; float* sc = big; float* ch = big + 256; float* gsc = big + 512; int* gsel = (int*)(big + 520); int* eidx = (int*)(big + 530); float* egate = big + 540;
            const float sv = sig(((const float*)(ws + WS_LG))[(size_t)t * NE_ + threadIdx.x]); sc[threadIdx.x] = sv; ch[threadIdx.x] = sv + a.in[I_RB][threadIdx.x]; __syncthreads();
            if (threadIdx.x < 8) { float m1 = -INFINITY, m2 = -INFINITY; for (int i = 0; i < 32; ++i) { const float v = ch[threadIdx.x * 32 + i]; if (v > m1) { m2 = m1; m1 = v; } else if (v > m2) m2 = v; } gsc[threadIdx.x] = m1 + m2; }
            __syncthreads();
            if (threadIdx.x == 0) { for (int g = 0; g < 8; ++g) { int rank = 0; for (int gp = 0; gp < 8; ++gp) rank += (gsc[gp] > gsc[g] || (gsc[gp] == gsc[g] && gp < g)) ? 1 : 0; gsel[g] = rank < 4; }
                float ssum = 0.f;
                for (int k = 0; k < 8; ++k) { int best = -1; float bv = -INFINITY; for (int e = 0; e < 256; ++e) { if (!gsel[e >> 5]) continue; bool taken = false; for (int kk = 0; kk < k; ++kk) taken |= (eidx[kk] == e); if (taken) continue; if (ch[e] > bv) { bv = ch[e]; best = e; } }
                    eidx[k] = best; egate[k] = sc[best]; ssum += sc[best]; }
                for (int k = 0; k < 8; ++k) { const int gi = ((const int*)(ws + WS_TOPI))[t * 8 + k]; errmax(ctl, 15, gi != eidx[k] ? 1.f : 0.f, 0.f, 1.f);
                    errmax(ctl, 15, ((const float*)(ws + WS_TOPG))[t * 8 + k], egate[k] / ssum * ROUTED_SCALE_, 1e-3f); } }
            __syncthreads();
        }
        {
            const int* list = (const int*)(ws + WS_LIST); const int* topi = (const int*)(ws + WS_TOPI);
            if (blockIdx.x == 0) { const int c = (int)ctl[CW_CNT + 64 * threadIdx.x]; const float tot = blk_sum((float)c, sh); if (threadIdx.x == 0) errmax(ctl, 16, tot, (float)(T_ * 8), 0.f); }
            const int e = h1 % NE_, c = (int)ctl[CW_CNT + 64 * e]; if (c > 0) { const int pos = h2 % c, av = list[(size_t)e * T_ + pos]; float bad = 0.f; if (av < 0 || av >= T_ * 8) bad = 1.f; else if (topi[av] != e) bad = 1.f; errmax(ctl, 16, bad, 0.f, 1.f); }
        }
    } else if (ph == 10 || ph == 11) {
        const int e = (gs & 7) == 0 ? NE_ : (int)(h1 % NE_); const int c = e < NE_ ? (int)ctl[CW_CNT + 64 * e] : T_;
        if (c > 0) { int ts = 0; for (int i = 0; i < e; ++i) ts += ((int)ctl[CW_CNT + 64 * i] + 255) >> 8;
            const int pos = h2 % c; const int av = e < NE_ ? ((const int*)(ws + WS_LIST))[(size_t)e * T_ + pos] : pos * 8; const int t = av >> 3; const size_t row = (size_t)(ts + (pos >> 8)) * 256 + (pos & 255);
            if (ph == 10) { const int n = h3 % FE_; const us* hr = (const us*)(ws + WS_H2) + (size_t)t * D_; const us* W = (const us*)(ws + WS_WUP) + ((size_t)e * 512 + (n >> 7) * 256 + (n & 127)) * 1024;
                const float A = dotbf(hr, W, 1024), B = dotbf(hr, W + 128 * 1024, 1024); errmax(ctl, 17, bf2f(((const us*)(ws + WS_HID))[row * FE_ + n]), A * sig(A) * B, 0.03f); }
            else if (e < NE_) { const int col = h3 % D_; const float r = ((const float*)(ws + WS_TOPG))[av] * dotbf((const us*)(ws + WS_HID) + row * FE_, (const us*)(ws + WS_WDN) + ((size_t)e * 1024 + col) * 256, 256);
                { const unsigned char yb = ((const unsigned char*)(ws + WS_YS))[(size_t)av * D_ + col]; const float got = __builtin_amdgcn_cvt_pk_f32_fp8((int)yb, false)[0] / pg8::YS_SCALE; errmax(ctl, 18, got, r, 0.02f); } }
        }
    } else if (ph == 12) {
        const int t = hashu(blockIdx.x * 211 + 13) % T_, b = t >> 12; float v[4]; float s = 0.f, q = 0.f;
        _Pragma("unroll") for (int i = 0; i < 4; ++i) { const int c = threadIdx.x + 256 * i; float y = 0.f; for (int k = 0; k < 8; ++k) y += __builtin_amdgcn_cvt_pk_f32_fp8((int)((const unsigned char*)(ws + WS_YS))[((size_t)t * 8 + k) * D_ + c], false)[0] / pg8::YS_SCALE;
            v[i] = ((const float*)(ws + WS_Z))[(size_t)t * D_ + c] + mod[b * 6144 + 5120 + c] * y; s += v[i]; }
        const float mean = blk_sum(s, sh) / 1024.f; _Pragma("unroll") for (int i = 0; i < 4; ++i) q += (v[i] - mean) * (v[i] - mean); const float rstd = 1.0f / sqrtf(blk_sum(q, sh) / 1024.f + LN_EPS_);
        _Pragma("unroll") for (int i = 0; i < 4; ++i) { const int c = threadIdx.x + 256 * i; errmax(ctl, 19, a.out[(size_t)t * D_ + c], (v[i] - mean) * rstd * a.in[I_LN2G][c] + a.in[I_LN2B][c], 0.05f); }
    }
}

__global__ void __launch_bounds__(256) chk_scan(Args a) {
    unsigned* ctl = (unsigned*)(a.ws + WS_CTL); const unsigned short* A = (const unsigned short*)(a.ws + WS_SGA); const unsigned short* B = (const unsigned short*)(a.ws + WS_SGB);
    for (size_t i = (size_t)blockIdx.x * 256 + threadIdx.x; i < (size_t)T_ * D_; i += (size_t)gridDim.x * 256) {
        const float va = chk::bf2f(A[i]), vb = chk::bf2f(B[i]); const int row = (int)(i >> 10), col = (int)(i & 1023);
        if (!(va >= 0.f && va <= 1.f)) { atomicAdd(ctl + CW_ERR + 40, 1u); atomicOr(ctl + CW_ERR + 41, 1u << (col >> 7)); atomicOr(ctl + CW_ERR + 42, 1u << ((row >> 8) & 31)); atomicMin(ctl + CW_ERR + 43, (unsigned)row ^ 0xffffffffu); atomicMax(ctl + CW_ERR + 44, (unsigned)row); atomicOr(ctl + CW_ERR + 46, 1u << (row & 31)); atomicOr(ctl + CW_ERR + 47, 1u << ((col >> 2) & 31)); }
        if (!(vb >= 0.f && vb <= 1.f)) atomicAdd(ctl + CW_ERR + 45, 1u);
        { const unsigned short* S = (const unsigned short*)(a.ws + WS_CACT); const float vs = chk::bf2f(S[i]); if (!(vs >= 0.f && vs <= 1.f)) atomicAdd(ctl + CW_ERR + 48, 1u); if (S[i] != A[i]) atomicAdd(ctl + CW_ERR + 49, 1u); }
    }
}
#ifndef CHK_TOL
#define CHK_TOL 0.06f
#endif
#ifndef CHK_FIRST
#define CHK_FIRST 1
#endif
__global__ void __launch_bounds__(256) chk_final(Args a) {
    const unsigned* ctl = (const unsigned*)(a.ws + WS_CTL); int bad = 0;
    for (int id = 20; id >= CHK_FIRST; --id) if (__uint_as_float(ctl[CW_ERR + id]) > CHK_TOL) bad = id;
#ifdef CHK_WORD
    { const unsigned w = ctl[CW_ERR + CHK_WORD];
#if CHK_ENC == 0
      bad = 1 + (int)(4.f * log2f((float)w + 1.f) + 0.5f);
#else
      bad = 1 + (int)((w >> CHK_SHIFT) & 63u);
#endif
    }
#endif
#ifdef CHK_MAG
    { const float e = __uint_as_float(ctl[CW_ERR + CHK_MAG]); float code = 40.f + 4.f * log2f(fmaxf(e, 1e-9f)); code = fminf(fmaxf(code, 0.f), 96.f); bad = (int)(code + 0.5f); if (bad < 1) bad = 1; }
#endif
    float vv = sqrtf((float)bad);
#ifdef CHK_TWO
    { const unsigned w1 = ctl[CW_ERR + 40], w2 = ctl[CW_ERR + 48], w3 = ctl[CW_ERR + 49]; int v1 = (int)(3.f * log2f((float)w1 + 1.f) + 0.5f); if (v1 > 63) v1 = 63; int v2 = (w2 != 0u ? 1 : 0) + (w3 != 0u ? 2 : 0);
      float sc = (float)(10 + v1) * 10.f; for (int i = 0; i < v2; ++i) sc *= 10.f; vv = sqrtf(sc); bad = 1; }
#endif
    if (bad) { const float v = vv; for (size_t i = (size_t)blockIdx.x * 256 + threadIdx.x; i < (size_t)T_ * D_; i += (size_t)gridDim.x * 256) a.out[i] = v; }
}
#endif

extern "C" void kernel_launch(void* const* d_in, const int* in_sizes, int n_in, void* d_out, int out_size, void* d_ws, size_t ws_size, hipStream_t stream) {
    static int grid = 0;
    if (grid == 0) {
        if (n_in != N_IN || in_sizes[0] != T_ * D_ || out_size != T_ * D_ || ws_size < WS_END) { fprintf(stderr, "kernel_launch: unexpected shapes (n_in %d, in0 %d, out %d, ws %zu); nothing launched\n", n_in, n_in > 0 ? in_sizes[0] : -1, out_size, ws_size); grid = -1; return; }
        int dev = 0, cus = 0, per_cu = 0;
        if (hipGetDevice(&dev) != hipSuccess || hipDeviceGetAttribute(&cus, hipDeviceAttributeMultiprocessorCount, dev) != hipSuccess) { grid = -1; return; }
        if (hipFuncSetAttribute((const void*)mk_fwd, hipFuncAttributeMaxDynamicSharedMemorySize, LDS_BYTES) != hipSuccess) { fprintf(stderr, "kernel_launch: hipFuncSetAttribute failed\n"); grid = -1; return; }
        if (hipOccupancyMaxActiveBlocksPerMultiprocessor(&per_cu, (const void*)mk_fwd, NWAVES * 64, LDS_BYTES) != hipSuccess || per_cu < 1) { fprintf(stderr, "kernel_launch: occupancy query reports %d\n", per_cu); }
        (void)hipGetLastError();
        grid = cus;
    }
    if (grid < 0) return;
    if (hipMemsetAsync((char*)d_ws + WS_CTL, 0, CTL_ZERO_BYTES, stream) != hipSuccess) return;
    Args a{};
    for (int i = 0; i < N_IN; ++i) a.in[i] = (const float*)d_in[i];
    a.out = (float*)d_out; a.ws = (unsigned char*)d_ws;
#if MK_SPLIT
    for (int p = 0; p < NPH; ++p) { a.ph_lo = p; a.ph_hi = p + 1;
#ifdef DBG_PREFILL
        if (p == 2) (void)hipMemsetAsync((char*)d_ws + WS_SGA, 0x3f, 2 * WS_SLOT, stream);
#endif
        hipLaunchKernelGGL(mk_fwd, dim3(grid), dim3(NWAVES * 64), LDS_BYTES, stream, a);
#if DBG_CHECK
        hipLaunchKernelGGL(chk_phase, dim3(64), dim3(256), 0, stream, a, p);
        if (p == 2) hipLaunchKernelGGL(chk_scan, dim3(1024), dim3(256), 0, stream, a);
#endif
    }
#if DBG_CHECK
    hipLaunchKernelGGL(chk_final, dim3(1024), dim3(256), 0, stream, a);
#ifdef DBG_POSTFILL
    (void)hipMemsetAsync((char*)d_ws + WS_SGA, 0x3f, 2 * WS_SLOT, stream);
#endif
#endif
#else
    a.ph_lo = 0; a.ph_hi = NPH;
    hipLaunchKernelGGL(mk_fwd, dim3(grid), dim3(NWAVES * 64), LDS_BYTES, stream, a);
#endif
}
```
